# Optimizing an MI355X kernel written in HIP

```python
import math
import jax
import jax.numpy as jnp
from jax import lax
import numpy as np

D_MODEL = 2048
BATCH = 8
SEQ = 2048
DEPTH = 2

HEAD_DIM = 64
N_HEADS = D_MODEL // HEAD_DIM
N_HEADS_SB = N_HEADS // 4
N_HEADS_DIL = (N_HEADS - N_HEADS_SB) // 2
N_HEADS_FOX = N_HEADS - N_HEADS_SB - N_HEADS_DIL
MIX_WIDTH = N_HEADS * HEAD_DIM
W_SB = N_HEADS_SB * HEAD_DIM
W_FOX = N_HEADS_FOX * HEAD_DIM
W_DIL = N_HEADS_DIL * HEAD_DIM
IN_SIZES = (W_SB, W_SB, W_SB, W_FOX, W_FOX, W_FOX, W_DIL, W_DIL, W_DIL, N_HEADS_FOX)
VALUE_SLOTS = (2, 5, 8)
IN_WIDTH = sum(IN_SIZES)

QUERY_BLOCK = 128
DILATED_PATTERNS = ((128, 1), (512, 4), (2048, 16))
ROPE_THETA = 10000.0
FORGET_BIAS_INIT = 4.0

N_EXPERTS = 64
TOP_K = 6
EXPERT_HIDDEN = 512
SHARED_HIDDEN = 512
ROUTED_SCALE = 2.5
MOE_BLOCK = 128

DEEPNORM_ALPHA = (2 * DEPTH) ** 0.25
DEEPNORM_BETA = (8 * DEPTH) ** -0.25
LN_EPS = 1e-5
RMS_EPS = 1e-6

kernel_name = 'hybrid_stickbreak_fox_dilated_moe_deepnorm_adaln'


def layer_norm(x, g, b):
    xf = x.astype(jnp.float32)
    mu = jnp.mean(xf, axis=-1, keepdims=True)
    var = jnp.mean(jnp.square(xf - mu), axis=-1, keepdims=True)
    return ((xf - mu) * lax.rsqrt(var + LN_EPS) * g + b).astype(x.dtype)


def rms_norm(x, g):
    xf = x.astype(jnp.float32)
    return (xf * lax.rsqrt(jnp.mean(jnp.square(xf), axis=-1, keepdims=True) + RMS_EPS) * g).astype(x.dtype)


def split_columns(proj):
    parts, off = [], 0
    for n in IN_SIZES:
        parts.append(proj[..., off:off + n])
        off += n
    return parts


def to_heads(t):
    b, s, w = t.shape
    return t.reshape(b, s, w // HEAD_DIM, HEAD_DIM).transpose(0, 2, 1, 3)


def rope(t, positions):
    half = HEAD_DIM // 2
    inv_freq = ROPE_THETA ** (-jnp.arange(half, dtype=jnp.float32) / half)
    ang = positions.astype(jnp.float32)[:, None, :, None] * inv_freq
    cos, sin = jnp.cos(ang), jnp.sin(ang)
    tf = t.astype(jnp.float32)
    t1, t2 = tf[..., :half], tf[..., half:]
    return jnp.concatenate([t1 * cos - t2 * sin, t1 * sin + t2 * cos], axis=-1).astype(t.dtype)


def sweep_query_blocks(block_fn, seq_len):
    n_blocks = seq_len // QUERY_BLOCK
    out = lax.map(block_fn, jnp.arange(n_blocks))
    out = jnp.moveaxis(out, 0, 2)
    return out.reshape(out.shape[:2] + (seq_len, out.shape[-1]))


def stick_breaking_attention(q, k, v):
    seq_len = q.shape[2]
    key_idx = jnp.arange(seq_len)

    def block(b):
        start = b * QUERY_BLOCK
        qb = lax.dynamic_slice_in_dim(q, start, QUERY_BLOCK, axis=2)
        z = jnp.einsum('bhqd,bhkd->bhqk', qb, k, preferred_element_type=jnp.float32) * HEAD_DIM ** -0.5
        q_idx = start + jnp.arange(QUERY_BLOCK)
        past = key_idx[None, :] < q_idx[:, None]
        log_keep = jnp.where(past, jax.nn.log_sigmoid(-z), 0.0)
        later = lax.cumsum(log_keep, axis=3, reverse=True) - log_keep
        w = jnp.where(past, jnp.exp(jax.nn.log_sigmoid(z) + later), 0.0)
        return jnp.einsum('bhqk,bhkd->bhqd', w.astype(v.dtype), v)

    return sweep_query_blocks(block, seq_len)


def forgetting_attention(q, k, v, log_f):
    seq_len = q.shape[2]
    key_idx = jnp.arange(seq_len)
    cum = jnp.cumsum(log_f, axis=-1)

    def block(b):
        start = b * QUERY_BLOCK
        qb = lax.dynamic_slice_in_dim(q, start, QUERY_BLOCK, axis=2)
        cum_q = lax.dynamic_slice_in_dim(cum, start, QUERY_BLOCK, axis=2)
        z = jnp.einsum('bhqd,bhkd->bhqk', qb, k, preferred_element_type=jnp.float32) * HEAD_DIM ** -0.5
        logits = z + (cum_q[..., :, None] - cum[..., None, :])
        q_idx = start + jnp.arange(QUERY_BLOCK)
        causal = key_idx[None, :] <= q_idx[:, None]
        p = jax.nn.softmax(jnp.where(causal, logits, -jnp.inf), axis=-1)
        return jnp.einsum('bhqk,bhkd->bhqd', p.astype(v.dtype), v)

    return sweep_query_blocks(block, seq_len)


def sliding_window_attention(q, k, v, window):
    length = q.shape[-2]
    blk = math.gcd(length, QUERY_BLOCK)
    n_blocks = length // blk
    span = window + blk
    pad = [(0, 0)] * (q.ndim - 2) + [(window, 0), (0, 0)]
    kp, vp = jnp.pad(k, pad), jnp.pad(v, pad)
    starts = jnp.arange(n_blocks) * blk
    slab = starts[:, None] + jnp.arange(span)[None, :]
    ks = jnp.take(kp, slab, axis=-2)
    vs = jnp.take(vp, slab, axis=-2)
    qb = q.reshape(q.shape[:-2] + (n_blocks, blk, q.shape[-1]))
    logits = jnp.einsum('...nqd,...nkd->...nqk', qb, ks, preferred_element_type=jnp.float32)
    dist = jnp.arange(blk)[:, None] + window - jnp.arange(span)[None, :]
    key_pos = starts[:, None] - window + jnp.arange(span)[None, :]
    valid = ((dist >= 0) & (dist <= window))[None] & (key_pos >= 0)[:, None, :]
    logits = jnp.where(valid, logits, -jnp.inf)
    m = jnp.max(logits, axis=-1, keepdims=True)
    p = jnp.exp(logits - m)
    denom = jnp.sum(p, axis=-1)
    o = jnp.einsum('...nqk,...nkd->...nqd', p.astype(v.dtype), vs, preferred_element_type=jnp.float32)
    o = o / denom[..., None]
    lse = m[..., 0] + jnp.log(denom)
    return o.reshape(q.shape).astype(v.dtype), lse.reshape(q.shape[:-1])


def to_residues(t, dil):
    b, h, s = t.shape[:3]
    return jnp.swapaxes(t.reshape((b, h, s // dil, dil) + t.shape[3:]), 2, 3)


def from_residues(t):
    t = jnp.swapaxes(t, 2, 3)
    return t.reshape(t.shape[:2] + (t.shape[2] * t.shape[3],) + t.shape[4:])


def dilated_attention(q, k, v):
    q = q * HEAD_DIM ** -0.5
    outs, lses = [], []
    for window, dil in DILATED_PATTERNS:
        o, lse = sliding_window_attention(to_residues(q, dil), to_residues(k, dil),
                                          to_residues(v, dil), window // dil)
        outs.append(from_residues(o))
        lses.append(from_residues(lse))
    wts = jax.nn.softmax(jnp.stack(lses), axis=0)
    o = jnp.sum(wts[..., None] * jnp.stack(outs).astype(jnp.float32), axis=0)
    return o.astype(v.dtype)


def token_mixer(h, positions, w_in, b_forget, head_norm_g, w_out):
    b, s, _ = h.shape
    proj = h @ w_in
    (q_sb, k_sb, v_sb, q_fx, k_fx, v_fx, q_dl, k_dl, v_dl, f_logit) = split_columns(proj)
    o_sb = stick_breaking_attention(to_heads(q_sb), to_heads(k_sb), to_heads(v_sb))
    log_f = jax.nn.log_sigmoid((f_logit + b_forget).astype(jnp.float32)).transpose(0, 2, 1)
    o_fx = forgetting_attention(to_heads(q_fx), to_heads(k_fx), to_heads(v_fx), log_f)
    o_dl = dilated_attention(rope(to_heads(q_dl), positions), rope(to_heads(k_dl), positions),
                             to_heads(v_dl))
    o = jnp.concatenate([o_sb, o_fx, o_dl], axis=1)
    o = rms_norm(o, head_norm_g.reshape(N_HEADS, 1, HEAD_DIM))
    o = o.transpose(0, 2, 1, 3).reshape(b, s, MIX_WIDTH)
    return o @ w_out


def swiglu(x, w_gate, w_up, w_down):
    return (jax.nn.silu(x @ w_gate) * (x @ w_up)) @ w_down


def grouped_experts(hf, expert_idx, gates, w_gate, w_up, w_down):
    n_tok = hf.shape[0]
    n_assign = n_tok * TOP_K
    flat_e = expert_idx.reshape(-1)
    flat_tok = jnp.arange(n_assign, dtype=jnp.int32) // TOP_K
    flat_w = gates.reshape(-1)
    order = jnp.argsort(flat_e, stable=True)
    e_sorted = flat_e[order]
    counts = jnp.bincount(flat_e, length=N_EXPERTS)
    padded = (counts + MOE_BLOCK - 1) // MOE_BLOCK * MOE_BLOCK
    start = jnp.cumsum(counts) - counts
    pad_end = jnp.cumsum(padded)
    pad_start = pad_end - padded
    dest = pad_start[e_sorted] + jnp.arange(n_assign, dtype=jnp.int32) - start[e_sorted]
    n_blocks = -(-(n_assign + N_EXPERTS * (MOE_BLOCK - 1)) // MOE_BLOCK)
    rows = n_blocks * MOE_BLOCK
    row_tok = jnp.zeros((rows,), jnp.int32).at[dest].set(flat_tok[order])
    row_w = jnp.zeros((rows,), flat_w.dtype).at[dest].set(flat_w[order])
    block_e = jnp.searchsorted(pad_end, jnp.arange(n_blocks) * MOE_BLOCK, side='right')
    block_e = jnp.minimum(block_e, N_EXPERTS - 1)

    def step(acc, blk):
        tok, wt, e = blk
        y = swiglu(hf[tok], w_gate[e], w_up[e], w_down[e]) * wt[:, None]
        return acc.at[tok].add(y), None

    acc, _ = lax.scan(step, jnp.zeros_like(hf),
                      (row_tok.reshape(n_blocks, MOE_BLOCK), row_w.reshape(n_blocks, MOE_BLOCK), block_e))
    return acc


def moe_ffn(h, w_router, router_bias, w_gate, w_up, w_down, ws_gate, ws_up, ws_down):
    b, s, d = h.shape
    hf = h.reshape(b * s, d)
    scores = jax.nn.sigmoid(hf.astype(jnp.float32) @ w_router.astype(jnp.float32))
    _, idx = lax.top_k(scores + router_bias.astype(jnp.float32), TOP_K)
    sel = jnp.take_along_axis(scores, idx, axis=-1)
    gates = (sel / jnp.sum(sel, axis=-1, keepdims=True) * ROUTED_SCALE).astype(h.dtype)
    routed = grouped_experts(hf, idx, gates, w_gate, w_up, w_down)
    shared = swiglu(hf, ws_gate, ws_up, ws_down)
    return (routed + shared).reshape(b, s, d)


def setup_inputs(seed: int = 0) -> dict:
    key = jax.random.key(seed)
    ks = jax.random.split(key, 22)
    d, L, e, fh, sh = D_MODEL, DEPTH, N_EXPERTS, EXPERT_HIDDEN, SHARED_HIDDEN

    def dense(k, shape, fan_in, gain=1.0):
        return jax.random.normal(k, shape, jnp.float32) * (gain * fan_in ** -0.5)

    def near_one(k, shape):
        return 1.0 + 0.02 * jax.random.normal(k, shape, jnp.float32)

    def small(k, shape, scale=0.02):
        return scale * jax.random.normal(k, shape, jnp.float32)

    col_gain = jnp.concatenate([jnp.full((n,), DEEPNORM_BETA if i in VALUE_SLOTS else 1.0, jnp.float32)
                                for i, n in enumerate(IN_SIZES)])
    offsets = jax.random.randint(ks[2], (BATCH, 1), 0, SEQ, dtype=jnp.int32)
    return {
        'x': jax.random.normal(ks[0], (BATCH, SEQ, d), jnp.float32),
        'c': jax.random.normal(ks[1], (BATCH, d), jnp.float32),
        'positions': offsets + jnp.arange(SEQ, dtype=jnp.int32)[None, :],
        'w_ada': dense(ks[3], (L, d, 6 * d), d),
        'b_ada': small(ks[4], (L, 6 * d)),
        'w_in': dense(ks[5], (L, d, IN_WIDTH), d) * col_gain,
        'b_forget': FORGET_BIAS_INIT + small(ks[6], (L, N_HEADS_FOX), 0.1),
        'head_norm_g': near_one(ks[7], (L, MIX_WIDTH)),
        'w_out': dense(ks[8], (L, MIX_WIDTH, d), MIX_WIDTH, DEEPNORM_BETA),
        'ln1_g': near_one(ks[9], (L, d)),
        'ln1_b': small(ks[10], (L, d)),
        'w_router': dense(ks[11], (L, d, e), d),
        'router_bias': small(ks[12], (L, e), 0.01),
        'w_exp_gate': dense(ks[13], (L, e, d, fh), d, DEEPNORM_BETA),
        'w_exp_up': dense(ks[14], (L, e, d, fh), d, DEEPNORM_BETA),
        'w_exp_down': dense(ks[15], (L, e, fh, d), fh, DEEPNORM_BETA),
        'w_sh_gate': dense(ks[16], (L, d, sh), d, DEEPNORM_BETA),
        'w_sh_up': dense(ks[17], (L, d, sh), d, DEEPNORM_BETA),
        'w_sh_down': dense(ks[18], (L, sh, d), sh, DEEPNORM_BETA),
        'ln2_g': near_one(ks[19], (L, d)),
        'ln2_b': small(ks[20], (L, d)),
    }


def reference(x, c, positions, w_ada, b_ada, w_in, b_forget, head_norm_g, w_out, ln1_g, ln1_b,
              w_router, router_bias, w_exp_gate, w_exp_up, w_exp_down, w_sh_gate, w_sh_up, w_sh_down,
              ln2_g, ln2_b):
    c_act = jax.nn.silu(c)
    for l in range(DEPTH):
        mod = (c_act @ w_ada[l] + b_ada[l])[:, None, :]
        shift1, scale1, gate1, shift2, scale2, gate2 = jnp.split(mod, 6, axis=-1)
        h = x * (1.0 + scale1) + shift1
        mix = token_mixer(h, positions, w_in[l], b_forget[l], head_norm_g[l], w_out[l])
        x = layer_norm(DEEPNORM_ALPHA * x + gate1 * mix, ln1_g[l], ln1_b[l])
        h = x * (1.0 + scale2) + shift2
        ffn = moe_ffn(h, w_router[l], router_bias[l], w_exp_gate[l], w_exp_up[l], w_exp_down[l],
                      w_sh_gate[l], w_sh_up[l], w_sh_down[l])
        x = layer_norm(DEEPNORM_ALPHA * x + gate2 * ffn, ln2_g[l], ln2_b[l])
    return x
```

```cpp
#include <hip/hip_runtime.h>
#include <hip/hip_bf16.h>
#include <cstdio>
#include <cstdint>

#ifndef MK_ONE_LAUNCH
#define MK_ONE_LAUNCH 1
#endif

namespace pg8 {
#define PG8_LAS __attribute__((address_space(3)))
typedef unsigned short bf16_t;
typedef short bf16x8 __attribute__((ext_vector_type(8)));
typedef float f32x4 __attribute__((ext_vector_type(4)));
typedef unsigned u32x4 __attribute__((ext_vector_type(4)));
constexpr int BM = 256, BK = 64, HALF = 128, HTB = HALF * BK * 2, STAGE_BYTES = 8 * HTB, NXCD = 8, WGM = 8;
constexpr int GOFF_REL = 137216;

__host__ __device__ __forceinline__ int lds_byte(int r, int c) { const int st = (r >> 4) * 2 + (c >> 5), rr = r & 15, cc = c & 31, ob = rr * 64 + cc * 2; return st * 1024 + (ob ^ (((ob >> 9) & 1) << 5)); }
__host__ __device__ __forceinline__ void stage_rc(int b, int& R, int& C) { const int st = b / 1024, sb = b % 1024, swz = sb ^ (((sb >> 9) & 1) << 5); R = (st >> 1) * 16 + swz / 64; C = (st & 1) * 32 + (swz % 64) / 2; }
__host__ __device__ __forceinline__ int perm32(int rho) { const int n = rho >> 4, i = rho & 15; return 8 * (i >> 2) + 4 * n + (i & 3); }

struct Unit { int pm, pn; };
struct Gemm { const void* A; const void* Bt; int KB; int sa, sb; };

struct StaticOrder {
    static constexpr bool GATHER = false;
    int nM, nN, nwg, G, c;
    __device__ void init(int M, int N, int G_, int c_) { nM = M / BM; nN = N / BM; nwg = nM * nN; G = G_; c = c_; }
    __device__ bool next(int i, Unit& u) const {
        const long L = (long)i * G + c; if (L >= nwg) return false;
        int wgid = (int)L; { const int q = nwg / NXCD, r = nwg % NXCD, xcd = wgid % NXCD, off = wgid / NXCD; wgid = (xcd < r ? xcd * (q + 1) : r * (q + 1) + (xcd - r) * q) + off; }
        const int nig = WGM * nN, gid = wgid / nig, fm = gid * WGM, gsz = (nM - fm) < WGM ? (nM - fm) : WGM;
        u.pm = fm + ((wgid % nig) % gsz); u.pn = (wgid % nig) / gsz; return true;
    }
    __device__ __forceinline__ unsigned tok_off(const Unit&, int) const { return 0u; }
};

typedef int v8i_t __attribute__((ext_vector_type(8))); typedef int v4i_t __attribute__((ext_vector_type(4)));
__device__ __forceinline__ v8i_t cat8(bf16x8 a, bf16x8 b) { const v4i_t x = __builtin_bit_cast(v4i_t, a), y = __builtin_bit_cast(v4i_t, b); return __builtin_shufflevector(x, y, 0, 1, 2, 3, 4, 5, 6, 7); }
__device__ __forceinline__ unsigned cvt_pk_bf16(float lo, float hi) { unsigned r; asm volatile("v_cvt_pk_bf16_f32 %0, %1, %2" : "=v"(r) : "v"(lo), "v"(hi)); return r; }

template <class Epi, class Sched, bool ALIGN_EPI, bool FP8 = false>
__device__ __forceinline__ void gemm_phase(PG8_LAS unsigned char* lds, const Gemm g, const Sched& S, const Epi& E, const int wid, const int lane) {
    constexpr bool GA = Sched::GATHER;
    const int tid = wid * 64 + lane, wr = wid >> 2, wc = wid & 3, fr = lane & 15, fq = lane >> 4;
    int KB = g.KB; asm volatile("" : "+s"(KB)); const int nt = KB / 128;
    unsigned voffA[2], voffB[2]; int rA[2]; unsigned cA2[2];
#pragma unroll
    for (int i = 0; i < 2; ++i) { int R, C; stage_rc(tid * 16 + i * 8192, R, C); const int Rb = Epi::PERM ? ((R & ~31) + perm32(R & 31)) : R;
        rA[i] = R; cA2[i] = (unsigned)C * 2u; voffA[i] = (unsigned)(R * KB + C * 2); voffB[i] = (unsigned)(Rb * KB + C * 2); }
    const size_t kstep = (size_t)(BK * 2);
    const size_t hstep = (size_t)HALF * KB;
    const size_t hstepA = GA ? (size_t)0 : hstep;
    const size_t tstep = 2 * hstep;
    const unsigned ldsw = (unsigned)wid * 1024u;
    const int aoff = lds_byte(wr * 64 + fr, fq * 8), boff = lds_byte(wc * 32 + fr, fq * 8);
#define PG8_SA(b, h) (((b) * 2 + (h)) * HTB)
#define PG8_SB(b, h) ((4 + (b) * 2 + (h)) * HTB)
    const unsigned ldsb = (unsigned)__builtin_amdgcn_readfirstlane((int)((unsigned)(__UINTPTR_TYPE__)lds + ldsw));
#define PG8_STAGE(bufoff, gbase, voff) do { _Pragma("unroll") for (int _i = 0; _i < 2; ++_i) { unsigned keep_; \
        asm volatile("s_mov_b32 %0, m0\n\ts_mov_b32 m0, %3\n\ts_nop 0\n\tglobal_load_lds_dwordx4 %1, %2\n\ts_mov_b32 m0, %0" : "=&s"(keep_) : "v"((voff)[_i]), "s"((const char*)(gbase)), "s"(ldsb + (unsigned)((bufoff) + _i * 8192)) : "memory"); } } while (0)
#define PG8_LDA(dst, b, h) do { _Pragma("unroll") for (int m = 0; m < 4; ++m) _Pragma("unroll") for (int k = 0; k < 2; ++k) dst[m][k] = *(const PG8_LAS bf16x8*)(lds + PG8_SA(b, h) + aoff + m * 2048 + k * 1024); } while (0)
#define PG8_LDB(dst, b, h) do { _Pragma("unroll") for (int n = 0; n < 2; ++n) _Pragma("unroll") for (int k = 0; k < 2; ++k) dst[n][k] = *(const PG8_LAS bf16x8*)(lds + PG8_SB(b, h) + boff + n * 2048 + k * 1024); } while (0)
#define PG8_MMA(ai, bj, At, Bt) do { __builtin_amdgcn_s_setprio(1); _Pragma("unroll") for (int m = 0; m < 4; ++m) _Pragma("unroll") for (int n = 0; n < 2; ++n) { \
        if constexpr (FP8) { asm volatile("v_mfma_scale_f32_16x16x128_f8f6f4 %0, %1, %2, %0, %3, %4 op_sel_hi:[0,0,0]" : "+v"(acc[ai][bj][m][n]) : "v"(cat8(Bt[n][0], Bt[n][1])), "v"(cat8(At[m][0], At[m][1])), "v"(sa_v), "v"(sb_v)); } \
        else { _Pragma("unroll") for (int k = 0; k < 2; ++k) acc[ai][bj][m][n] = __builtin_amdgcn_mfma_f32_16x16x32_bf16(Bt[n][k], At[m][k], acc[ai][bj][m][n], 0, 0, 0); } } \
        __builtin_amdgcn_s_setprio(0); } while (0)
#define PG8_WAIT_V(n) asm volatile("s_waitcnt vmcnt(" #n ")" ::: "memory")
#define PG8_WAIT_L(n) asm volatile("s_waitcnt lgkmcnt(" #n ")" ::: "memory")
#define PG8_BAR __builtin_amdgcn_s_barrier()
#define PG8_SCHED __builtin_amdgcn_sched_barrier(0)
    const int sa_v = g.sa, sb_v = g.sb;
    Unit cur, nxt; int ui = 0;
    if (!S.next(0, cur)) return;
    f32x4 acc[2][2][4][2];
#pragma unroll
    for (int a = 0; a < 2; ++a)
#pragma unroll
        for (int b = 0; b < 2; ++b)
#pragma unroll
            for (int m = 0; m < 4; ++m)
#pragma unroll
                for (int n = 0; n < 2; ++n) acc[a][b][m][n] = (f32x4){0.f, 0.f, 0.f, 0.f};
    bf16x8 At[4][2], B0[2][2], B1[2][2];
    unsigned vc0[2], vc1[2];
    PG8_LAS u32x4* gslot = (PG8_LAS u32x4*)(lds + GOFF_REL) + tid;
#pragma unroll
    for (int i = 0; i < 2; ++i) {
        if (GA) { vc0[i] = S.tok_off(cur, rA[i]) + cA2[i]; vc1[i] = S.tok_off(cur, HALF + rA[i]) + cA2[i]; }
        else { vc0[i] = voffA[i]; vc1[i] = voffA[i]; } }
    if (GA) asm volatile("" : "+v"(vc0[0]), "+v"(vc0[1]), "+v"(vc1[0]), "+v"(vc1[1]));
    const char* cA = GA ? (const char*)g.A : (const char*)g.A + (size_t)cur.pm * tstep; const char* cB = (const char*)g.Bt + (size_t)cur.pn * tstep;
    PG8_STAGE(PG8_SB(0, 0), cB, voffB); PG8_STAGE(PG8_SB(0, 1), cB + hstep, voffB); PG8_STAGE(PG8_SA(0, 0), cA, vc0); PG8_STAGE(PG8_SA(0, 1), cA + hstepA, vc1);
    if (wr == 1) PG8_BAR;
    PG8_WAIT_V(2); PG8_BAR;
    PG8_STAGE(PG8_SB(1, 0), cB + kstep, voffB); PG8_STAGE(PG8_SA(1, 0), cA + kstep, vc0); PG8_STAGE(PG8_SB(1, 1), cB + hstep + kstep, voffB);
    PG8_WAIT_V(6); PG8_BAR;
    for (;;) {
        const bool has_next = S.next(ui + 1, nxt);
        const char* nA = GA ? (const char*)g.A : (has_next ? (const char*)g.A + (size_t)nxt.pm * tstep : cA); const char* nB = has_next ? (const char*)g.Bt + (size_t)nxt.pn * tstep : cB;
        if (GA && has_next) {
            u32x4 q; q.x = S.tok_off(nxt, rA[0]) + cA2[0]; q.y = S.tok_off(nxt, rA[1]) + cA2[1]; q.z = S.tok_off(nxt, HALF + rA[0]) + cA2[0]; q.w = S.tok_off(nxt, HALF + rA[1]) + cA2[1];
            *gslot = q;
        }
#pragma clang loop unroll(disable)
        for (int t = 0; t < nt; t += 2) {
            const bool last = (t == nt - 2);
            const char* a1 = cA + (size_t)(t + 1) * kstep;
            const char* a2 = last ? nA : cA + (size_t)(t + 2) * kstep; const char* b2 = last ? nB : cB + (size_t)(t + 2) * kstep;
            const char* a3 = a2 + kstep; const char* b3 = b2 + kstep;
            PG8_LDB(B0, 0, 0); PG8_LDB(B1, 0, 1); PG8_SCHED; PG8_LDA(At, 0, 0); PG8_STAGE(PG8_SA(1, 1), a1 + hstepA, vc1);
            if (GA && last && has_next) { const u32x4 q = *gslot; vc0[0] = q.x; vc0[1] = q.y; vc1[0] = q.z; vc1[1] = q.w; }
            PG8_WAIT_V(8); PG8_WAIT_L(0); PG8_BAR; PG8_MMA(0, 0, At, B0); PG8_MMA(0, 1, At, B1); PG8_BAR; PG8_SCHED;
            PG8_LDA(At, 0, 1); PG8_STAGE(PG8_SB(0, 0), b2, voffB); PG8_STAGE(PG8_SB(0, 1), b2 + hstep, voffB); PG8_STAGE(PG8_SA(0, 0), a2, vc0);
            PG8_WAIT_V(8); PG8_WAIT_L(0); PG8_BAR; PG8_MMA(1, 0, At, B0); PG8_MMA(1, 1, At, B1); PG8_BAR; PG8_SCHED;
            PG8_LDB(B0, 1, 0); PG8_LDB(B1, 1, 1); PG8_SCHED; PG8_LDA(At, 1, 0); PG8_STAGE(PG8_SA(0, 1), a2 + hstepA, vc1);
            PG8_WAIT_V(8); PG8_WAIT_L(0); PG8_BAR; PG8_MMA(0, 0, At, B0); PG8_MMA(0, 1, At, B1); PG8_BAR; PG8_SCHED;
            PG8_LDA(At, 1, 1); PG8_STAGE(PG8_SB(1, 0), b3, voffB); PG8_STAGE(PG8_SB(1, 1), b3 + hstep, voffB); PG8_STAGE(PG8_SA(1, 0), a3, vc0);
            PG8_WAIT_V(8); PG8_WAIT_L(0); PG8_BAR; PG8_MMA(1, 0, At, B0); PG8_MMA(1, 1, At, B1); PG8_BAR; PG8_SCHED;
        }
        if constexpr (ALIGN_EPI) { if (wr == 0) PG8_BAR; }
        if constexpr (FP8) {
#pragma unroll
            for (int a = 0; a < 2; ++a)
#pragma unroll
                for (int b = 0; b < 2; ++b) asm volatile("s_nop 15\n\ts_nop 15" : "+v"(acc[a][b][0][0]), "+v"(acc[a][b][0][1]), "+v"(acc[a][b][1][0]), "+v"(acc[a][b][1][1]), "+v"(acc[a][b][2][0]), "+v"(acc[a][b][2][1]), "+v"(acc[a][b][3][0]), "+v"(acc[a][b][3][1]));
        }
        E(acc, cur, wr, wc, fr, fq);
        if (!has_next) break;
#pragma unroll
        for (int a = 0; a < 2; ++a)
#pragma unroll
            for (int b = 0; b < 2; ++b)
#pragma unroll
                for (int m = 0; m < 4; ++m)
#pragma unroll
                    for (int n = 0; n < 2; ++n) acc[a][b][m][n] = (f32x4){0.f, 0.f, 0.f, 0.f};
        cur = nxt; cA = nA; cB = nB; ++ui;
        if constexpr (ALIGN_EPI) { if (wr == 1) PG8_BAR; }
    }
    PG8_WAIT_V(0);
    if constexpr (!ALIGN_EPI) { if (wr == 0) PG8_BAR; }
    PG8_BAR;
#undef PG8_SA
#undef PG8_SB
#undef PG8_STAGE
#undef PG8_LDA
#undef PG8_LDB
#undef PG8_MMA
#undef PG8_WAIT_V
#undef PG8_WAIT_L
#undef PG8_BAR
#undef PG8_SCHED
}
}

constexpr int NWAVES = 8;
constexpr int T = 16384, D = 2048, NB = 8, SEQ = 2048, NPROJ = 6144, INW = 6156, NFOX = 12;
constexpr int NE = 64, TOPK = 6, EH = 512, LISTCAP = 16384;
constexpr int QCOL_SB = 0, KCOL_SB = 512, VCOL_SB = 1024, QCOL_FX = 1536, KCOL_FX = 2304, VCOL_FX = 3072, QCOL_DL = 3840, KCOL_DL = 4608, VCOL_DL = 5376;
constexpr float LN_EPS = 1e-5f, RMS_EPS = 1e-6f, ALPHA = 1.4142135623730951f, ROUTED_SCALE = 2.5f;
constexpr float LOG2E = 1.4426950408889634f;
constexpr int WSHIFT = 6, ASHIFT = 4, YSHIFT = 4;
constexpr float C2 = 0.125f * 1.4426950408889634f;

constexpr size_t MiB = 1u << 20;
constexpr size_t WS_CTL = 0, CTL_ZERO_BYTES = 1 * MiB;
constexpr size_t WS_MOD = 1 * MiB;
constexpr size_t WS_TAB = 2 * MiB;
constexpr size_t WS_FLOG = 6 * MiB;
constexpr size_t WS_CUM = 7 * MiB;
constexpr size_t WS_TINFO = 8 * MiB;
constexpr size_t WS_GATE = 9 * MiB;
constexpr size_t WS_LIST = 10 * MiB;
constexpr size_t WS_WR = 14 * MiB;
constexpr size_t WS_W = 16 * MiB;
constexpr size_t W_IN_OFF = 0, W_OUT_OFF = 24 * MiB, W_1_OFF = 32 * MiB, W_2_OFF = 292 * MiB, W_LAYER = 422 * MiB;
constexpr size_t WS_H = 860 * MiB;
constexpr size_t WS_X1 = 924 * MiB;
constexpr size_t WS_X2B = 988 * MiB;
constexpr size_t WS_H2 = 1052 * MiB;
constexpr size_t WS_R1 = 1116 * MiB;
constexpr size_t WS_PROJ = WS_R1, WS_OBUF = WS_R1 + 192 * MiB, WS_Y1 = WS_R1 + 256 * MiB;
constexpr size_t WS_ACT = WS_R1, WS_YBUF = WS_R1 + 128 * MiB;
constexpr size_t WS_DST_O = WS_R1 + 640 * MiB;
constexpr size_t WS_DST_M = WS_DST_O + 24 * MiB;
constexpr size_t WS_LIST2 = WS_DST_M + 2 * MiB;
constexpr size_t WS_WF = WS_LIST2 + 4 * MiB;
constexpr size_t WS_END = WS_WF + 1 * MiB;
constexpr int MAXTILES = 512;

constexpr int CW_TMO = 0, CW_CODE = 1;
constexpr int CW_BAR = 4096;
constexpr int CW_CURSOR = 8192;
constexpr int CW_AQ = 12288;
constexpr int CW_DA = 20480;

constexpr int RING_OFF = 0, RING_BYTES = 131072;
constexpr int WSF_OFF = 131072;
constexpr int TILEE_OFF = WSF_OFF + 2048;
constexpr int TB_OFF = TILEE_OFF + 2048;
constexpr int CNT_OFF = TB_OFF + 512;
constexpr int PTR_OFF = CNT_OFF + 512;
constexpr int MISC_OFF = PTR_OFF + 256;
constexpr int GOFF_OFF = 137216;
static_assert(GOFF_OFF >= MISC_OFF + 128 && GOFF_OFF + 8192 <= 147456 && GOFF_OFF == RING_OFF + pg8::GOFF_REL, "gather slots");
constexpr int LDSCTL_OFF = WSF_OFF;
constexpr int LDS_BYTES = 147456;
static_assert(MISC_OFF + 128 <= LDS_BYTES, "LDS map");
typedef unsigned v2u_early __attribute__((ext_vector_type(2)));

#define GAS __attribute__((address_space(1)))
#define LAS __attribute__((address_space(3)))
typedef unsigned short bf16;
typedef unsigned v4u __attribute__((ext_vector_type(4)));
typedef unsigned v2u __attribute__((ext_vector_type(2)));
typedef float f32x4 __attribute__((ext_vector_type(4)));
typedef short bf16x8 __attribute__((ext_vector_type(8)));
typedef GAS unsigned gu32;
#define RLX_AGENT __ATOMIC_RELAXED, __HIP_MEMORY_SCOPE_AGENT
#define LDS_WAIT() asm volatile("s_waitcnt lgkmcnt(0)" ::: "memory")
#define VM_WAIT() asm volatile("s_waitcnt vmcnt(0)" ::: "memory")
__device__ __forceinline__ unsigned f2bf(float f) { unsigned u = __builtin_bit_cast(unsigned, f); return (u + 0x7fffu + ((u >> 16) & 1u)) >> 16; }
__device__ __forceinline__ unsigned pk2(float lo, float hi) { return f2bf(lo) | (f2bf(hi) << 16); }
__device__ __forceinline__ unsigned pk4_fp8(float a, float b, float c, float d) { int r = __builtin_amdgcn_cvt_pk_fp8_f32(a, b, 0, false); r = __builtin_amdgcn_cvt_pk_fp8_f32(c, d, r, true); return (unsigned)r; }
__device__ __forceinline__ f32x4 bf4(unsigned a, unsigned b);
__device__ __forceinline__ float bflo(unsigned w) { return __builtin_bit_cast(float, w << 16); }
__device__ __forceinline__ float bfhi(unsigned w) { return __builtin_bit_cast(float, w & 0xffff0000u); }
__device__ __forceinline__ f32x4 bf4(unsigned a, unsigned b) { return (f32x4){bflo(a), bfhi(a), bflo(b), bfhi(b)}; }

#define XB_TMO      128
#define XB_XCNT(j)  (256  + 64 * (j))
#define XB_XSUB(j)  (1280 + 64 * (j))
#define XB_XGEN(j)  (2304 + 64 * (j))
#define XB_TOP      3328
#define XB_TOPGEN   3392
#define XCD_BAR_WORDS 3456
#define XB_SPIN_CAP (1u << 20)

__device__ __forceinline__ unsigned xb_ld(unsigned* p)              { return __hip_atomic_load(p, __ATOMIC_RELAXED, __HIP_MEMORY_SCOPE_AGENT); }
__device__ __forceinline__ unsigned xb_add(unsigned* p, unsigned v) { return __hip_atomic_fetch_add(p, v, __ATOMIC_RELAXED, __HIP_MEMORY_SCOPE_AGENT); }
__device__ __forceinline__ unsigned xb_xcc_id() { return (unsigned)__builtin_amdgcn_s_getreg((3 << 11) | 20) & 0xFu; }
#define XB_SPIN(cond, bar) do { unsigned _sp = 0; while (cond) { __builtin_amdgcn_s_sleep(1); \
    if ((++_sp & 255u) == 0u) { if (xb_ld(&(bar)[XB_TMO])) break; if (_sp > XB_SPIN_CAP) { atomicAdd(&(bar)[XB_TMO], 1u); break; } } } } while (0)

struct XcdBarrier { unsigned* bar; unsigned x; volatile LAS unsigned* st; };

__device__ __forceinline__ XcdBarrier xcd_barrier_post(unsigned* bar, volatile LAS unsigned* st, bool leader) {
    XcdBarrier b; b.bar = bar; b.x = xb_xcc_id(); b.st = st;
    if (leader) (void)xb_add(&bar[XB_XCNT(b.x)], 1u);
    return b;
}
__device__ __forceinline__ void xcd_barrier_complete(unsigned* bar, unsigned x, unsigned& nloc, unsigned& nx) {
    const unsigned G = gridDim.x * gridDim.y * gridDim.z;
    unsigned sum, cnt, mine, sp = 0u;
    for (;;) {
        sum = 0u; cnt = 0u; mine = 0u;
#pragma unroll
        for (unsigned j = 0; j < 16; ++j) { const unsigned c = xb_ld(&bar[XB_XCNT(j)]); sum += c; cnt += (c > 0u) ? 1u : 0u; mine = (j == x) ? c : mine; }
        if (sum == G) break;
        __builtin_amdgcn_s_sleep(1);
        if ((++sp & 255u) == 0u) { if (xb_ld(&bar[XB_TMO])) break; if (sp > XB_SPIN_CAP) { atomicAdd(&bar[XB_TMO], 1u); break; } }
    }
    nloc = mine > 0u ? mine : 1u; nx = cnt > 0u ? cnt : 1u;
}
__device__ __forceinline__ void xcd_barrier(const XcdBarrier& b, bool leader  ) {
    asm volatile("s_waitcnt vmcnt(0)" ::: "memory");
    __syncthreads();
    if (leader) {
        unsigned* bar = b.bar;
        __builtin_amdgcn_s_waitcnt(0);
        unsigned nloc = b.st[0], nx = b.st[1];
        if (nloc == 0u) { xcd_barrier_complete(bar, b.x, nloc, nx); b.st[0] = nloc; b.st[1] = nx; }
        const unsigned old = xb_add(&bar[XB_XSUB(b.x)], 1u);
        const unsigned gen = old / nloc;
        if (old + 1u == (gen + 1u) * nloc) {
            __builtin_amdgcn_fence(__ATOMIC_RELEASE, "agent");
            asm volatile("s_waitcnt vmcnt(0)" ::: "memory");
            const unsigned og = xb_add(&bar[XB_TOP], 1u);
            const unsigned tg = og / nx;
            if (og + 1u == (tg + 1u) * nx) xb_add(&bar[XB_TOPGEN], 1u);
            else XB_SPIN(xb_ld(&bar[XB_TOPGEN]) == tg, bar);
            __builtin_amdgcn_fence(__ATOMIC_ACQUIRE, "agent");
            xb_add(&bar[XB_XGEN(b.x)], 1u);
            asm volatile("s_waitcnt vmcnt(0)" ::: "memory");
        } else {
            XB_SPIN(xb_ld(&bar[XB_XGEN(b.x)]) == gen, bar);
            __builtin_amdgcn_fence(__ATOMIC_ACQUIRE, "agent");
            asm volatile("s_waitcnt vmcnt(0)" ::: "memory");
        }
    }
    __syncthreads();
}

struct Frame {
    LAS unsigned char* lds;
    gu32* ctl;
    int tid, lane, wave, G;
    unsigned char* ws;
};
enum { I_X = 0, I_C, I_POS, I_WADA, I_BADA, I_WIN, I_BFORGET, I_HNG, I_WOUT, I_LN1G, I_LN1B, I_WROUTER, I_RBIAS, I_WEG, I_WEU, I_WED, I_WSG, I_WSU, I_WSD, I_LN2G, I_LN2B, I_OUT, I_NPTR };
template <class TP> __device__ __forceinline__ TP* inptr(const Frame& F, int i) {
    const v2u v = *(const LAS v2u*)(F.lds + PTR_OFF + 8 * i);
    const unsigned long long p = ((unsigned long long)(unsigned)__builtin_amdgcn_readfirstlane((int)v.y) << 32) | (unsigned)__builtin_amdgcn_readfirstlane((int)v.x);
    return (TP*)p;
}
__device__ __forceinline__ void refresh(Frame& F) { int l = (int)__builtin_amdgcn_mbcnt_hi(~0u, __builtin_amdgcn_mbcnt_lo(~0u, 0u)); asm volatile("" : "+v"(l)); F.lane = l; F.tid = F.wave * 64 + l; }
__device__ __forceinline__ float wave_sum(float v) {
#pragma unroll
    for (int o = 1; o < 64; o <<= 1) v += __shfl_xor(v, o);
    return v;
}

__device__ __forceinline__ void p0_transpose_item(const float* W, size_t ldw, int k0, int n0, bf16* WT, size_t drowA, size_t drowB, int Kd, LAS unsigned* S, int lane) {
    const int n4 = lane & 15, ks = lane >> 4;
    const float* src = W + (size_t)(k0 + 2 * ks) * ldw + n0 + 4 * n4;
    f32x4 a[8], b[8];
#pragma unroll
    for (int i = 0; i < 8; ++i) { a[i] = __builtin_nontemporal_load((const GAS f32x4*)(src + (size_t)(8 * i) * ldw)); b[i] = __builtin_nontemporal_load((const GAS f32x4*)(src + (size_t)(8 * i + 1) * ldw)); }
#pragma unroll
    for (int i = 0; i < 8; ++i) { const int kp = 4 * i + ks;
#pragma unroll
        for (int j = 0; j < 4; ++j) { const int n = 4 * n4 + j; S[n * 32 + 4 * ((kp >> 2) ^ (n4 & 7)) + (kp & 3)] = pg8::cvt_pk_bf16(a[i][j], b[i][j]); } }
    LDS_WAIT(); asm volatile("" ::: "memory");
    const int c = lane & 7;
#pragma unroll
    for (int j = 0; j < 8; ++j) { const int n = (lane >> 3) + 8 * j;
        const v4u o = *(const LAS v4u*)(S + n * 32 + 4 * (c ^ ((n >> 2) & 7)));
        const size_t drow = (n < 32 ? drowA + n : drowB + (n - 32));
        *(GAS v4u*)(WT + drow * (size_t)Kd + k0 + 8 * c) = o; }
    LDS_WAIT(); asm volatile("" ::: "memory");
}
template <bool PAIR>
__device__ __forceinline__ void p0_transpose_item8(const float* W, size_t ldw, int k0, int n0, unsigned char* WT, size_t drow0, int KdB, float scale, LAS unsigned* S, int lane) {
    const int n4 = lane & 7, ks = lane >> 3;
    const float* src = W + (size_t)(k0 + 4 * ks) * ldw + n0 + 4 * n4;
    f32x4 a[4][4];
#pragma unroll
    for (int i = 0; i < 4; ++i)
#pragma unroll
        for (int r = 0; r < 4; ++r) a[i][r] = __builtin_nontemporal_load((const GAS f32x4*)(src + (size_t)(32 * i + r) * ldw));
#pragma unroll
    for (int i = 0; i < 4; ++i) { const int kq = ks + 8 * i;
#pragma unroll
        for (int j = 0; j < 4; ++j) { const int n = 4 * n4 + j; S[n * 32 + 4 * ((kq >> 2) ^ n4) + (kq & 3)] = pk4_fp8(a[i][0][j] * scale, a[i][1][j] * scale, a[i][2][j] * scale, a[i][3][j] * scale); } }
    LDS_WAIT(); asm volatile("" ::: "memory");
    const int c = lane & 7;
#pragma unroll
    for (int j = 0; j < 4; ++j) { const int n = (lane >> 3) + 8 * j;
        const v4u o = *(const LAS v4u*)(S + n * 32 + 4 * (c ^ ((n >> 2) & 7)));
        const int dn = PAIR ? ((n & 7) + 8 * ((n >> 4) & 1) + 128 * ((n >> 3) & 1)) : n;
        *(GAS v4u*)(WT + (drow0 + dn) * (size_t)KdB + k0 + 16 * c) = o; }
    LDS_WAIT(); asm volatile("" ::: "memory");
}
__device__ __forceinline__ int in_dest_row(int n0) {
    if (n0 < KCOL_DL + 768 && n0 >= QCOL_DL) { const int reg = (n0 - QCOL_DL) / 768, c = (n0 - QCOL_DL) % 768, tile = c >> 8, hd = (c & 255) >> 6, dh = (c & 63) >> 5;
        return QCOL_DL + reg * 768 + tile * 256 + dh * 128 + hd * 32; }
    return n0;
}
constexpr int ITEMS_IN = 32 * 96, ITEMS_OUT = 32 * 32, ITEMS_E = 768, ITEMS_LAYER = ITEMS_IN + ITEMS_OUT + 65 * ITEMS_E;

__device__ __forceinline__ void p0_prologue(Frame& F) {
    float* mod = (float*)(F.ws + WS_MOD);
    const float* Fc = inptr<const float>(F, I_C); const float* Fw_ada = inptr<const float>(F, I_WADA); const float* Fb_ada = inptr<const float>(F, I_BADA);
    {
        LAS float* cact = (LAS float*)(F.lds);
        LAS float* part = (LAS float*)(F.lds + 65536);
        for (int i = F.tid; i < NB * D; i += NWAVES * 64) { const float v = Fc[i]; cact[i] = v / (1.f + __expf(-v)); }
        __syncthreads();
        const int cg = F.tid & 7, kq = F.tid >> 3;
        for (int item = blockIdx.x; item < 768; item += F.G) {
            const int l = item / 384, col0 = (item % 384) * 32;
            f32x4 acc[8];
#pragma unroll
            for (int b = 0; b < 8; ++b) acc[b] = (f32x4){0.f, 0.f, 0.f, 0.f};
            const float* wp = Fw_ada + ((size_t)l * D) * 12288 + col0 + 4 * cg;
#pragma unroll 4
            for (int i = 0; i < 32; ++i) { const int k = kq + 64 * i; const f32x4 w4 = *(const GAS f32x4*)(wp + (size_t)k * 12288);
#pragma unroll
                for (int b = 0; b < 8; ++b) { const float cv = cact[b * D + k]; acc[b] += w4 * cv; } }
#pragma unroll
            for (int b = 0; b < 8; ++b) *(LAS f32x4*)(part + (kq * 8 + b) * 32 + 4 * cg) = acc[b];
            __syncthreads();
            if (F.tid < 256) { const int b = F.tid >> 5, col = F.tid & 31; float s = 0.f;
                for (int q = 0; q < 64; ++q) s += part[(q * 8 + b) * 32 + col];
                mod[((size_t)l * 8 + b) * 12288 + col0 + col] = s + Fb_ada[(size_t)l * 12288 + col0 + col]; }
            __syncthreads();
        }
    }
    {
        float* tab = (float*)(F.ws + WS_TAB); const int* Fpos = inptr<const int>(F, I_POS);
        for (int idx = blockIdx.x * (NWAVES * 64) + F.tid; idx < T * 32; idx += F.G * NWAVES * 64) {
            const int t = idx >> 5, i = idx & 31;
            const float inv = exp2f(-(float)i * (13.287712379549449f / 32.f));
            const float ang = (float)Fpos[t] * inv;
            double rev = (double)ang * 0.15915494309189535; rev -= __builtin_rint(rev);
            tab[(size_t)t * 64 + i] = __builtin_amdgcn_cosf((float)rev); tab[(size_t)t * 64 + 32 + i] = __builtin_amdgcn_sinf((float)rev);
        }
    }
    {
        const float* Fwr = inptr<const float>(F, I_WROUTER);
        for (int idx = blockIdx.x * (NWAVES * 64) + F.tid; idx < 2 * 128 * 2 * 64; idx += F.G * NWAVES * 64) {
            const int ln = idx & 63, nt = (idx >> 6) & 1, ks = (idx >> 7) & 127, l = idx >> 14;
            const int e = 32 * nt + (ln & 31), k0 = 16 * ks + 8 * (ln >> 5);
            float w[8]; unsigned hb[8], lb[8];
#pragma unroll
            for (int j = 0; j < 8; ++j) { w[j] = Fwr[((size_t)l * D + k0 + j) * NE + e]; hb[j] = f2bf(w[j]); lb[j] = f2bf(w[j] - __builtin_bit_cast(float, hb[j] << 16)); }
            v4u oh, ol; oh.x = hb[0] | (hb[1] << 16); oh.y = hb[2] | (hb[3] << 16); oh.z = hb[4] | (hb[5] << 16); oh.w = hb[6] | (hb[7] << 16);
            ol.x = lb[0] | (lb[1] << 16); ol.y = lb[2] | (lb[3] << 16); ol.z = lb[4] | (lb[5] << 16); ol.w = lb[6] | (lb[7] << 16);
            unsigned char* dst = F.ws + WS_WR + (size_t)l * 524288 + (size_t)((ks * 2 + nt) * 2) * 1024 + ln * 16;
            *(GAS v4u*)dst = oh; *(GAS v4u*)(dst + 1024) = ol;
        }
    }
    {
        const float* Fwi = inptr<const float>(F, I_WIN);
        for (int idx = blockIdx.x * (NWAVES * 64) + F.tid; idx < 2 * 128 * 64; idx += F.G * NWAVES * 64) {
            const int ln = idx & 63, ks = (idx >> 6) & 127, l = idx >> 13;
            const int n = ln & 31, k0 = 16 * ks + 8 * (ln >> 5);
            unsigned hb[8], lb[8];
#pragma unroll
            for (int j = 0; j < 8; ++j) { const float w = (n < NFOX) ? Fwi[((size_t)l * D + k0 + j) * INW + NPROJ + n] : 0.f; hb[j] = f2bf(w); lb[j] = f2bf(w - __builtin_bit_cast(float, hb[j] << 16)); }
            v4u oh, ol; oh.x = hb[0] | (hb[1] << 16); oh.y = hb[2] | (hb[3] << 16); oh.z = hb[4] | (hb[5] << 16); oh.w = hb[6] | (hb[7] << 16);
            ol.x = lb[0] | (lb[1] << 16); ol.y = lb[2] | (lb[3] << 16); ol.z = lb[4] | (lb[5] << 16); ol.w = lb[6] | (lb[7] << 16);
            unsigned char* dst = F.ws + WS_WF + (size_t)l * 262144 + (size_t)(ks * 2) * 1024 + ln * 16;
            *(GAS v4u*)dst = oh; *(GAS v4u*)(dst + 1024) = ol;
        }
    }
    {
        LAS unsigned* scr = (LAS unsigned*)(F.lds + RING_OFF + F.wave * 16384);
        const int gw = blockIdx.x * NWAVES + F.wave, NGW = F.G * NWAVES;
        for (int it = gw; it < 2 * ITEMS_LAYER; it += NGW) {
            const int l = 1 - it / ITEMS_LAYER; int r = ITEMS_LAYER - 1 - it % ITEMS_LAYER;
            bf16* WL = (bf16*)(F.ws + WS_W + (size_t)l * W_LAYER);
            if (r < ITEMS_IN) { const float* Fw_in = inptr<const float>(F, I_WIN); const int kb = r / 96, nb = r % 96;
                p0_transpose_item(Fw_in + (size_t)l * D * INW, INW, 64 * kb, 64 * nb, WL + W_IN_OFF / 2, in_dest_row(64 * nb), in_dest_row(64 * nb + 32), D, scr, F.lane); continue; }
            r -= ITEMS_IN;
            if (r < ITEMS_OUT) { const int kb = r / 64, nb = r % 64; const float* Fw_out = inptr<const float>(F, I_WOUT);
                p0_transpose_item8<false>(Fw_out + (size_t)l * D * D, D, 128 * kb, 32 * nb, F.ws + WS_W + (size_t)l * W_LAYER + W_OUT_OFF, (size_t)(32 * nb), D, (float)(1 << WSHIFT), scr, F.lane); continue; }
            r -= ITEMS_OUT;
            const int e = r / ITEMS_E, q = r % ITEMS_E;
            unsigned char* WLb = F.ws + WS_W + (size_t)l * W_LAYER;
            if (q < 512) { const int up = q >> 8, qq = q & 255, kb = qq / 16, nb = qq % 16, n0 = 32 * nb;
                const float* src = (e < NE) ? (inptr<const float>(F, up ? I_WEU : I_WEG) + ((size_t)l * NE + e) * D * EH) : (inptr<const float>(F, up ? I_WSU : I_WSG) + (size_t)l * D * EH);
                const size_t dr = (size_t)e * 1024 + (n0 >> 7) * 256 + up * 128 + (n0 & 127);
                p0_transpose_item8<false>(src, EH, 128 * kb, n0, WLb + W_1_OFF, dr, D, (float)(1 << WSHIFT), scr, F.lane);
            } else { const int qq = q - 512, kb = qq / 64, nb = qq % 64;
                const float* src = (e < NE) ? (inptr<const float>(F, I_WED) + ((size_t)l * NE + e) * EH * D) : (inptr<const float>(F, I_WSD) + (size_t)l * EH * D);
                { const int n0 = 32 * nb, o = n0 & 255; p0_transpose_item8<true>(src, D, 128 * kb, n0, WLb + W_2_OFF, (size_t)e * 2048 + (n0 & ~255) + 32 * (o >> 6) + 16 * ((o >> 5) & 1), EH, (float)(1 << WSHIFT), scr, F.lane); } }
        }
    }
}

__device__ __forceinline__ void prep_row_from_regs(Frame& F, const f32x4 (&xv)[8], int m, int l, const LAS float* wf) {
    const float* mod = (const float*)(F.ws + WS_MOD) + ((size_t)l * 8 + (m >> 11)) * 12288;
    bf16* hrow = (bf16*)(F.ws + WS_H) + (size_t)m * D;
    float fl[12];
#pragma unroll
    for (int j = 0; j < 12; ++j) fl[j] = 0.f;
#pragma unroll
    for (int j = 0; j < 8; ++j) { int k = 4 * F.lane + 256 * j; asm volatile("" : "+v"(k));
        const f32x4 sh = *(const GAS f32x4*)(mod + k), sc = *(const GAS f32x4*)(mod + 2048 + k);
        const f32x4 h = xv[j] * (sc + 1.0f) + sh;
        v2u o; o.x = pk2(h.x, h.y); o.y = pk2(h.z, h.w); *(GAS v2u*)(hrow + k) = o;
#pragma unroll
        for (int e = 0; e < 4; ++e) { const LAS f32x4* wr = (const LAS f32x4*)(wf + (k + e) * 12); const f32x4 a = wr[0], b = wr[1], c = wr[2]; const float hv = h[e];
            fl[0] += hv * a.x; fl[1] += hv * a.y; fl[2] += hv * a.z; fl[3] += hv * a.w; fl[4] += hv * b.x; fl[5] += hv * b.y; fl[6] += hv * b.z; fl[7] += hv * b.w;
            fl[8] += hv * c.x; fl[9] += hv * c.y; fl[10] += hv * c.z; fl[11] += hv * c.w; }
        asm volatile("" ::: "memory"); }
    float mine = 0.f;
#pragma unroll
    for (int j = 0; j < 12; ++j) { const float s = wave_sum(fl[j]); if (F.lane == j) mine = s; }
    if (F.lane < 12) ((float*)(F.ws + WS_FLOG))[(size_t)m * 16 + F.lane] = mine;
}
__device__ __forceinline__ void load_wf(Frame& F, int l, LAS float* wf) {
    const float* src = inptr<const float>(F, I_WIN) + (size_t)l * D * INW + NPROJ;
    for (int i = F.tid; i < D * 12; i += NWAVES * 64) { const int k = i / 12, j = i % 12; wf[i] = src[(size_t)k * INW + j]; }
    __syncthreads();
}

constexpr int APITCH = 64;
__device__ __forceinline__ size_t hm_off(int cs, int Hg, int b, int h) { return (size_t)NB * SEQ * cs + ((size_t)(b * Hg + h) * SEQ) * 64; }
namespace att {
typedef float f32x16 __attribute__((ext_vector_type(16)));
typedef short s16x4 __attribute__((ext_vector_type(4)));
typedef LAS unsigned char* lptr;
typedef float f32x2_t __attribute__((ext_vector_type(2))); typedef __bf16 bf16x2_t __attribute__((ext_vector_type(2)));
__device__ __forceinline__ unsigned cvtpk(float lo, float hi) { f32x2_t v = {lo, hi}; bf16x2_t b = __builtin_convertvector(v, bf16x2_t); return __builtin_bit_cast(unsigned, b); }
typedef short v4i16_t __attribute__((ext_vector_type(4)));
__device__ __forceinline__ s16x4 vtr(const LAS unsigned char* p) { return __builtin_bit_cast(s16x4, __builtin_amdgcn_ds_read_tr16_b64_v4i16((LAS v4i16_t*)p)); }
__device__ __forceinline__ int crow(int r, int hi) { return (r & 3) + 8 * (r >> 2) + 4 * hi; }
__device__ __forceinline__ float max3f(float a, float b, float c) { float r; asm("v_max3_f32 %0, %1, %2, %3" : "=v"(r) : "v"(a), "v"(b), "v"(c)); return r; }
__device__ __forceinline__ float max2f(float a, float b) { float r; asm("v_max_f32_e32 %0, %1, %2" : "=v"(r) : "v"(a), "v"(b)); return r; }
__device__ __forceinline__ float rowmax32(const f32x16& p0, const f32x16& p1) {
    float a = max3f(p0[0], p0[1], p1[0]), b = max3f(p0[2], p0[3], p1[1]); a = max3f(a, p1[2], p1[3]);
#pragma unroll
    for (int r = 4; r < 16; r += 4) { a = max3f(a, p0[r], p0[r + 1]); b = max3f(b, p0[r + 2], p0[r + 3]); a = max3f(a, p1[r], p1[r + 1]); b = max3f(b, p1[r + 2], p1[r + 3]); }
    return max2f(a, b);
}
__device__ __forceinline__ float rowmax16(const f32x16& p0) {
    float a = max3f(p0[0], p0[1], p0[2]), b = max3f(p0[3], p0[4], p0[5]);
    a = max3f(a, p0[6], p0[7]); b = max3f(b, p0[8], p0[9]); a = max3f(a, p0[10], p0[11]); b = max3f(b, p0[12], p0[13]); a = max3f(a, p0[14], p0[15]);
    return max2f(a, b);
}
__device__ __forceinline__ float pswap_max(float m) { auto rr = __builtin_amdgcn_permlane32_swap(__float_as_uint(m), __float_as_uint(m), false, false); return max2f(__uint_as_float(rr[0]), __uint_as_float(rr[1])); }

#define ATT_PACK8(P, B) __builtin_bit_cast(bf16x8, (v4u){cvtpk(P[B], P[B + 1]), cvtpk(P[B + 2], P[B + 3]), cvtpk(P[B + 4], P[B + 5]), cvtpk(P[B + 6], P[B + 7])})

template <int DHS>
__device__ __forceinline__ void pv_step(f32x16 (&o)[2], const LAS unsigned char* vb, int vsw, int s, bf16x8 pa) {
#pragma unroll
    for (int d0 = 0; d0 < 2; ++d0) {
        const s16x4 lo = vtr(vb + d0 * (DHS + vsw) + s * 1024), hi = vtr(vb + d0 * (DHS + vsw) + s * 1024 + 512);
        const bf16x8 vf = (bf16x8){lo[0], lo[1], lo[2], lo[3], hi[0], hi[1], hi[2], hi[3]};
        o[d0] = __builtin_amdgcn_mfma_f32_32x32x16_bf16(pa, vf, o[d0], 0, 0, 0);
    }
}
__device__ __forceinline__ void epilogue(const f32x16 (&o)[2], float linv_lane  , lptr wl, LAS float* wsf, const float* gn, unsigned char* orow0  ,
                                         int tok0, int tstride, int lane) {
    const int r32 = lane & 31, hi = lane >> 5;
    LAS float* stg = (LAS float*)wl;
#pragma unroll
    for (int r = 0; r < 16; ++r) { const int q = crow(r, hi); stg[q * 68 + r32] = o[0][r]; stg[q * 68 + 32 + r32] = o[1][r]; }
    if (hi == 0) wsf[r32] = linv_lane;
    LDS_WAIT(); asm volatile("" ::: "memory");
    const int row = lane >> 1, hf = lane & 1;
    const float li = wsf[row];
    f32x4 v[8]; float ss = 0.f;
#pragma unroll
    for (int i = 0; i < 8; ++i) { v[i] = *(const LAS f32x4*)(stg + row * 68 + hf * 32 + 4 * i) * li; ss += (v[i].x * v[i].x + v[i].y * v[i].y) + (v[i].z * v[i].z + v[i].w * v[i].w); }
    ss += __shfl_xor(ss, 1);
    const float rn = 1.0f / sqrtf(ss * (1.0f / 64.0f) + RMS_EPS);
    unsigned char* op = orow0 + (size_t)(tok0 + tstride * row) * D + hf * 32;
    const float rq = rn * 16.0f;
    unsigned wq[8];
#pragma unroll
    for (int i = 0; i < 4; ++i) { const f32x4 g0 = *(const GAS f32x4*)(gn + hf * 32 + 8 * i), g1 = *(const GAS f32x4*)(gn + hf * 32 + 8 * i + 4); const f32x4 a = v[2 * i] * rq * g0, b = v[2 * i + 1] * rq * g1;
        wq[2 * i] = pk4_fp8(a.x, a.y, a.z, a.w); wq[2 * i + 1] = pk4_fp8(b.x, b.y, b.z, b.w); }
    { v4u w0, w1; w0.x = wq[0]; w0.y = wq[1]; w0.z = wq[2]; w0.w = wq[3]; w1.x = wq[4]; w1.y = wq[5]; w1.z = wq[6]; w1.w = wq[7]; *(GAS v4u*)(op) = w0; *(GAS v4u*)(op + 16) = w1; }
    LDS_WAIT(); asm volatile("" ::: "memory");
}

__device__ __forceinline__ void qk64(f32x16& p0, f32x16& p1, const bf16x8 (&qr)[4], const LAS unsigned char* kf, const f32x16& c0, const f32x16& c1) {
    p0 = c0; p1 = c1;
#pragma unroll
    for (int d0 = 0; d0 < 4; ++d0) { const bf16x8 k0 = *(const LAS bf16x8*)(kf + d0 * 2048), k1 = *(const LAS bf16x8*)(kf + d0 * 2048 + 512);
        p0 = __builtin_amdgcn_mfma_f32_32x32x16_bf16(k0, qr[d0], p0, 0, 0, 0); p1 = __builtin_amdgcn_mfma_f32_32x32x16_bf16(k1, qr[d0], p1, 0, 0, 0); }
}
__device__ __forceinline__ void load_kf64(bf16x8 (&kf)[8], const LAS unsigned char* kt, int r32, int hi) {
#pragma unroll
    for (int d0 = 0; d0 < 4; ++d0) { const int ch = 2 * d0 + hi; const LAS unsigned char* p = kt + ch * 1024 + ((r32 ^ ch) << 4); kf[2 * d0] = *(const LAS bf16x8*)p; kf[2 * d0 + 1] = *(const LAS bf16x8*)(p + 512); }
}
template <bool ZC>
__device__ __forceinline__ void qk64_regs(f32x16& p0, f32x16& p1, const bf16x8 (&qr)[4], const bf16x8 (&kf)[8], const f32x16& c0, const f32x16& c1) {
    if (ZC) { p0 = f32x16{}; p1 = f32x16{}; } else { p0 = c0; p1 = c1; }
#pragma unroll
    for (int d0 = 0; d0 < 4; ++d0) { p0 = __builtin_amdgcn_mfma_f32_32x32x16_bf16(kf[2 * d0], qr[d0], p0, 0, 0, 0); p1 = __builtin_amdgcn_mfma_f32_32x32x16_bf16(kf[2 * d0 + 1], qr[d0], p1, 0, 0, 0); }
}
__device__ __forceinline__ void load_vf64(bf16x8 (&vf)[8], const LAS unsigned char* vb) {
#pragma unroll
    for (int s = 0; s < 4; ++s)
#pragma unroll
        for (int d0 = 0; d0 < 2; ++d0) { const s16x4 lo = vtr(vb + d0 * 4096 + s * 1024), hi = vtr(vb + d0 * 4096 + s * 1024 + 512);
            vf[2 * s + d0] = (bf16x8){lo[0], lo[1], lo[2], lo[3], hi[0], hi[1], hi[2], hi[3]}; }
}
__device__ __forceinline__ void rescale_o(f32x16 (&o)[2], float alpha, LAS float* wsf, int r32, int hi) {
    if (hi == 0) wsf[r32] = alpha;
    LDS_WAIT(); asm volatile("" ::: "memory");
#pragma unroll
    for (int j = 0; j < 4; ++j) { const f32x4 a = *(const LAS f32x4*)(wsf + 8 * j + 4 * hi);
#pragma unroll
        for (int e = 0; e < 4; ++e) { o[0][4 * j + e] *= a[e]; o[1][4 * j + e] *= a[e]; } }
    LDS_WAIT(); asm volatile("" ::: "memory");
}
constexpr float RESC_THR = 8.0f;

__device__ __forceinline__ void fox_softmax(f32x16& p0, f32x16& p1, f32x16 (&o)[2], float& mrun, float& lrun, int kv0, int qtok, bool diag, LAS float* wsf, int r32, int hi) {
    if (__builtin_amdgcn_readfirstlane((int)diag)) {
#pragma unroll
        for (int r = 0; r < 16; ++r) { const int kv = kv0 + (r & 3) + 8 * (r >> 2); if (kv > qtok) p0[r] = -INFINITY; if (kv + 32 > qtok) p1[r] = -INFINITY; } }
    float mt = pswap_max(rowmax32(p0, p1));
    if (__any(mt > mrun + RESC_THR)) { const float mnew = max2f(mrun, mt), alpha = __builtin_amdgcn_exp2f(mrun - mnew); mrun = mnew; lrun *= alpha; rescale_o(o, alpha, wsf, r32, hi); }
    float rs = 0.f;
#pragma unroll
    for (int r = 0; r < 16; ++r) { p0[r] = __builtin_amdgcn_exp2f(p0[r] - mrun); p1[r] = __builtin_amdgcn_exp2f(p1[r] - mrun); rs += p0[r] + p1[r]; }
    lrun += rs;
}
__device__ __forceinline__ void sb_weights(f32x16& p0, f32x16& p1, float& R, int kv0, int qtok, bool diag, int hi) {
    float run = 1.f;
#pragma unroll
    for (int hh = 1; hh >= 0; --hh)
#pragma unroll
        for (int j = 3; j >= 0; --j) {
            float kk[4], bb[4];
#pragma unroll
            for (int e = 0; e < 4; ++e) { const float y = hh ? p1[4 * j + e] : p0[4 * j + e]; float yc; asm("v_min_f32_e32 %0, 0x42a00000, %1" : "=v"(yc) : "v"(y)); const float ex = __builtin_amdgcn_exp2f(yc); kk[e] = __builtin_amdgcn_rcpf(1.0f + ex); bb[e] = ex * kk[e];
                if (diag) { const int kv = kv0 + 32 * hh + 8 * j + e; if (kv >= qtok) { kk[e] = 1.f; bb[e] = 0.f; } } }
            const float s2 = kk[3], s1 = kk[3] * kk[2], s0 = s1 * kk[1], Gp = s0 * kk[0];
            auto rr = __builtin_amdgcn_permlane32_swap(__float_as_uint(Gp), __float_as_uint(Gp), false, false);
            const float ga = __uint_as_float(rr[0]), gb = __uint_as_float(rr[1]);
            const float after = R * run * (hi ? 1.0f : gb);
            if (hh) { p1[4 * j] = bb[0] * after * s0; p1[4 * j + 1] = bb[1] * after * s1; p1[4 * j + 2] = bb[2] * after * s2; p1[4 * j + 3] = bb[3] * after; }
            else { p0[4 * j] = bb[0] * after * s0; p0[4 * j + 1] = bb[1] * after * s1; p0[4 * j + 2] = bb[2] * after * s2; p0[4 * j + 3] = bb[3] * after; }
            run *= ga * gb;
        }
    R *= run;
}

template <int TYPE>
__device__ __forceinline__ void causal_wg_unit(const bf16* proj, const float* cum2, const float* gn, unsigned char* obuf, int b, int h, int qb, LAS unsigned char* kvbuf, LAS float* ncum, lptr wl, LAS float* wsf, int tid, int wave) {
    const int lane = tid & 63, r32 = lane & 31, hi = lane >> 5;
    constexpr int QC = TYPE == 0 ? QCOL_SB : QCOL_FX, KC = TYPE == 0 ? KCOL_SB : KCOL_FX, VC = TYPE == 0 ? VCOL_SB : VCOL_FX;
    constexpr int HG = TYPE == 0 ? 8 : 12;
    const bf16* Qp = proj + hm_off(QC, HG, b, h); const bf16* Kp = proj + hm_off(KC, HG, b, h); const bf16* Vp = proj + hm_off(VC, HG, b, h);
    const int qt = 8 * qb + wave, qtok = 32 * qt + r32;
    bf16x8 qr[4];
#pragma unroll
    for (int d0 = 0; d0 < 4; ++d0) qr[d0] = *(const GAS bf16x8*)(Qp + (size_t)qtok * APITCH + d0 * 16 + hi * 8);
    const int NT = 4 * qb + 4, my_tlast = qt >> 1;
    const unsigned lvoff = (unsigned)(((tid >> 3) * APITCH + (tid & 7) * 8) * 2);
    const int skey = tid >> 3, sch = tid & 7;
    const int kst = sch * 1024 + ((skey ^ sch) << 4), vst = 8192 + (sch >> 2) * 4096 + ((skey ^ (sch >> 2)) << 6) + (sch & 3) * 16;
    v4u kreg, vreg;
#define ATT_TILE(s_) (TYPE == 0 ? NT - 1 - (s_) : (s_))
#define ATT_LOAD(t) do { kreg = *(const GAS v4u*)((const char*)(Kp + (size_t)(64 * (t)) * APITCH) + lvoff); vreg = *(const GAS v4u*)((const char*)(Vp + (size_t)(64 * (t)) * APITCH) + lvoff); } while (0)
#define ATT_STORE(slot) do { *(LAS v4u*)(kvbuf + (slot) * 16384 + kst) = kreg; *(LAS v4u*)(kvbuf + (slot) * 16384 + vst) = vreg; } while (0)
    if (TYPE == 1) { const int n = 256 * (qb + 1); if (4 * tid < n) { const f32x4 c = *(const GAS f32x4*)(cum2 + 4 * tid); v4u w;
#pragma unroll
        for (int e = 0; e < 4; ++e) { const float v = -c[e]; const unsigned hb = f2bf(v); const unsigned lb = f2bf(v - __builtin_bit_cast(float, hb << 16)); w[e] = hb | (lb << 16); }
        *(LAS v4u*)(ncum + 4 * tid) = w; } }
    const bf16x8 qone = hi ? (bf16x8){0, 0, 0, 0, 0, 0, 0, 0} : (bf16x8){(short)0x3f80, (short)0x3f80, 0, 0, 0, 0, 0, 0};
    f32x16 o[2]; o[0] = f32x16{}; o[1] = f32x16{};
    float mrun = -1e30f, lrun = 0.f, R = 1.f;
    const int vbo = 8192 + ((lane >> 4) & 1) * 32 + (lane & 3) * 8 + (4 * hi + ((lane & 15) >> 2)) * 64, vsw = ((lane >> 2) & 1) ? -64 : 64;
    ATT_LOAD(ATT_TILE(0)); ATT_STORE(0);
    ATT_LOAD(ATT_TILE(1)); ATT_STORE(1);
    __syncthreads();
    f32x16 pc0 = f32x16{}, pc1 = f32x16{}, pn0 = f32x16{}, pn1 = f32x16{};
#define ATT_QK(P0, P1, s_) do { const int t_ = ATT_TILE(s_); const LAS unsigned char* kb_ = kvbuf + ((s_) % 3) * 16384; \
        if (TYPE == 1) { const LAS unsigned* cw_ = (const LAS unsigned*)ncum + 64 * t_ + r32; const unsigned w0_ = hi ? 0u : cw_[0], w1_ = hi ? 0u : cw_[32]; \
            const bf16x8 ka_ = __builtin_bit_cast(bf16x8, (v4u){w0_, 0u, 0u, 0u}), kb2_ = __builtin_bit_cast(bf16x8, (v4u){w1_, 0u, 0u, 0u}); \
            bf16x8 kf_[8]; load_kf64(kf_, kb_, r32, hi); \
            f32x16 c0_ = __builtin_amdgcn_mfma_f32_32x32x16_bf16(ka_, qone, f32x16{}, 0, 0, 0), c1_ = __builtin_amdgcn_mfma_f32_32x32x16_bf16(kb2_, qone, f32x16{}, 0, 0, 0); \
            qk64_regs<false>(P0, P1, qr, kf_, c0_, c1_); } \
        else { bf16x8 kf_[8]; load_kf64(kf_, kb_, r32, hi); qk64_regs<true>(P0, P1, qr, kf_, P0, P1); } } while (0)
    if (ATT_TILE(0) <= my_tlast) ATT_QK(pc0, pc1, 0);
    constexpr float SB_DEAD = 1e-30f;
    bool dead = false;
    LAS int* aflag = (LAS int*)ncum;
    for (int s = 0; s < NT; ++s) {
        const int t = ATT_TILE(s);
        if (s + 2 < NT) ATT_LOAD(ATT_TILE(s + 2));
        const bool act = !dead && t <= my_tlast, actn = !dead && (s + 1 < NT) && (ATT_TILE(s + 1) <= my_tlast);
        if (actn) ATT_QK(pn0, pn1, s + 1);
        if (act) {
            const int kv0 = 64 * t + 4 * hi; const bool diag = (t == my_tlast);
            if (TYPE == 1) fox_softmax(pc0, pc1, o, mrun, lrun, kv0, qtok, diag, wsf, r32, hi);
            else sb_weights(pc0, pc1, R, kv0, qtok, diag, hi);
            const bf16x8 pa0 = ATT_PACK8(pc0, 0), pa1 = ATT_PACK8(pc0, 8), pa2 = ATT_PACK8(pc1, 0), pa3 = ATT_PACK8(pc1, 8);
            const LAS unsigned char* vb = kvbuf + (s % 3) * 16384 + vbo;
            pv_step<4096>(o, vb, vsw, 0, pa0); pv_step<4096>(o, vb, vsw, 1, pa1); pv_step<4096>(o, vb, vsw, 2, pa2); pv_step<4096>(o, vb, vsw, 3, pa3);
        }
        if (s + 2 < NT) ATT_STORE((s + 2) % 3);
        if (TYPE == 0) { if (act && !__any(R >= SB_DEAD)) dead = true; if (lane == 0) aflag[(s & 1) * 8 + wave] = dead ? 0 : 1; }
        __syncthreads();
        if (TYPE == 0) { const v4u f0 = *(const LAS v4u*)(aflag + (s & 1) * 8), f1 = *(const LAS v4u*)(aflag + (s & 1) * 8 + 4);
            if (((f0.x | f0.y) | (f0.z | f0.w) | (f1.x | f1.y) | (f1.z | f1.w)) == 0u) break; }
        pc0 = pn0; pc1 = pn1;
    }
#undef ATT_QK
#undef ATT_TILE
#undef ATT_LOAD
#undef ATT_STORE
    float linv = 1.0f;
    if (TYPE == 1) { auto rr = __builtin_amdgcn_permlane32_swap(__float_as_uint(lrun), __float_as_uint(lrun), false, false); linv = 1.0f / (__uint_as_float(rr[0]) + __uint_as_float(rr[1])); }
    const int headcol = TYPE == 0 ? h : 8 + h;
    epilogue(o, linv, wl, wsf, gn + headcol * 64, obuf + (size_t)b * SEQ * D + headcol * 64, 32 * qt, 1, lane);
}

__device__ __forceinline__ void qk32(f32x16& p0, const bf16x8 (&qr)[4], const LAS unsigned char* kt, int r32, int hi) {
    p0 = f32x16{};
#pragma unroll
    for (int d0 = 0; d0 < 4; ++d0) { const int ch = 2 * d0 + hi; const bf16x8 k0 = *(const LAS bf16x8*)(kt + ch * 512 + ((r32 ^ ch) << 4)); p0 = __builtin_amdgcn_mfma_f32_32x32x16_bf16(k0, qr[d0], p0, 0, 0, 0); }
}
__device__ __forceinline__ void dil_softmax_pv(f32x16& p0, f32x16 (&o)[2], float& mrun, float& lrun, const LAS unsigned char* vb, int vsw, int jq, int jb, LAS float* wsf, int r32, int hi) {
#pragma unroll
    for (int r = 0; r < 16; ++r) { const int dist = jq - (jb + (r & 3) + 8 * (r >> 2)); if ((unsigned)dist > 128u) p0[r] = -INFINITY; }
    float mt = pswap_max(rowmax16(p0));
    if (__any(mt > mrun + RESC_THR)) { const float mnew = max2f(mrun, mt), alpha = __builtin_amdgcn_exp2f(mrun - mnew); mrun = mnew; lrun *= alpha; rescale_o(o, alpha, wsf, r32, hi); }
    float rs = 0.f;
#pragma unroll
    for (int r = 0; r < 16; ++r) { p0[r] = __builtin_amdgcn_exp2f(p0[r] - mrun); rs += p0[r]; }
    lrun += rs;
    const bf16x8 pa0 = ATT_PACK8(p0, 0), pa1 = ATT_PACK8(p0, 8);
    pv_step<2048>(o, vb, vsw, 0, pa0); pv_step<2048>(o, vb, vsw, 1, pa1);
}
#define DILP_LOAD(sh_, rst_, tt_) do { const unsigned lvo_ = (unsigned)((((lane >> 3) << (sh_)) * APITCH + (lane & 7) * 8) * 2); const size_t tok0_ = (size_t)((rst_) + ((32 * (tt_)) << (sh_))); \
        const char* kb_ = (const char*)(Kp + tok0_ * APITCH); const char* vb_ = (const char*)(Vp + tok0_ * APITCH); const size_t is_ = (size_t)(8 << (sh_)) * APITCH * 2; \
        _Pragma("unroll") for (int i = 0; i < 4; ++i) { kreg[i] = *(const GAS v4u*)(kb_ + i * is_ + lvo_); vreg[i] = *(const GAS v4u*)(vb_ + i * is_ + lvo_); } } while (0)
#define DILP_STORE() do { _Pragma("unroll") for (int i = 0; i < 4; ++i) { const int id = lane + 64 * i, key = id >> 3, ch = id & 7; \
        *(LAS v4u*)(wl + ch * 512 + ((key ^ ch) << 4)) = kreg[i]; *(LAS v4u*)(wl + 4096 + (ch >> 2) * 2048 + ((key ^ (ch >> 2)) << 6) + (ch & 3) * 16) = vreg[i]; } } while (0)
__device__ __forceinline__ void dil_a_unit(const bf16* proj, bf16* SO, float* SM, gu32* done, int b, int h, int qb, lptr wl, LAS float* wsf, int tid, int wave) {
    const int lane = tid & 63, r32 = lane & 31, hi = lane >> 5;
    const bf16* Qp = proj + hm_off(QCOL_DL, 12, b, h); const bf16* Kp = proj + hm_off(KCOL_DL, 12, b, h); const bf16* Vp = proj + hm_off(VCOL_DL, 12, b, h);
    const int qt = 8 * qb + wave, qtok = 32 * qt + r32;
    bf16x8 qr[4];
#pragma unroll
    for (int d0 = 0; d0 < 4; ++d0) qr[d0] = *(const GAS bf16x8*)(Qp + (size_t)qtok * APITCH + d0 * 16 + hi * 8);
    f32x16 o[2]; o[0] = f32x16{}; o[1] = f32x16{};
    float mrun = -1e30f, lrun = 0.f;
    const int vbo = 4096 + ((lane >> 4) & 1) * 32 + (lane & 3) * 8 + (4 * hi + ((lane & 15) >> 2)) * 64, vsw = ((lane >> 2) & 1) ? -64 : 64;
    v4u kreg[4], vreg[4];
    int tt = qt > 4 ? qt - 4 : 0;
    DILP_LOAD(0, 0, tt);
    for (;;) {
        DILP_STORE();
        const int jb = 32 * tt + 4 * hi; const bool more = tt < qt;
        if (more) { ++tt; DILP_LOAD(0, 0, tt); }
        f32x16 p0; qk32(p0, qr, wl, r32, hi);
        dil_softmax_pv(p0, o, mrun, lrun, wl + vbo, vsw, qtok, jb, wsf, r32, hi);
        if (!more) break;
    }
    { auto rr = __builtin_amdgcn_permlane32_swap(__float_as_uint(lrun), __float_as_uint(lrun), false, false); lrun = __uint_as_float(rr[0]) + __uint_as_float(rr[1]); }
    const size_t srow0 = ((size_t)(b * 12 + h) * SEQ + 32 * qt);
    if (hi == 0) __hip_atomic_store((unsigned long long*)(SM + (srow0 + r32) * 2), ((unsigned long long)__float_as_uint(lrun) << 32) | __float_as_uint(mrun), RLX_AGENT);
    LAS float* stg = (LAS float*)wl;
#pragma unroll
    for (int r = 0; r < 16; ++r) { const int q = crow(r, hi); stg[q * 68 + r32] = o[0][r]; stg[q * 68 + 32 + r32] = o[1][r]; }
    LDS_WAIT(); asm volatile("" ::: "memory");
    { const int row = lane >> 1, hf = lane & 1; bf16* op = SO + (srow0 + row) * 64 + hf * 32;
#pragma unroll
      for (int i = 0; i < 4; ++i) { const f32x4 a = *(const LAS f32x4*)(stg + row * 68 + hf * 32 + 8 * i), c = *(const LAS f32x4*)(stg + row * 68 + hf * 32 + 8 * i + 4);
          v4u w; w.x = pk2(a.x, a.y); w.y = pk2(a.z, a.w); w.z = pk2(c.x, c.y); w.w = pk2(c.z, c.w);
          asm volatile("global_store_dwordx4 %0, %1, off sc1" :: "v"(op + 8 * i), "v"(w) : "memory"); } }
    LDS_WAIT();
    asm volatile("s_waitcnt vmcnt(0)" ::: "memory");
    __syncthreads();
    if (tid == 0) __hip_atomic_fetch_add(done, 1u, RLX_AGENT);
}
__device__ __forceinline__ void dil_b_unit(const bf16* proj, const bf16* SO, const float* SM, gu32* done, gu32* tmo, const float* gn, unsigned char* obuf, int b, int h, int blk, int half, lptr wl, LAS float* wsf, int tid, int wave) {
    const int lane = tid & 63, r32 = lane & 31, hi = lane >> 5, r16 = 8 * half + wave;
    if (tid == 0) { unsigned sp = 0; while (__hip_atomic_load(done, RLX_AGENT) < 2u) { __builtin_amdgcn_s_sleep(2); if (++sp > (1u << 22)) { __hip_atomic_store(tmo, 1u, RLX_AGENT); break; } }
        __builtin_amdgcn_fence(__ATOMIC_ACQUIRE, "agent"); asm volatile("s_waitcnt vmcnt(0)" ::: "memory"); }
    __syncthreads();
    const bf16* Qp = proj + hm_off(QCOL_DL, 12, b, h); const bf16* Kp = proj + hm_off(KCOL_DL, 12, b, h); const bf16* Vp = proj + hm_off(VCOL_DL, 12, b, h);
    const int p0tok = 512 * blk + r16;
    bf16x8 qr[4];
#pragma unroll
    for (int d0 = 0; d0 < 4; ++d0) qr[d0] = *(const GAS bf16x8*)(Qp + (size_t)(p0tok + 16 * r32) * APITCH + d0 * 16 + hi * 8);
    const size_t srow0 = (size_t)(b * 12 + h) * SEQ + p0tok;
    const f32x2_t ml = *(const GAS f32x2_t*)(SM + (srow0 + 16 * r32) * 2);
    float mrun = ml.x, lrun = hi ? 0.f : ml.y;
    f32x16 o[2];
    { LAS float* stg = (LAS float*)wl; const int row = lane >> 1, hf = lane & 1; const bf16* ip = SO + (srow0 + 16 * row) * 64 + hf * 32;
#pragma unroll
      for (int i = 0; i < 4; ++i) { const v4u w = *(const GAS v4u*)(ip + 8 * i);
          *(LAS f32x4*)(stg + row * 68 + hf * 32 + 8 * i) = (f32x4){bflo(w.x), bfhi(w.x), bflo(w.y), bfhi(w.y)}; *(LAS f32x4*)(stg + row * 68 + hf * 32 + 8 * i + 4) = (f32x4){bflo(w.z), bfhi(w.z), bflo(w.w), bfhi(w.w)}; }
      LDS_WAIT(); asm volatile("" ::: "memory");
#pragma unroll
      for (int r = 0; r < 16; ++r) { const int q = crow(r, hi); o[0][r] = stg[q * 68 + r32]; o[1][r] = stg[q * 68 + 32 + r32]; }
      LDS_WAIT(); asm volatile("" ::: "memory"); }
    const int vbo = 4096 + ((lane >> 4) & 1) * 32 + (lane & 3) * 8 + (4 * hi + ((lane & 15) >> 2)) * 64, vsw = ((lane >> 2) & 1) ? -64 : 64;
    {
        int sh = 2, rst = r16 & 3, jq0 = (p0tok - rst) >> 2, dj = 4;
        int tt = (jq0 > 128 ? jq0 - 128 : 0) >> 5, thi = (jq0 + dj * 31) >> 5;
        v4u kreg[4], vreg[4];
        DILP_LOAD(sh, rst, tt);
        for (;;) {
            DILP_STORE();
            const int jq = jq0 + dj * r32, jb = 32 * tt + 4 * hi;
            bool more = true;
            if (tt < thi) ++tt;
            else if (sh == 2) { sh = 4; rst = r16; jq0 = (p0tok - rst) >> 4; dj = 1; tt = (jq0 > 128 ? jq0 - 128 : 0) >> 5; thi = (jq0 + 31) >> 5; }
            else more = false;
            if (more) DILP_LOAD(sh, rst, tt);
            f32x16 p0; qk32(p0, qr, wl, r32, hi);
            dil_softmax_pv(p0, o, mrun, lrun, wl + vbo, vsw, jq, jb, wsf, r32, hi);
            if (!more) break;
        }
    }
    auto rr = __builtin_amdgcn_permlane32_swap(__float_as_uint(lrun), __float_as_uint(lrun), false, false);
    const float linv = 1.0f / (__uint_as_float(rr[0]) + __uint_as_float(rr[1]));
    epilogue(o, linv, wl, wsf, gn + (20 + h) * 64, obuf + (size_t)b * SEQ * D + (20 + h) * 64, p0tok, 16, lane);
}
__device__ __forceinline__ void sb_wave_unit(const bf16* proj, const float* gn, unsigned char* obuf, int b, int h, int qt, lptr wl, LAS float* wsf, int lane) {
    const int r32 = lane & 31, hi = lane >> 5;
    const bf16* Qp = proj + hm_off(QCOL_SB, 8, b, h); const bf16* Kp = proj + hm_off(KCOL_SB, 8, b, h); const bf16* Vp = proj + hm_off(VCOL_SB, 8, b, h);
    const int qtok = 32 * qt + r32;
    bf16x8 qr[4];
#pragma unroll
    for (int d0 = 0; d0 < 4; ++d0) qr[d0] = *(const GAS bf16x8*)(Qp + (size_t)qtok * APITCH + d0 * 16 + hi * 8);
    f32x16 o[2]; o[0] = f32x16{}; o[1] = f32x16{};
    float R = 1.f;
    const int vbo = 4096 + ((lane >> 4) & 1) * 32 + (lane & 3) * 8 + (4 * hi + ((lane & 15) >> 2)) * 64, vsw = ((lane >> 2) & 1) ? -64 : 64;
    v4u kreg[4], vreg[4];
    int tt = qt;
    DILP_LOAD(0, 0, tt);
    for (;;) {
        DILP_STORE();
        const int kv0 = 32 * tt + 4 * hi; const bool diag = (tt == qt), more = tt > 0;
        if (more) { DILP_LOAD(0, 0, tt - 1); }
        f32x16 p0; qk32(p0, qr, wl, r32, hi);
        asm volatile("s_nop 15\n\ts_nop 7" : "+v"(p0));
        float run = 1.f;
#pragma unroll
        for (int j = 3; j >= 0; --j) {
            float kk[4], bb[4];
#pragma unroll
            for (int e = 0; e < 4; ++e) { float yc; asm("v_min_f32_e32 %0, 0x42a00000, %1" : "=v"(yc) : "v"(p0[4 * j + e])); const float ex = __builtin_amdgcn_exp2f(yc); kk[e] = __builtin_amdgcn_rcpf(1.0f + ex); bb[e] = ex * kk[e];
                if (diag) { const int kv = kv0 + 8 * j + e; if (kv >= qtok) { kk[e] = 1.f; bb[e] = 0.f; } } }
            const float s2 = kk[3], s1 = kk[3] * kk[2], s0 = s1 * kk[1], Gp = s0 * kk[0];
            auto rr = __builtin_amdgcn_permlane32_swap(__float_as_uint(Gp), __float_as_uint(Gp), false, false);
            const float ga = __uint_as_float(rr[0]), gb = __uint_as_float(rr[1]);
            const float after = R * run * (hi ? 1.0f : gb);
            p0[4 * j] = bb[0] * after * s0; p0[4 * j + 1] = bb[1] * after * s1; p0[4 * j + 2] = bb[2] * after * s2; p0[4 * j + 3] = bb[3] * after;
            run *= ga * gb;
        }
        R *= run;
        const bf16x8 pa0 = ATT_PACK8(p0, 0), pa1 = ATT_PACK8(p0, 8);
        pv_step<2048>(o, wl + vbo, vsw, 0, pa0); pv_step<2048>(o, wl + vbo, vsw, 1, pa1);
        if (!more || !__any(R >= 1e-30f)) break;
        --tt;
    }
    epilogue(o, 1.0f, wl, wsf, gn + h * 64, obuf + (size_t)b * SEQ * D + h * 64, 32 * qt, 1, lane);
}
#undef DILP_LOAD
#undef DILP_STORE
#undef ATT_PACK8
}

using pg8::Unit; using pg8::HALF; using pg8::BM; using pg8::cvt_pk_bf16;
struct EpiProj {
    static constexpr bool PERM = true;
    bf16* O; const float* tab;
    __device__ __forceinline__ bf16* dst(int row, int c) const {
        const int cs = c < 1536 ? (c >> 9) << 9 : 1536 + ((c - 1536) / 768) * 768, Hg = c < 1536 ? 8 : 12;
        const int hl = (c - cs) >> 6, d = c & 63, b = row >> 11, sq = row & 2047;
        return O + (size_t)NB * SEQ * cs + ((size_t)(b * Hg + hl) * SEQ + sq) * 64 + d;
    }
    __device__ __forceinline__ void operator()(const f32x4 (&acc)[2][2][4][2], const Unit& u, int wr, int wc, int fr, int fq) const {
        const int row0 = u.pm * BM + wr * 64 + fr, pn = u.pn;
        const bool isq = (pn < 2) || (pn >= 6 && pn < 9) || (pn >= 15 && pn < 18);
        const float sc = isq ? C2 : 1.0f;
        if (pn >= 15 && pn < 21) {
            const int col = pn * 256 + wc * 64 + 8 * fq;
            f32x4 tn[4];
            { const float* tr = tab + (size_t)row0 * 64 + 8 * fq; tn[0] = *(const GAS f32x4*)(tr); tn[1] = *(const GAS f32x4*)(tr + 4); tn[2] = *(const GAS f32x4*)(tr + 32); tn[3] = *(const GAS f32x4*)(tr + 36); }
#pragma unroll
            for (int ai = 0; ai < 2; ++ai)
#pragma unroll
                for (int m = 0; m < 4; ++m) { const int row = row0 + ai * HALF + m * 16;
                    const f32x4 c0 = tn[0], c1 = tn[1], s0 = tn[2], s1 = tn[3];
                    if (ai * 4 + m < 7) { const int rown = row0 + ((ai * 4 + m + 1) >> 2) * HALF + ((ai * 4 + m + 1) & 3) * 16; const float* tr = tab + (size_t)rown * 64 + 8 * fq;
                        tn[0] = *(const GAS f32x4*)(tr); tn[1] = *(const GAS f32x4*)(tr + 4); tn[2] = *(const GAS f32x4*)(tr + 32); tn[3] = *(const GAS f32x4*)(tr + 36); }
                    const f32x4 a0 = acc[ai][0][m][0] * sc, a1 = acc[ai][0][m][1] * sc, b0 = acc[ai][1][m][0] * sc, b1 = acc[ai][1][m][1] * sc;
                    const f32x4 l0 = a0 * c0 - b0 * s0, l1 = a1 * c1 - b1 * s1, h0 = a0 * s0 + b0 * c0, h1 = a1 * s1 + b1 * c1;
                    pg8::u32x4 wl, wh; wl.x = cvt_pk_bf16(l0[0], l0[1]); wl.y = cvt_pk_bf16(l0[2], l0[3]); wl.z = cvt_pk_bf16(l1[0], l1[1]); wl.w = cvt_pk_bf16(l1[2], l1[3]);
                    wh.x = cvt_pk_bf16(h0[0], h0[1]); wh.y = cvt_pk_bf16(h0[2], h0[3]); wh.z = cvt_pk_bf16(h1[0], h1[1]); wh.w = cvt_pk_bf16(h1[2], h1[3]);
                    bf16* rp = dst(row, col); *(pg8::u32x4*)rp = wl; *(pg8::u32x4*)(rp + 32) = wh;
                    asm volatile("" ::: "memory"); }
        } else {
            const int col0 = pn * 256 + wc * 32 + 8 * fq;
#pragma unroll
            for (int ai = 0; ai < 2; ++ai)
#pragma unroll
                for (int m = 0; m < 4; ++m) { const int row = row0 + ai * HALF + m * 16;
#pragma unroll
                    for (int bj = 0; bj < 2; ++bj) { const f32x4 v0 = acc[ai][bj][m][0] * sc, v1 = acc[ai][bj][m][1] * sc;
                        pg8::u32x4 w; w.x = cvt_pk_bf16(v0[0], v0[1]); w.y = cvt_pk_bf16(v0[2], v0[3]); w.z = cvt_pk_bf16(v1[0], v1[1]); w.w = cvt_pk_bf16(v1[2], v1[3]);
                        *(pg8::u32x4*)dst(row, col0 + bj * HALF) = w; } }
        }
    }
};
struct EpiMix {
    static constexpr bool PERM = true;
    bf16* O;
    __device__ __forceinline__ void operator()(const f32x4 (&acc)[2][2][4][2], const Unit& u, int wr, int wc, int fr, int fq) const {
        const int row0 = u.pm * BM + wr * 64 + fr, col0 = u.pn * BM + wc * 32 + 8 * fq;
#pragma unroll
        for (int ai = 0; ai < 2; ++ai)
#pragma unroll
            for (int m = 0; m < 4; ++m) { bf16* rowp = O + (size_t)(row0 + ai * HALF + m * 16) * D + col0;
#pragma unroll
                for (int bj = 0; bj < 2; ++bj) { const f32x4 v0 = acc[ai][bj][m][0], v1 = acc[ai][bj][m][1];
                    pg8::u32x4 w; w.x = cvt_pk_bf16(v0[0], v0[1]); w.y = cvt_pk_bf16(v0[2], v0[3]); w.z = cvt_pk_bf16(v1[0], v1[1]); w.w = cvt_pk_bf16(v1[2], v1[3]);
                    *(pg8::u32x4*)(rowp + bj * HALF) = w; } }
    }
};
struct EpiSwiglu {
    static constexpr bool PERM = true;
    unsigned char* O;
    __device__ __forceinline__ void operator()(const f32x4 (&acc)[2][2][4][2], const Unit& u, int wr, int wc, int fr, int fq) const {
        const int row0 = u.pm * BM + wr * 64 + fr, col0 = (u.pn & 3) * 128 + wc * 32 + 8 * fq;
#pragma unroll
        for (int ai = 0; ai < 2; ++ai)
#pragma unroll
            for (int m = 0; m < 4; ++m) { float r[8];
#pragma unroll
                for (int n = 0; n < 2; ++n)
#pragma unroll
                    for (int e = 0; e < 4; ++e) { const float g = acc[ai][0][m][n][e], up = acc[ai][1][m][n][e]; r[4 * n + e] = g * __builtin_amdgcn_rcpf(1.0f + __builtin_amdgcn_exp2f(-g * LOG2E)) * up * (float)(1 << ASHIFT); }
                v2u w; w.x = pk4_fp8(r[0], r[1], r[2], r[3]); w.y = pk4_fp8(r[4], r[5], r[6], r[7]);
                *(v2u*)(O + (size_t)(row0 + ai * HALF + m * 16) * EH + col0) = w; }
    }
};
struct EpiDown {
    static constexpr bool PERM = true;
    unsigned char* O;
    const LAS int* tileE; const LAS int* tb; const LAS int* cnt; const int* list2;
    __device__ __forceinline__ void operator()(const f32x4 (&acc)[2][2][4][2], const Unit& u, int wr, int wc, int fr, int fq) const {
        const int col0 = (u.pn & 7) * 256 + wc * 64 + 16 * fq;
        const int e = tileE[u.pm], lbase = (u.pm - tb[e]) * 256 + wr * 64 + fr, ce = cnt[e];
        const float ysc = (float)(1 << YSHIFT);
        int drow[2][4];
#pragma unroll
        for (int ai = 0; ai < 2; ++ai)
#pragma unroll
            for (int m = 0; m < 4; ++m) { const int local = lbase + ai * HALF + m * 16; drow[ai][m] = (e >= NE) ? (local * 7 + 6) : ((local < ce) ? list2[(size_t)e * LISTCAP + local] : 7 * T); }
#pragma unroll
        for (int ai = 0; ai < 2; ++ai)
#pragma unroll
            for (int m = 0; m < 4; ++m) { unsigned char* rowp = O + (size_t)drow[ai][m] * D + col0;
                const f32x4 a0 = acc[ai][0][m][0] * ysc, a1 = acc[ai][0][m][1] * ysc, b0 = acc[ai][1][m][0] * ysc, b1 = acc[ai][1][m][1] * ysc;
                v4u w; w.x = pk4_fp8(a0[0], a0[1], a0[2], a0[3]); w.y = pk4_fp8(a1[0], a1[1], a1[2], a1[3]); w.z = pk4_fp8(b0[0], b0[1], b0[2], b0[3]); w.w = pk4_fp8(b1[0], b1[1], b1[2], b1[3]);
                *(v4u*)rowp = w; }
    }
};
template <bool GATHER_, int NT>
struct MoeOrder {
    static constexpr bool GATHER = GATHER_;
    int G, c, nunits; const LAS int* tileE; const LAS int* tb; const LAS int* cnt; const int* list; unsigned K2;
    __device__ __forceinline__ bool next(int i, Unit& u) const {
        const int v = ((G & 7) == 0) ? (c & 7) * (G >> 3) + (c >> 3) : c;
        const int L = i * G + v; if (L >= nunits) return false;
        const int pm = L / NT, pl = L % NT; u.pm = pm; u.pn = tileE[pm] * NT + pl; return true;
    }
    __device__ __forceinline__ unsigned tok_off(const Unit& u, int r) const {
        const int e = tileE[u.pm], local = (u.pm - tb[e]) * 256 + r;
        int tok = local;
        if (e < NE) tok = (local < cnt[e]) ? list[(size_t)e * LISTCAP + local] : 0;
        return (unsigned)tok * K2;
    }
};
__device__ __forceinline__ void build_tables(Frame& F, int l) {
    LAS int* tileE = (LAS int*)(F.lds + TILEE_OFF); LAS int* tb = (LAS int*)(F.lds + TB_OFF); LAS int* cnt = (LAS int*)(F.lds + CNT_OFF);
    if (F.wave == 0) {
        int c = (int)__hip_atomic_load(F.ctl + CW_CURSOR + (l * 64 + F.lane) * 16, RLX_AGENT); if (c > LISTCAP) c = LISTCAP;
        const int tiles = (c + 255) >> 8; int inc = tiles;
#pragma unroll
        for (int o = 1; o < 64; o <<= 1) { const int t = __shfl_up(inc, o); if (F.lane >= o) inc += t; }
        cnt[F.lane] = c; tb[F.lane] = inc - tiles;
        if (F.lane == 63) { cnt[64] = T; tb[64] = inc; tb[65] = inc + 64; }
    }
    __syncthreads();
    const int nt = tb[65];
    for (int pm = F.tid; pm < nt; pm += NWAVES * 64) { int e = 0;
#pragma unroll 1
        for (int step = 64; step >= 1; step >>= 1) { const int q = e + step; if (q <= 64 && tb[q] <= pm) e = q; }
        tileE[pm] = e; }
    __syncthreads();
}

#if MK_ONE_LAUNCH
#define GRID_BAR() xcd_barrier(bar, F.tid == 0)
#else
#define GRID_BAR() do { } while (0)
#endif
#ifndef ONLY_PHASE
#define ONLY_PHASE -1
#endif
#define IN(k) ((ONLY_PHASE < 0 || ONLY_PHASE == ((k) < 1 ? (k) : 1 + ((k) - 1) % 8)) && lo <= (k) && (k) < hi)
#define BOTH(k) (IN(k) && IN((k) + 1))
#ifndef REPEAT_MASK
#define REPEAT_MASK 0
#endif
#define NREP(k) (1 + ((REPEAT_MASK >> (k)) & 1))
template <int l>
__device__ __forceinline__ void layer_phases(Frame& F, const XcdBarrier& bar, const int lo, const int hi) {
    unsigned char* ws = F.ws;
    const int gw = blockIdx.x * NWAVES + F.wave, NGW = F.G * NWAVES;
    constexpr int pb = 2 + 8 * l;

        if (IN(pb - 1)) for (int rep = 0; rep < NREP(1); ++rep) {
            refresh(F);
            LAS unsigned char* hs = F.lds + RING_OFF;
            LAS float* part = (LAS float*)(F.lds + RING_OFF);
            const unsigned char* wff = ws + WS_WF + (size_t)l * 262144;
            const float* Fx = inptr<const float>(F, I_X); const bf16* Xb = (const bf16*)(ws + WS_X2B);
            bf16* hbuf = (bf16*)(ws + WS_H); float* flog = (float*)(ws + WS_FLOG);
            for (int item = blockIdx.x; item < T / 32; item += F.G) {
                const int m0 = item * 32 + 4 * F.wave;
                int lq = F.lane; asm volatile("" : "+v"(lq));
                const int r32 = lq & 31, hi5 = lq >> 5;
                const float* mrow = (const float*)(ws + WS_MOD) + ((size_t)l * 8 + (m0 >> 11)) * 12288;
                f32x4 xv[4][8];
#pragma unroll
                for (int rr = 0; rr < 4; ++rr)
#pragma unroll
                    for (int j = 0; j < 8; ++j) { const size_t o0 = (size_t)(m0 + rr) * D + 4 * lq + 256 * j;
                        if (l == 0) xv[rr][j] = __builtin_nontemporal_load((const GAS f32x4*)(Fx + o0)); else { const v2u a = __builtin_nontemporal_load((const GAS v2u*)(Xb + o0)); xv[rr][j] = bf4(a.x, a.y); } }
#pragma unroll
                for (int j = 0; j < 8; ++j) { const int k = 4 * lq + 256 * j;
                    const f32x4 sh = *(const GAS f32x4*)(mrow + k), sc = *(const GAS f32x4*)(mrow + 2048 + k) + 1.0f;
#pragma unroll
                    for (int rr = 0; rr < 4; ++rr) { const int rloc = 4 * F.wave + rr; const f32x4 h = xv[rr][j] * sc + sh;
                        v2u o; o.x = pk2(h.x, h.y); o.y = pk2(h.z, h.w);
                        *(GAS v2u*)(hbuf + (size_t)(m0 + rr) * D + k) = o;
                        const int chunk = (lq >> 1) + 32 * j;
                        *(LAS v2u*)(hs + rloc * 4096 + ((chunk ^ (rloc & 15)) << 4) + (lq & 1) * 8) = o; } }
                asm volatile("" ::: "memory");
                bf16x8 bw[16][2];
                { const unsigned char* wb = wff + (size_t)(16 * F.wave) * 2048 + lq * 16;
#pragma unroll
                  for (int q = 0; q < 16; ++q) { bw[q][0] = *(const GAS bf16x8*)(wb + q * 2048); bw[q][1] = *(const GAS bf16x8*)(wb + q * 2048 + 1024); } }
                __syncthreads();
                att::f32x16 acc0 = att::f32x16{};
#pragma unroll
                for (int q = 0; q < 16; ++q) { const int ks = 16 * F.wave + q;
                    const bf16x8 af = *(const LAS bf16x8*)(hs + r32 * 4096 + (((2 * ks + hi5) ^ (r32 & 15)) << 4));
                    acc0 = __builtin_amdgcn_mfma_f32_32x32x16_bf16(af, bw[q][0], acc0, 0, 0, 0); acc0 = __builtin_amdgcn_mfma_f32_32x32x16_bf16(af, bw[q][1], acc0, 0, 0, 0); }
                __syncthreads();
#pragma unroll
                for (int r = 0; r < 16; ++r) part[(F.wave * 32 + att::crow(r, hi5)) * 32 + r32] = acc0[r];
                __syncthreads();
                if (F.tid < 32 * NFOX) { const int row = F.tid / NFOX, j = F.tid % NFOX; float sacc = 0.f;
#pragma unroll
                    for (int w = 0; w < 8; ++w) sacc += part[(w * 32 + row) * 32 + j];
                    flog[(size_t)(item * 32 + row) * 16 + j] = sacc; }
                __syncthreads();
            }
            __syncthreads();
            if (BOTH(pb - 1)) GRID_BAR();
        }
        if (IN(pb + 0)) for (int rep = 0; rep < NREP(2); ++rep) {
            refresh(F);
            if ((int)blockIdx.x < NB * NFOX) {
                const int b = blockIdx.x / NFOX, hh = blockIdx.x % NFOX;
                const float* fl = (const float*)(ws + WS_FLOG) + (size_t)b * SEQ * 16 + hh; const float bf = inptr<const float>(F, I_BFORGET)[l * NFOX + hh];
                LAS float* wtot = (LAS float*)(F.lds + RING_OFF);
                float v[4], run = 0.f;
#pragma unroll
                for (int i = 0; i < 4; ++i) { const float z = fl[(size_t)(4 * F.tid + i) * 16] + bf; const float ls = fminf(z, 0.f) - log1pf(__expf(-fabsf(z))); run += ls * LOG2E; v[i] = run; }
                float inc = run;
#pragma unroll
                for (int o = 1; o < 64; o <<= 1) { const float t = __shfl_up(inc, o); if (F.lane >= o) inc += t; }
                if (F.lane == 63) wtot[F.wave] = inc;
                __syncthreads();
                float basev = inc - run;
                for (int w = 0; w < F.wave; ++w) basev += wtot[w];
                float* co = (float*)(ws + WS_CUM) + (size_t)blockIdx.x * SEQ + 4 * F.tid;
#pragma unroll
                for (int i = 0; i < 4; ++i) co[i] = basev + v[i];
                __syncthreads();
            }
            const bf16* WL = (const bf16*)(ws + WS_W + (size_t)l * W_LAYER);
            pg8::Gemm g{(const void*)(ws + WS_H), (const void*)(WL + W_IN_OFF / 2), D * 2, 127, 127}; pg8::StaticOrder S; S.init(T, NPROJ, F.G, (int)blockIdx.x);
            EpiProj E{(bf16*)(ws + WS_PROJ), (const float*)(ws + WS_TAB)};
            pg8::gemm_phase<EpiProj, pg8::StaticOrder, true>(F.lds + RING_OFF, g, S, E, F.wave, F.lane);
            if (BOTH(pb + 0)) GRID_BAR();
        }
        if (IN(pb + 1)) for (int rep = 0; rep < NREP(3); ++rep) {
            refresh(F);
            const bf16* proj = (const bf16*)(ws + WS_PROJ); unsigned char* obuf = ws + WS_OBUF;
            const float* gn = inptr<const float>(F, I_HNG) + (size_t)l * D;
            LAS unsigned char* kvbuf = F.lds + RING_OFF; LAS float* ncum = (LAS float*)(F.lds + RING_OFF + 49152); att::lptr wl = F.lds + RING_OFF + 57344 + F.wave * 9216; LAS float* wsf = (LAS float*)(F.lds + WSF_OFF + F.wave * 256);
            volatile LAS unsigned* uslot = (volatile LAS unsigned*)(F.lds + MISC_OFF + 64);
            const int qid = blockIdx.x & 7;
#ifndef ATT_ONLY
#define ATT_ONLY -1
#endif
#define ATT_DEQ(ctrp, out) do { __syncthreads(); if (F.tid == 0) uslot[0] = __hip_atomic_fetch_add((ctrp), 1u, RLX_AGENT); __syncthreads(); (out) = (int)uslot[0] * 8 + qid; } while (0)
            bf16* dstO = (bf16*)(ws + WS_DST_O); float* dstM = (float*)(ws + WS_DST_M);
            if (rep == 0) { gu32* ctr = F.ctl + CW_AQ + ((l * 4 + 3) * 8 + qid) * 64;
              for (;;) { int gi; ATT_DEQ(ctr, gi); if (gi >= 768) break;
                  const int qb = gi / 96, bh = gi % 96;
                  att::dil_a_unit(proj, dstO, dstM, F.ctl + CW_DA + ((l * 96 + bh) * 4 + (qb >> 1)) * 16, bh / 12, bh % 12, qb, wl, wsf, F.tid, F.wave); } }
            if (ATT_ONLY < 0 || ATT_ONLY == 0) { gu32* ctr = F.ctl + CW_AQ + ((l * 4 + 0) * 8 + qid) * 64 + rep * 32;
              for (;;) { int gi; ATT_DEQ(ctr, gi); if (gi >= 512) break;
                  const int qb = 7 - gi / 64, bh = gi % 64;
                  att::sb_wave_unit(proj, gn, obuf, bh >> 3, bh & 7, 8 * qb + F.wave, wl, wsf, F.lane); } }
            if (ATT_ONLY < 0 || ATT_ONLY == 1) { gu32* ctr = F.ctl + CW_AQ + ((l * 4 + 1) * 8 + qid) * 64 + rep * 32;
              for (;;) { int gi; ATT_DEQ(ctr, gi); if (gi >= 768) break;
                  const int slot_ = gi >> 3, qb = 7 - (slot_ & 7), bh = (slot_ >> 3) * 8 + (gi & 7);
                  att::causal_wg_unit<1>(proj, (const float*)(ws + WS_CUM) + (size_t)bh * SEQ, gn, obuf, bh / 12, bh % 12, qb, kvbuf, ncum, wl, wsf, F.tid, F.wave); } }
            if (ATT_ONLY < 0 || ATT_ONLY == 2) { gu32* ctr = F.ctl + CW_AQ + ((l * 4 + 2) * 8 + qid) * 64 + rep * 32;
              for (;;) { int gi; ATT_DEQ(ctr, gi); if (gi >= 768) break;
                  const int blk = 3 - gi / 192, rem = gi % 192, bh = rem >> 1, half = rem & 1;
                  att::dil_b_unit(proj, dstO, dstM, F.ctl + CW_DA + ((l * 96 + bh) * 4 + blk) * 16, F.ctl + CW_TMO, gn, obuf, bh / 12, bh % 12, blk, half, wl, wsf, F.tid, F.wave); } }
#undef ATT_DEQ
            __syncthreads();
            if (BOTH(pb + 1)) GRID_BAR();
        }
        if (IN(pb + 2)) for (int rep = 0; rep < NREP(4); ++rep) {
            refresh(F);
            const bf16* WL = (const bf16*)(ws + WS_W + (size_t)l * W_LAYER);
            pg8::Gemm g{(const void*)(ws + WS_OBUF), (const void*)(WL + W_OUT_OFF / 2), D, 127 - WSHIFT, 127 - ASHIFT}; pg8::StaticOrder S; S.init(T, D, F.G, (int)blockIdx.x);
            EpiMix E{(bf16*)(ws + WS_Y1)};
            pg8::gemm_phase<EpiMix, pg8::StaticOrder, true, true>(F.lds + RING_OFF, g, S, E, F.wave, F.lane);
            if (BOTH(pb + 2)) GRID_BAR();
        }
        if (IN(pb + 3)) for (int rep = 0; rep < NREP(5); ++rep) {
            refresh(F);
            const bf16* mixb = (const bf16*)(ws + WS_Y1); const float* xin = inptr<const float>(F, I_X); const bf16* xinb = (const bf16*)(ws + WS_X2B); bf16* x1 = (bf16*)(ws + WS_X1); unsigned char* h2q = ws + WS_H2;
            const float* g1 = inptr<const float>(F, I_LN1G) + (size_t)l * D; const float* b1 = inptr<const float>(F, I_LN1B) + (size_t)l * D;
            int* tinfo = (int*)(ws + WS_TINFO); float* gates = (float*)(ws + WS_GATE); int* list = (int*)(ws + WS_LIST); int* list2 = (int*)(ws + WS_LIST2);
            LAS unsigned char* h2s = F.lds + RING_OFF;
            LAS float* part = (LAS float*)(F.lds + RING_OFF);
            const unsigned char* wrf = ws + WS_WR + (size_t)l * 524288;
            const float rb = inptr<const float>(F, I_RBIAS)[l * NE + F.lane];
            for (int item = blockIdx.x; item < T / 32; item += F.G) {
                const int m0 = item * 32 + 4 * F.wave;
                int lq = F.lane; asm volatile("" : "+v"(lq));
                const int r32 = lq & 31, hi5 = lq >> 5;
                const float* mrow = (const float*)(ws + WS_MOD) + ((size_t)l * 8 + (m0 >> 11)) * 12288;
#pragma unroll
                for (int rp = 0; rp < 2; ++rp) {
                f32x4 vv[2][8];
#pragma unroll
                for (int rr = 0; rr < 2; ++rr)
#pragma unroll
                    for (int j = 0; j < 8; ++j) { const size_t off = (size_t)(m0 + 2 * rp + rr) * D + 4 * lq + 256 * j;
                        f32x4 xv; if (l == 0) xv = __builtin_nontemporal_load((const GAS f32x4*)(xin + off)); else { const v2u xw_ = __builtin_nontemporal_load((const GAS v2u*)(xinb + off)); xv = bf4(xw_.x, xw_.y); } const v2u mw = __builtin_nontemporal_load((const GAS v2u*)(mixb + off)); const f32x4 gv = *(const GAS f32x4*)(mrow + 4096 + 4 * lq + 256 * j);
                        vv[rr][j] = xv * ALPHA + gv * (f32x4){bflo(mw.x), bfhi(mw.x), bflo(mw.y), bfhi(mw.y)}; }
#pragma unroll
                for (int rq = 0; rq < 2; ++rq) { const int rr = 2 * rp + rq, m = m0 + rr, rloc = 4 * F.wave + rr;
                    f32x4 (&v)[8] = vv[rq]; float s = 0.f;
#pragma unroll
                    for (int j = 0; j < 8; ++j) s += (v[j].x + v[j].y) + (v[j].z + v[j].w);
                    const float mean = wave_sum(s) * (1.f / D); float s2 = 0.f;
#pragma unroll
                    for (int j = 0; j < 8; ++j) { v[j] = v[j] - mean; s2 += (v[j].x * v[j].x + v[j].y * v[j].y) + (v[j].z * v[j].z + v[j].w * v[j].w); }
                    const float rstd = 1.f / sqrtf(wave_sum(s2) * (1.f / D) + LN_EPS);
#pragma unroll
                    for (int j = 0; j < 8; ++j) { const int k = 4 * lq + 256 * j;
                        const f32x4 xv = v[j] * rstd * *(const GAS f32x4*)(g1 + k) + *(const GAS f32x4*)(b1 + k);
                        { v2u xo; xo.x = pk2(xv.x, xv.y); xo.y = pk2(xv.z, xv.w); *(GAS v2u*)(x1 + (size_t)m * D + k) = xo; }
                        const f32x4 hv = xv * (*(const GAS f32x4*)(mrow + 8192 + k) + 1.0f) + *(const GAS f32x4*)(mrow + 6144 + k);
                        v2u o; o.x = pk2(hv.x, hv.y); o.y = pk2(hv.z, hv.w);
                        *(GAS unsigned*)(h2q + (size_t)m * D + k) = pk4_fp8(hv.x, hv.y, hv.z, hv.w);
                        const int chunk = (lq >> 1) + 32 * j;
                        *(LAS v2u*)(h2s + rloc * 4096 + ((chunk ^ (rloc & 15)) << 4) + (lq & 1) * 8) = o; }
                }
                }
                bf16x8 bqa[4][4], bqb[4][4];
                const unsigned lo_ = lq * 16;
                const unsigned char* wbase = wrf + (size_t)(16 * F.wave) * 4096 + lo_;
#define P5_LDB(dst, q0) do { _Pragma("unroll") for (int q_ = 0; q_ < 4; ++q_) _Pragma("unroll") for (int c_ = 0; c_ < 4; ++c_) dst[q_][c_] = *(const GAS bf16x8*)(wbase + (size_t)((q0) + q_) * 4096 + c_ * 1024); } while (0)
#define P5_MMA(src, q0) do { _Pragma("unroll") for (int q_ = 0; q_ < 4; ++q_) { const int ks = 16 * F.wave + (q0) + q_; \
                    const bf16x8 af = *(const LAS bf16x8*)(h2s + r32 * 4096 + (((2 * ks + hi5) ^ (r32 & 15)) << 4)); \
                    acc0 = __builtin_amdgcn_mfma_f32_32x32x16_bf16(af, src[q_][0], acc0, 0, 0, 0); acc0 = __builtin_amdgcn_mfma_f32_32x32x16_bf16(af, src[q_][1], acc0, 0, 0, 0); \
                    acc1 = __builtin_amdgcn_mfma_f32_32x32x16_bf16(af, src[q_][2], acc1, 0, 0, 0); acc1 = __builtin_amdgcn_mfma_f32_32x32x16_bf16(af, src[q_][3], acc1, 0, 0, 0); } } while (0)
                asm volatile("" ::: "memory");
                P5_LDB(bqa, 0); P5_LDB(bqb, 4);
                __syncthreads();
                att::f32x16 acc0 = att::f32x16{}, acc1 = att::f32x16{};
                P5_MMA(bqa, 0); asm volatile("" ::: "memory"); P5_LDB(bqa, 8);
                P5_MMA(bqb, 4); asm volatile("" ::: "memory"); P5_LDB(bqb, 12);
                P5_MMA(bqa, 8); P5_MMA(bqb, 12);
#undef P5_LDB
#undef P5_MMA
                __syncthreads();
#pragma unroll
                for (int r = 0; r < 16; ++r) { const int row = att::crow(r, hi5); part[(F.wave * 32 + row) * 64 + r32] = acc0[r]; part[(F.wave * 32 + row) * 64 + 32 + r32] = acc1[r]; }
                __syncthreads();
                float score[4]; unsigned key[4]; int ek[4][6]; float sk[4][6];
#pragma unroll
                for (int rr = 0; rr < 4; ++rr) { const int rloc = 4 * F.wave + rr; float lg = 0.f;
#pragma unroll
                    for (int w = 0; w < 8; ++w) lg += part[(w * 32 + rloc) * 64 + F.lane];
                    score[rr] = 1.0f / (1.0f + __expf(-lg)); const float sel = score[rr] + rb;
                    unsigned ob = __float_as_uint(sel); ob = (ob & 0x80000000u) ? ~ob : (ob | 0x80000000u);
                    key[rr] = (ob & ~63u) | (unsigned)(63 - F.lane); }
#pragma unroll
                for (int k = 0; k < 6; ++k) {
                    unsigned mx[4];
#pragma unroll
                    for (int rr = 0; rr < 4; ++rr) mx[rr] = key[rr];
#pragma unroll
                    for (int o = 1; o < 64; o <<= 1) {
#pragma unroll
                        for (int rr = 0; rr < 4; ++rr) { const unsigned t = __shfl_xor(mx[rr], o); mx[rr] = t > mx[rr] ? t : mx[rr]; } }
#pragma unroll
                    for (int rr = 0; rr < 4; ++rr) { const int win = 63 - (int)(__builtin_amdgcn_readfirstlane((int)mx[rr]) & 63);
                        ek[rr][k] = win; sk[rr][k] = __uint_as_float((unsigned)__builtin_amdgcn_readlane((int)__float_as_uint(score[rr]), win)); if (F.lane == win) key[rr] = 0u; }
                }
#pragma unroll
                for (int rr = 0; rr < 4; ++rr) { const int m = m0 + rr;
                    const float ssum = ((sk[rr][0] + sk[rr][1]) + (sk[rr][2] + sk[rr][3])) + (sk[rr][4] + sk[rr][5]);
                    if (F.lane < 6 && rep == 0) { int e = ek[rr][0]; float sc = sk[rr][0];
#pragma unroll
                        for (int k = 1; k < 6; ++k) if (F.lane == k) { e = ek[rr][k]; sc = sk[rr][k]; }
                        const unsigned pos = __hip_atomic_fetch_add(F.ctl + CW_CURSOR + (l * 64 + e) * 16, 1u, RLX_AGENT);
                        if (pos < (unsigned)LISTCAP) { list[(size_t)e * LISTCAP + pos] = m; list2[(size_t)e * LISTCAP + pos] = m * 7 + F.lane; }
                        tinfo[(size_t)m * 6 + F.lane] = e | (int)(pos << 8); gates[(size_t)m * 6 + F.lane] = sc / ssum * ROUTED_SCALE; }
                }
                __syncthreads();
            }
            __syncthreads();
            if (BOTH(pb + 3)) GRID_BAR();
        }
        if (IN(pb + 4)) for (int rep = 0; rep < NREP(6); ++rep) {
            refresh(F);
            build_tables(F, l);
            const LAS int* tb = (const LAS int*)(F.lds + TB_OFF);
            MoeOrder<true, 4> S{F.G, (int)blockIdx.x, tb[65] * 4, (const LAS int*)(F.lds + TILEE_OFF), tb, (const LAS int*)(F.lds + CNT_OFF), (const int*)(ws + WS_LIST), (unsigned)D};
            const bf16* WL = (const bf16*)(ws + WS_W + (size_t)l * W_LAYER);
            pg8::Gemm g{(const void*)(ws + WS_H2), (const void*)(WL + W_1_OFF / 2), D, 127 - WSHIFT, 127};
            EpiSwiglu E{(unsigned char*)(ws + WS_ACT)};
            pg8::gemm_phase<EpiSwiglu, MoeOrder<true, 4>, true, true>(F.lds + RING_OFF, g, S, E, F.wave, F.lane);
            if (BOTH(pb + 4)) GRID_BAR();
        }
        if (IN(pb + 5)) for (int rep = 0; rep < NREP(7); ++rep) {
            refresh(F);
            build_tables(F, l);
            const LAS int* tb = (const LAS int*)(F.lds + TB_OFF);
            MoeOrder<false, 8> S{F.G, (int)blockIdx.x, tb[65] * 8, (const LAS int*)(F.lds + TILEE_OFF), tb, (const LAS int*)(F.lds + CNT_OFF), (const int*)(ws + WS_LIST), (unsigned)EH};
            const bf16* WL = (const bf16*)(ws + WS_W + (size_t)l * W_LAYER);
            pg8::Gemm g{(const void*)(ws + WS_ACT), (const void*)(WL + W_2_OFF / 2), EH, 127 - WSHIFT, 127 - ASHIFT};
            EpiDown E{(unsigned char*)(ws + WS_YBUF), (const LAS int*)(F.lds + TILEE_OFF), tb, (const LAS int*)(F.lds + CNT_OFF), (const int*)(ws + WS_LIST2)};
            pg8::gemm_phase<EpiDown, MoeOrder<false, 8>, true, true>(F.lds + RING_OFF, g, S, E, F.wave, F.lane);
            if (BOTH(pb + 5)) GRID_BAR();
        }
        if (IN(pb + 6)) for (int rep = 0; rep < NREP(8); ++rep) {
            refresh(F);
            build_tables(F, l);
            const LAS int* tb = (const LAS int*)(F.lds + TB_OFF);
            const unsigned char* yb = ws + WS_YBUF; const bf16* x1 = (const bf16*)(ws + WS_X1); bf16* x2b = (bf16*)(ws + WS_X2B);
            const int* tinfo = (const int*)(ws + WS_TINFO); const float* gates = (const float*)(ws + WS_GATE);
            const float* g2 = inptr<const float>(F, I_LN2G) + (size_t)l * D; const float* b2 = inptr<const float>(F, I_LN2B) + (size_t)l * D; float* Fout = inptr<float>(F, I_OUT);
            const int shared_row0 = tb[64] * 256;
            for (int m = gw; m < T; m += NGW) {
                const float* mrow = (const float*)(ws + WS_MOD) + ((size_t)l * 8 + (m >> 11)) * 12288;
                size_t rows[7]; float gt[7];
                float gtv = 0.f; if (F.lane < 6) gtv = gates[(size_t)m * 6 + F.lane];
#pragma unroll
                for (int k = 0; k < 6; ++k) { rows[k] = (size_t)m * 7 + k; gt[k] = __uint_as_float((unsigned)__builtin_amdgcn_readlane((int)__float_as_uint(gtv), k)); }
                rows[6] = (size_t)m * 7 + 6; gt[6] = 1.0f;
                f32x4 v[8]; float s = 0.f;
#pragma unroll
                for (int jh = 0; jh < 2; ++jh) { const v4u xa = __builtin_nontemporal_load((const GAS v4u*)(x1 + (size_t)m * D + 16 * F.lane + 1024 * jh)), xb = __builtin_nontemporal_load((const GAS v4u*)(x1 + (size_t)m * D + 16 * F.lane + 1024 * jh + 8));
                    v[4 * jh] = bf4(xa.x, xa.y); v[4 * jh + 1] = bf4(xa.z, xa.w); v[4 * jh + 2] = bf4(xb.x, xb.y); v[4 * jh + 3] = bf4(xb.z, xb.w); }
#pragma unroll
                for (int jh = 0; jh < 2; ++jh) {
                    v4u yw[7];
#pragma unroll
                    for (int q = 0; q < 7; ++q) yw[q] = __builtin_nontemporal_load((const GAS v4u*)(yb + rows[q] * D + 16 * F.lane + 1024 * jh));
#pragma unroll
                    for (int i = 0; i < 4; ++i) { const int j = 4 * jh + i, k = 16 * F.lane + 1024 * jh + 4 * i; f32x4 f = (f32x4){0.f, 0.f, 0.f, 0.f};
#pragma unroll
                        for (int q = 0; q < 7; ++q) { const unsigned w = yw[q][i]; const float gq = gt[q];
                            const auto lo2 = __builtin_amdgcn_cvt_pk_f32_fp8((int)w, false), hi2 = __builtin_amdgcn_cvt_pk_f32_fp8((int)w, true);
                            f.x += gq * lo2[0]; f.y += gq * lo2[1]; f.z += gq * hi2[0]; f.w += gq * hi2[1]; }
                        v[j] = v[j] * ALPHA + *(const GAS f32x4*)(mrow + 10240 + k) * (f * (1.0f / (float)(1 << YSHIFT)));
                        s += (v[j].x + v[j].y) + (v[j].z + v[j].w); }
                    asm volatile("" ::: "memory");
                }
                const float mean = wave_sum(s) * (1.f / D); float s2 = 0.f;
#pragma unroll
                for (int j = 0; j < 8; ++j) { v[j] = v[j] - mean; s2 += (v[j].x * v[j].x + v[j].y * v[j].y) + (v[j].z * v[j].z + v[j].w * v[j].w); }
                const float rstd = 1.f / sqrtf(wave_sum(s2) * (1.f / D) + LN_EPS);
                float* orow = Fout + (size_t)m * D;
#pragma unroll
                for (int j = 0; j < 8; ++j) { const int k = 16 * F.lane + 1024 * (j >> 2) + 4 * (j & 3);
                    v[j] = v[j] * rstd * *(const GAS f32x4*)(g2 + k) + *(const GAS f32x4*)(b2 + k);
                    if (l == 1) { *(GAS f32x4*)(orow + k) = v[j]; if (j & 1) asm volatile("" ::: "memory"); } }
                if (l == 0) {
#pragma unroll
                    for (int jh = 0; jh < 2; ++jh) { v4u wa, wb; wa.x = pk2(v[4 * jh].x, v[4 * jh].y); wa.y = pk2(v[4 * jh].z, v[4 * jh].w); wa.z = pk2(v[4 * jh + 1].x, v[4 * jh + 1].y); wa.w = pk2(v[4 * jh + 1].z, v[4 * jh + 1].w);
                        wb.x = pk2(v[4 * jh + 2].x, v[4 * jh + 2].y); wb.y = pk2(v[4 * jh + 2].z, v[4 * jh + 2].w); wb.z = pk2(v[4 * jh + 3].x, v[4 * jh + 3].y); wb.w = pk2(v[4 * jh + 3].z, v[4 * jh + 3].w);
                        *(GAS v4u*)(x2b + (size_t)m * D + 16 * F.lane + 1024 * jh) = wa; *(GAS v4u*)(x2b + (size_t)m * D + 16 * F.lane + 1024 * jh + 8) = wb; } }
            }
            __syncthreads();
            if ((l == 0 || rep + 1 < NREP(8)) && BOTH(pb + 6)) GRID_BAR();
        }

}
struct Args { const void* in[21]; float* out; unsigned char* ws; int ph_lo, ph_hi; };
__global__ void __launch_bounds__(NWAVES * 64, 2) fwd_kernel(Args args) {
    extern __shared__ __attribute__((aligned(16))) unsigned char lds[];
    Frame F;
    F.lds = (LAS unsigned char*)lds;
    F.wave = __builtin_amdgcn_readfirstlane((int)(threadIdx.x >> 6)); refresh(F); F.G = gridDim.x;
    unsigned char* ws = args.ws; F.ws = ws; F.ctl = (gu32*)(ws + WS_CTL);
    for (int u = F.tid; u < (LDS_BYTES - LDSCTL_OFF) / 4; u += NWAVES * 64) ((LAS unsigned*)(F.lds + LDSCTL_OFF))[u] = 0u;
    __syncthreads();
    if (F.tid < 21) *(LAS unsigned long long*)(F.lds + PTR_OFF + 8 * F.tid) = (unsigned long long)args.in[F.tid];
    if (F.tid == 21) *(LAS unsigned long long*)(F.lds + PTR_OFF + 8 * 21) = (unsigned long long)args.out;
    __syncthreads();
    volatile LAS unsigned* MISC = (volatile LAS unsigned*)(F.lds + MISC_OFF);
    XcdBarrier bar; bar.bar = (unsigned*)(F.ctl + CW_BAR); bar.x = 0; bar.st = nullptr;
#if MK_ONE_LAUNCH
    bar = xcd_barrier_post((unsigned*)(F.ctl + CW_BAR), MISC + 8, F.tid == 0);
#endif
    const int lo = args.ph_lo, hi = args.ph_hi;
    const int gw = blockIdx.x * NWAVES + F.wave, NGW = F.G * NWAVES;

    if (IN(0)) for (int rep = 0; rep < NREP(0); ++rep) { refresh(F); p0_prologue(F); if (BOTH(0)) GRID_BAR(); }
    layer_phases<0>(F, bar, lo, hi);
    layer_phases<1>(F, bar, lo, hi);
#undef IN
#undef BOTH
}

extern "C" void kernel_launch(void* const* d_in, const int* in_sizes, int n_in, void* d_out, int out_size, void* d_ws, size_t ws_size, hipStream_t stream) {
    static int grid = 0;
    if (grid == 0) {
        if (n_in != 21 || out_size != T * D || ws_size < WS_END) { fprintf(stderr, "kernel_launch: unexpected sizes (n_in %d, out %d, ws %zu < %zu)\n", n_in, out_size, ws_size, (size_t)WS_END); grid = -1; return; }
        int dev = 0, cus = 0, per_cu = 0;
        if (hipGetDevice(&dev) != hipSuccess || hipDeviceGetAttribute(&cus, hipDeviceAttributeMultiprocessorCount, dev) != hipSuccess) { grid = -1; return; }
        if (hipFuncSetAttribute((const void*)fwd_kernel, hipFuncAttributeMaxDynamicSharedMemorySize, LDS_BYTES) != hipSuccess) { fprintf(stderr, "kernel_launch: hipFuncSetAttribute failed\n"); grid = -1; return; }
        if (hipOccupancyMaxActiveBlocksPerMultiprocessor(&per_cu, (const void*)fwd_kernel, NWAVES * 64, LDS_BYTES) != hipSuccess || per_cu < 1) { fprintf(stderr, "kernel_launch: occupancy query says %d\n", per_cu); }
        (void)hipGetLastError();
        grid = cus;
    }
    if (grid < 0) return;
    (void)in_sizes;
    hipMemsetAsync((char*)d_ws + WS_CTL, 0, CTL_ZERO_BYTES, stream);
    Args a{};
    for (int i = 0; i < 21; ++i) a.in[i] = d_in[i];
    a.out = (float*)d_out; a.ws = (unsigned char*)d_ws;
#if MK_ONE_LAUNCH
    a.ph_lo = 0; a.ph_hi = 17;
    hipLaunchKernelGGL(fwd_kernel, dim3(grid), dim3(NWAVES * 64), LDS_BYTES, stream, a);
#else
    for (int p = 0; p < 17; ++p) { a.ph_lo = p; a.ph_hi = p + 1; hipLaunchKernelGGL(fwd_kernel, dim3(grid), dim3(NWAVES * 64), LDS_BYTES, stream, a); }
#endif
}
```

```cpp
#include <hip/hip_runtime.h>
#include <hip/hip_bf16.h>
#include <cstdio>
#include <cstdint>

#ifndef MK_ONE_LAUNCH
#define MK_ONE_LAUNCH 1
#endif

namespace pg8 {
#define PG8_LAS __attribute__((address_space(3)))
typedef unsigned short bf16_t;
typedef short bf16x8 __attribute__((ext_vector_type(8)));
typedef float f32x4 __attribute__((ext_vector_type(4)));
typedef unsigned u32x4 __attribute__((ext_vector_type(4)));
constexpr int BM = 256, BK = 64, HALF = 128, HTB = HALF * BK * 2, STAGE_BYTES = 8 * HTB, NXCD = 8, WGM = 8;
constexpr int GOFF_REL = 137216;

__host__ __device__ __forceinline__ int lds_byte(int r, int c) { const int st = (r >> 4) * 2 + (c >> 5), rr = r & 15, cc = c & 31, ob = rr * 64 + cc * 2; return st * 1024 + (ob ^ (((ob >> 9) & 1) << 5)); }
__host__ __device__ __forceinline__ void stage_rc(int b, int& R, int& C) { const int st = b / 1024, sb = b % 1024, swz = sb ^ (((sb >> 9) & 1) << 5); R = (st >> 1) * 16 + swz / 64; C = (st & 1) * 32 + (swz % 64) / 2; }
__host__ __device__ __forceinline__ int perm32(int rho) { const int n = rho >> 4, i = rho & 15; return 8 * (i >> 2) + 4 * n + (i & 3); }

struct Unit { int pm, pn; };
struct Gemm { const void* A; const void* Bt; int KB; int sa, sb; };

struct StaticOrder {
    static constexpr bool GATHER = false;
    int nM, nN, nwg, G, c;
    __device__ void init(int M, int N, int G_, int c_) { nM = M / BM; nN = N / BM; nwg = nM * nN; G = G_; c = c_; }
    __device__ bool next(int i, Unit& u) const {
        const long L = (long)i * G + c; if (L >= nwg) return false;
        int wgid = (int)L; { const int q = nwg / NXCD, r = nwg % NXCD, xcd = wgid % NXCD, off = wgid / NXCD; wgid = (xcd < r ? xcd * (q + 1) : r * (q + 1) + (xcd - r) * q) + off; }
        const int nig = WGM * nN, gid = wgid / nig, fm = gid * WGM, gsz = (nM - fm) < WGM ? (nM - fm) : WGM;
        u.pm = fm + ((wgid % nig) % gsz); u.pn = (wgid % nig) / gsz; return true;
    }
    __device__ __forceinline__ unsigned tok_off(const Unit&, int) const { return 0u; }
};

typedef int v8i_t __attribute__((ext_vector_type(8))); typedef int v4i_t __attribute__((ext_vector_type(4)));
__device__ __forceinline__ v8i_t cat8(bf16x8 a, bf16x8 b) { const v4i_t x = __builtin_bit_cast(v4i_t, a), y = __builtin_bit_cast(v4i_t, b); return __builtin_shufflevector(x, y, 0, 1, 2, 3, 4, 5, 6, 7); }
__device__ __forceinline__ unsigned cvt_pk_bf16(float lo, float hi) { unsigned r; asm volatile("v_cvt_pk_bf16_f32 %0, %1, %2" : "=v"(r) : "v"(lo), "v"(hi)); return r; }

template <class Epi, class Sched, bool ALIGN_EPI, bool FP8 = false>
__device__ __forceinline__ void gemm_phase(PG8_LAS unsigned char* lds, const Gemm g, const Sched& S, const Epi& E, const int wid, const int lane) {
    constexpr bool GA = Sched::GATHER;
    const int tid = wid * 64 + lane, wr = wid >> 2, wc = wid & 3, fr = lane & 15, fq = lane >> 4;
    int KB = g.KB; asm volatile("" : "+s"(KB)); const int nt = KB / 128;
    unsigned voffA[2], voffB[2]; int rA[2]; unsigned cA2[2];
#pragma unroll
    for (int i = 0; i < 2; ++i) { int R, C; stage_rc(tid * 16 + i * 8192, R, C); const int Rb = Epi::PERM ? ((R & ~31) + perm32(R & 31)) : R;
        rA[i] = R; cA2[i] = (unsigned)C * 2u; voffA[i] = (unsigned)(R * KB + C * 2); voffB[i] = (unsigned)(Rb * KB + C * 2); }
    const size_t kstep = (size_t)(BK * 2);
    const size_t hstep = (size_t)HALF * KB;
    const size_t hstepA = GA ? (size_t)0 : hstep;
    const size_t tstep = 2 * hstep;
    const unsigned ldsw = (unsigned)wid * 1024u;
    const int aoff = lds_byte(wr * 64 + fr, fq * 8), boff = lds_byte(wc * 32 + fr, fq * 8);
#define PG8_SA(b, h) (((b) * 2 + (h)) * HTB)
#define PG8_SB(b, h) ((4 + (b) * 2 + (h)) * HTB)
    const unsigned ldsb = (unsigned)__builtin_amdgcn_readfirstlane((int)((unsigned)(__UINTPTR_TYPE__)lds + ldsw));
#define PG8_STAGE(bufoff, gbase, voff) do { _Pragma("unroll") for (int _i = 0; _i < 2; ++_i) { unsigned keep_; \
        asm volatile("s_mov_b32 %0, m0\n\ts_mov_b32 m0, %3\n\ts_nop 0\n\tglobal_load_lds_dwordx4 %1, %2\n\ts_mov_b32 m0, %0" : "=&s"(keep_) : "v"((voff)[_i]), "s"((const char*)(gbase)), "s"(ldsb + (unsigned)((bufoff) + _i * 8192)) : "memory"); } } while (0)
#define PG8_LDA(dst, b, h) do { _Pragma("unroll") for (int m = 0; m < 4; ++m) _Pragma("unroll") for (int k = 0; k < 2; ++k) dst[m][k] = *(const PG8_LAS bf16x8*)(lds + PG8_SA(b, h) + aoff + m * 2048 + k * 1024); } while (0)
#define PG8_LDB(dst, b, h) do { _Pragma("unroll") for (int n = 0; n < 2; ++n) _Pragma("unroll") for (int k = 0; k < 2; ++k) dst[n][k] = *(const PG8_LAS bf16x8*)(lds + PG8_SB(b, h) + boff + n * 2048 + k * 1024); } while (0)
#define PG8_MMA(ai, bj, At, Bt) do { __builtin_amdgcn_s_setprio(1); _Pragma("unroll") for (int m = 0; m < 4; ++m) _Pragma("unroll") for (int n = 0; n < 2; ++n) { \
        if constexpr (FP8) { asm volatile("v_mfma_scale_f32_16x16x128_f8f6f4 %0, %1, %2, %0, %3, %4 op_sel_hi:[0,0,0]" : "+v"(acc[ai][bj][m][n]) : "v"(cat8(Bt[n][0], Bt[n][1])), "v"(cat8(At[m][0], At[m][1])), "v"(sa_v), "v"(sb_v)); } \
        else { _Pragma("unroll") for (int k = 0; k < 2; ++k) acc[ai][bj][m][n] = __builtin_amdgcn_mfma_f32_16x16x32_bf16(Bt[n][k], At[m][k], acc[ai][bj][m][n], 0, 0, 0); } } \
        __builtin_amdgcn_s_setprio(0); } while (0)
#define PG8_WAIT_V(n) asm volatile("s_waitcnt vmcnt(" #n ")" ::: "memory")
#define PG8_WAIT_L(n) asm volatile("s_waitcnt lgkmcnt(" #n ")" ::: "memory")
#define PG8_BAR __builtin_amdgcn_s_barrier()
#define PG8_SCHED __builtin_amdgcn_sched_barrier(0)
    const int sa_v = g.sa, sb_v = g.sb;
    Unit cur, nxt; int ui = 0;
    if (!S.next(0, cur)) return;
    f32x4 acc[2][2][4][2];
#pragma unroll
    for (int a = 0; a < 2; ++a)
#pragma unroll
        for (int b = 0; b < 2; ++b)
#pragma unroll
            for (int m = 0; m < 4; ++m)
#pragma unroll
                for (int n = 0; n < 2; ++n) acc[a][b][m][n] = (f32x4){0.f, 0.f, 0.f, 0.f};
    bf16x8 At[4][2], B0[2][2], B1[2][2];
    unsigned vc0[2], vc1[2];
    PG8_LAS u32x4* gslot = (PG8_LAS u32x4*)(lds + GOFF_REL) + tid;
#pragma unroll
    for (int i = 0; i < 2; ++i) {
        if (GA) { vc0[i] = S.tok_off(cur, rA[i]) + cA2[i]; vc1[i] = S.tok_off(cur, HALF + rA[i]) + cA2[i]; }
        else { vc0[i] = voffA[i]; vc1[i] = voffA[i]; } }
    if (GA) asm volatile("" : "+v"(vc0[0]), "+v"(vc0[1]), "+v"(vc1[0]), "+v"(vc1[1]));
    const char* cA = GA ? (const char*)g.A : (const char*)g.A + (size_t)cur.pm * tstep; const char* cB = (const char*)g.Bt + (size_t)cur.pn * tstep;
    PG8_STAGE(PG8_SB(0, 0), cB, voffB); PG8_STAGE(PG8_SB(0, 1), cB + hstep, voffB); PG8_STAGE(PG8_SA(0, 0), cA, vc0); PG8_STAGE(PG8_SA(0, 1), cA + hstepA, vc1);
    if (wr == 1) PG8_BAR;
    PG8_WAIT_V(2); PG8_BAR;
    PG8_STAGE(PG8_SB(1, 0), cB + kstep, voffB); PG8_STAGE(PG8_SA(1, 0), cA + kstep, vc0); PG8_STAGE(PG8_SB(1, 1), cB + hstep + kstep, voffB);
    PG8_WAIT_V(6); PG8_BAR;
    for (;;) {
        const bool has_next = S.next(ui + 1, nxt);
        const char* nA = GA ? (const char*)g.A : (has_next ? (const char*)g.A + (size_t)nxt.pm * tstep : cA); const char* nB = has_next ? (const char*)g.Bt + (size_t)nxt.pn * tstep : cB;
        if (GA && has_next) {
            u32x4 q; q.x = S.tok_off(nxt, rA[0]) + cA2[0]; q.y = S.tok_off(nxt, rA[1]) + cA2[1]; q.z = S.tok_off(nxt, HALF + rA[0]) + cA2[0]; q.w = S.tok_off(nxt, HALF + rA[1]) + cA2[1];
            *gslot = q;
        }
#pragma clang loop unroll(disable)
        for (int t = 0; t < nt; t += 2) {
            const bool last = (t == nt - 2);
            const char* a1 = cA + (size_t)(t + 1) * kstep;
            const char* a2 = last ? nA : cA + (size_t)(t + 2) * kstep; const char* b2 = last ? nB : cB + (size_t)(t + 2) * kstep;
            const char* a3 = a2 + kstep; const char* b3 = b2 + kstep;
            PG8_LDB(B0, 0, 0); PG8_LDB(B1, 0, 1); PG8_SCHED; PG8_LDA(At, 0, 0); PG8_STAGE(PG8_SA(1, 1), a1 + hstepA, vc1);
            if (GA && last && has_next) { const u32x4 q = *gslot; vc0[0] = q.x; vc0[1] = q.y; vc1[0] = q.z; vc1[1] = q.w; }
            PG8_WAIT_V(8); PG8_WAIT_L(0); PG8_BAR; PG8_MMA(0, 0, At, B0); PG8_MMA(0, 1, At, B1); PG8_BAR; PG8_SCHED;
            PG8_LDA(At, 0, 1); PG8_STAGE(PG8_SB(0, 0), b2, voffB); PG8_STAGE(PG8_SB(0, 1), b2 + hstep, voffB); PG8_STAGE(PG8_SA(0, 0), a2, vc0);
            PG8_WAIT_V(8); PG8_WAIT_L(0); PG8_BAR; PG8_MMA(1, 0, At, B0); PG8_MMA(1, 1, At, B1); PG8_BAR; PG8_SCHED;
            PG8_LDB(B0, 1, 0); PG8_LDB(B1, 1, 1); PG8_SCHED; PG8_LDA(At, 1, 0); PG8_STAGE(PG8_SA(0, 1), a2 + hstepA, vc1);
            PG8_WAIT_V(8); PG8_WAIT_L(0); PG8_BAR; PG8_MMA(0, 0, At, B0); PG8_MMA(0, 1, At, B1); PG8_BAR; PG8_SCHED;
            PG8_LDA(At, 1, 1); PG8_STAGE(PG8_SB(1, 0), b3, voffB); PG8_STAGE(PG8_SB(1, 1), b3 + hstep, voffB); PG8_STAGE(PG8_SA(1, 0), a3, vc0);
            PG8_WAIT_V(8); PG8_WAIT_L(0); PG8_BAR; PG8_MMA(1, 0, At, B0); PG8_MMA(1, 1, At, B1); PG8_BAR; PG8_SCHED;
        }
        if constexpr (ALIGN_EPI) { if (wr == 0) PG8_BAR; }
        if constexpr (FP8) {
#pragma unroll
            for (int a = 0; a < 2; ++a)
#pragma unroll
                for (int b = 0; b < 2; ++b) asm volatile("s_nop 15\n\ts_nop 15" : "+v"(acc[a][b][0][0]), "+v"(acc[a][b][0][1]), "+v"(acc[a][b][1][0]), "+v"(acc[a][b][1][1]), "+v"(acc[a][b][2][0]), "+v"(acc[a][b][2][1]), "+v"(acc[a][b][3][0]), "+v"(acc[a][b][3][1]));
        }
        E(acc, cur, wr, wc, fr, fq);
        if (!has_next) break;
#pragma unroll
        for (int a = 0; a < 2; ++a)
#pragma unroll
            for (int b = 0; b < 2; ++b)
#pragma unroll
                for (int m = 0; m < 4; ++m)
#pragma unroll
                    for (int n = 0; n < 2; ++n) acc[a][b][m][n] = (f32x4){0.f, 0.f, 0.f, 0.f};
        cur = nxt; cA = nA; cB = nB; ++ui;
        if constexpr (ALIGN_EPI) { if (wr == 1) PG8_BAR; }
    }
    PG8_WAIT_V(0);
    if constexpr (!ALIGN_EPI) { if (wr == 0) PG8_BAR; }
    PG8_BAR;
#undef PG8_SA
#undef PG8_SB
#undef PG8_STAGE
#undef PG8_LDA
#undef PG8_LDB
#undef PG8_MMA
#undef PG8_WAIT_V
#undef PG8_WAIT_L
#undef PG8_BAR
#undef PG8_SCHED
}
}

constexpr int NWAVES = 8;
constexpr int T = 16384, D = 2048, NB = 8, SEQ = 2048, NPROJ = 6144, INW = 6156, NFOX = 12;
constexpr int NE = 64, TOPK = 6, EH = 512, LISTCAP = 16384;
constexpr int QCOL_SB = 0, KCOL_SB = 512, VCOL_SB = 1024, QCOL_FX = 1536, KCOL_FX = 2304, VCOL_FX = 3072, QCOL_DL = 3840, KCOL_DL = 4608, VCOL_DL = 5376;
constexpr float LN_EPS = 1e-5f, RMS_EPS = 1e-6f, ALPHA = 1.4142135623730951f, ROUTED_SCALE = 2.5f;
constexpr float LOG2E = 1.4426950408889634f;
constexpr int WSHIFT = 6, ASHIFT = 4, YSHIFT = 4;
constexpr float C2 = 0.125f * 1.4426950408889634f;

constexpr size_t MiB = 1u << 20;
constexpr size_t WS_CTL = 0, CTL_ZERO_BYTES = 1 * MiB;
constexpr size_t WS_MOD = 1 * MiB;
constexpr size_t WS_TAB = 2 * MiB;
constexpr size_t WS_FLOG = 6 * MiB;
constexpr size_t WS_CUM = 7 * MiB;
constexpr size_t WS_TINFO = 8 * MiB;
constexpr size_t WS_GATE = 9 * MiB;
constexpr size_t WS_LIST = 10 * MiB;
constexpr size_t WS_WR = 14 * MiB;
constexpr size_t WS_W = 16 * MiB;
constexpr size_t W_IN_OFF = 0, W_OUT_OFF = 24 * MiB, W_1_OFF = 32 * MiB, W_2_OFF = 292 * MiB, W_LAYER = 422 * MiB;
constexpr size_t WS_H = 860 * MiB;
constexpr size_t WS_X1 = 924 * MiB;
constexpr size_t WS_X2B = 988 * MiB;
constexpr size_t WS_H2 = 1052 * MiB;
constexpr size_t WS_R1 = 1116 * MiB;
constexpr size_t WS_PROJ = WS_R1, WS_OBUF = WS_R1 + 192 * MiB, WS_Y1 = WS_R1 + 256 * MiB;
constexpr size_t WS_ACT = WS_R1, WS_YBUF = WS_R1 + 128 * MiB;
constexpr size_t WS_DST_O = WS_R1 + 640 * MiB;
constexpr size_t WS_DST_M = WS_DST_O + 24 * MiB;
constexpr size_t WS_LIST2 = WS_DST_M + 2 * MiB;
constexpr size_t WS_WF = WS_LIST2 + 4 * MiB;
constexpr size_t WS_END = WS_WF + 1 * MiB;
constexpr int MAXTILES = 512;

constexpr int CW_TMO = 0, CW_CODE = 1;
constexpr int CW_BAR = 4096;
constexpr int CW_CURSOR = 8192;
constexpr int CW_AQ = 12288;
constexpr int CW_DA = 20480;

constexpr int RING_OFF = 0, RING_BYTES = 131072;
constexpr int WSF_OFF = 131072;
constexpr int TILEE_OFF = WSF_OFF + 2048;
constexpr int TB_OFF = TILEE_OFF + 2048;
constexpr int CNT_OFF = TB_OFF + 512;
constexpr int PTR_OFF = CNT_OFF + 512;
constexpr int MISC_OFF = PTR_OFF + 256;
constexpr int GOFF_OFF = 137216;
static_assert(GOFF_OFF >= MISC_OFF + 128 && GOFF_OFF + 8192 <= 147456 && GOFF_OFF == RING_OFF + pg8::GOFF_REL, "gather slots");
constexpr int LDSCTL_OFF = WSF_OFF;
constexpr int LDS_BYTES = 147456;
static_assert(MISC_OFF + 128 <= LDS_BYTES, "LDS map");
typedef unsigned v2u_early __attribute__((ext_vector_type(2)));

#define GAS __attribute__((address_space(1)))
#define LAS __attribute__((address_space(3)))
typedef unsigned short bf16;
typedef unsigned v4u __attribute__((ext_vector_type(4)));
typedef unsigned v2u __attribute__((ext_vector_type(2)));
typedef float f32x4 __attribute__((ext_vector_type(4)));
typedef short bf16x8 __attribute__((ext_vector_type(8)));
typedef GAS unsigned gu32;
#define RLX_AGENT __ATOMIC_RELAXED, __HIP_MEMORY_SCOPE_AGENT
#define LDS_WAIT() asm volatile("s_waitcnt lgkmcnt(0)" ::: "memory")
#define VM_WAIT() asm volatile("s_waitcnt vmcnt(0)" ::: "memory")
__device__ __forceinline__ unsigned f2bf(float f) { unsigned u = __builtin_bit_cast(unsigned, f); return (u + 0x7fffu + ((u >> 16) & 1u)) >> 16; }
__device__ __forceinline__ unsigned pk2(float lo, float hi) { return f2bf(lo) | (f2bf(hi) << 16); }
__device__ __forceinline__ unsigned pk4_fp8(float a, float b, float c, float d) { int r = __builtin_amdgcn_cvt_pk_fp8_f32(a, b, 0, false); r = __builtin_amdgcn_cvt_pk_fp8_f32(c, d, r, true); return (unsigned)r; }
__device__ __forceinline__ f32x4 bf4(unsigned a, unsigned b);
__device__ __forceinline__ float bflo(unsigned w) { return __builtin_bit_cast(float, w << 16); }
__device__ __forceinline__ float bfhi(unsigned w) { return __builtin_bit_cast(float, w & 0xffff0000u); }
__device__ __forceinline__ f32x4 bf4(unsigned a, unsigned b) { return (f32x4){bflo(a), bfhi(a), bflo(b), bfhi(b)}; }

#define XB_TMO      128
#define XB_XCNT(j)  (256  + 64 * (j))
#define XB_XSUB(j)  (1280 + 64 * (j))
#define XB_XGEN(j)  (2304 + 64 * (j))
#define XB_TOP      3328
#define XB_TOPGEN   3392
#define XCD_BAR_WORDS 3456
#define XB_SPIN_CAP (1u << 20)

__device__ __forceinline__ unsigned xb_ld(unsigned* p)              { return __hip_atomic_load(p, __ATOMIC_RELAXED, __HIP_MEMORY_SCOPE_AGENT); }
__device__ __forceinline__ unsigned xb_add(unsigned* p, unsigned v) { return __hip_atomic_fetch_add(p, v, __ATOMIC_RELAXED, __HIP_MEMORY_SCOPE_AGENT); }
__device__ __forceinline__ unsigned xb_xcc_id() { return (unsigned)__builtin_amdgcn_s_getreg((3 << 11) | 20) & 0xFu; }
#define XB_SPIN(cond, bar) do { unsigned _sp = 0; while (cond) { __builtin_amdgcn_s_sleep(1); \
    if ((++_sp & 255u) == 0u) { if (xb_ld(&(bar)[XB_TMO])) break; if (_sp > XB_SPIN_CAP) { atomicAdd(&(bar)[XB_TMO], 1u); break; } } } } while (0)

struct XcdBarrier { unsigned* bar; unsigned x; volatile LAS unsigned* st; };

__device__ __forceinline__ XcdBarrier xcd_barrier_post(unsigned* bar, volatile LAS unsigned* st, bool leader) {
    XcdBarrier b; b.bar = bar; b.x = xb_xcc_id(); b.st = st;
    if (leader) (void)xb_add(&bar[XB_XCNT(b.x)], 1u);
    return b;
}
__device__ __forceinline__ void xcd_barrier_complete(unsigned* bar, unsigned x, unsigned& nloc, unsigned& nx) {
    const unsigned G = gridDim.x * gridDim.y * gridDim.z;
    unsigned sum, cnt, mine, sp = 0u;
    for (;;) {
        sum = 0u; cnt = 0u; mine = 0u;
#pragma unroll
        for (unsigned j = 0; j < 16; ++j) { const unsigned c = xb_ld(&bar[XB_XCNT(j)]); sum += c; cnt += (c > 0u) ? 1u : 0u; mine = (j == x) ? c : mine; }
        if (sum == G) break;
        __builtin_amdgcn_s_sleep(1);
        if ((++sp & 255u) == 0u) { if (xb_ld(&bar[XB_TMO])) break; if (sp > XB_SPIN_CAP) { atomicAdd(&bar[XB_TMO], 1u); break; } }
    }
    nloc = mine > 0u ? mine : 1u; nx = cnt > 0u ? cnt : 1u;
}
__device__ __forceinline__ void xcd_barrier(const XcdBarrier& b, bool leader  ) {
    asm volatile("s_waitcnt vmcnt(0)" ::: "memory");
    __syncthreads();
    if (leader) {
        unsigned* bar = b.bar;
        __builtin_amdgcn_s_waitcnt(0);
        unsigned nloc = b.st[0], nx = b.st[1];
        if (nloc == 0u) { xcd_barrier_complete(bar, b.x, nloc, nx); b.st[0] = nloc; b.st[1] = nx; }
        const unsigned old = xb_add(&bar[XB_XSUB(b.x)], 1u);
        const unsigned gen = old / nloc;
        if (old + 1u == (gen + 1u) * nloc) {
            __builtin_amdgcn_fence(__ATOMIC_RELEASE, "agent");
            asm volatile("s_waitcnt vmcnt(0)" ::: "memory");
            const unsigned og = xb_add(&bar[XB_TOP], 1u);
            const unsigned tg = og / nx;
            if (og + 1u == (tg + 1u) * nx) xb_add(&bar[XB_TOPGEN], 1u);
            else XB_SPIN(xb_ld(&bar[XB_TOPGEN]) == tg, bar);
            __builtin_amdgcn_fence(__ATOMIC_ACQUIRE, "agent");
            xb_add(&bar[XB_XGEN(b.x)], 1u);
            asm volatile("s_waitcnt vmcnt(0)" ::: "memory");
        } else {
            XB_SPIN(xb_ld(&bar[XB_XGEN(b.x)]) == gen, bar);
            __builtin_amdgcn_fence(__ATOMIC_ACQUIRE, "agent");
            asm volatile("s_waitcnt vmcnt(0)" ::: "memory");
        }
    }
    __syncthreads();
}

struct Frame {
    LAS unsigned char* lds;
    gu32* ctl;
    int tid, lane, wave, G;
    unsigned char* ws;
};
enum { I_X = 0, I_C, I_POS, I_WADA, I_BADA, I_WIN, I_BFORGET, I_HNG, I_WOUT, I_LN1G, I_LN1B, I_WROUTER, I_RBIAS, I_WEG, I_WEU, I_WED, I_WSG, I_WSU, I_WSD, I_LN2G, I_LN2B, I_OUT, I_NPTR };
template <class TP> __device__ __forceinline__ TP* inptr(const Frame& F, int i) {
    const v2u v = *(const LAS v2u*)(F.lds + PTR_OFF + 8 * i);
    const unsigned long long p = ((unsigned long long)(unsigned)__builtin_amdgcn_readfirstlane((int)v.y) << 32) | (unsigned)__builtin_amdgcn_readfirstlane((int)v.x);
    return (TP*)p;
}
__device__ __forceinline__ void refresh(Frame& F) { int l = (int)__builtin_amdgcn_mbcnt_hi(~0u, __builtin_amdgcn_mbcnt_lo(~0u, 0u)); asm volatile("" : "+v"(l)); F.lane = l; F.tid = F.wave * 64 + l; }
__device__ __forceinline__ float wave_sum(float v) {
#pragma unroll
    for (int o = 1; o < 64; o <<= 1) v += __shfl_xor(v, o);
    return v;
}

__device__ __forceinline__ void p0_transpose_item(const float* W, size_t ldw, int k0, int n0, bf16* WT, size_t drowA, size_t drowB, int Kd, LAS unsigned* S, int lane) {
    const int n4 = lane & 15, ks = lane >> 4;
    const float* src = W + (size_t)(k0 + 2 * ks) * ldw + n0 + 4 * n4;
    f32x4 a[8], b[8];
#pragma unroll
    for (int i = 0; i < 8; ++i) { a[i] = __builtin_nontemporal_load((const GAS f32x4*)(src + (size_t)(8 * i) * ldw)); b[i] = __builtin_nontemporal_load((const GAS f32x4*)(src + (size_t)(8 * i + 1) * ldw)); }
#pragma unroll
    for (int i = 0; i < 8; ++i) { const int kp = 4 * i + ks;
#pragma unroll
        for (int j = 0; j < 4; ++j) { const int n = 4 * n4 + j; S[n * 32 + 4 * ((kp >> 2) ^ (n4 & 7)) + (kp & 3)] = pg8::cvt_pk_bf16(a[i][j], b[i][j]); } }
    LDS_WAIT(); asm volatile("" ::: "memory");
    const int c = lane & 7;
#pragma unroll
    for (int j = 0; j < 8; ++j) { const int n = (lane >> 3) + 8 * j;
        const v4u o = *(const LAS v4u*)(S + n * 32 + 4 * (c ^ ((n >> 2) & 7)));
        const size_t drow = (n < 32 ? drowA + n : drowB + (n - 32));
        *(GAS v4u*)(WT + drow * (size_t)Kd + k0 + 8 * c) = o; }
    LDS_WAIT(); asm volatile("" ::: "memory");
}
template <bool PAIR>
__device__ __forceinline__ void p0_transpose_item8(const float* W, size_t ldw, int k0, int n0, unsigned char* WT, size_t drow0, int KdB, float scale, LAS unsigned* S, int lane) {
    const int n4 = lane & 7, ks = lane >> 3;
    const float* src = W + (size_t)(k0 + 4 * ks) * ldw + n0 + 4 * n4;
    f32x4 a[4][4];
#pragma unroll
    for (int i = 0; i < 4; ++i)
#pragma unroll
        for (int r = 0; r < 4; ++r) a[i][r] = __builtin_nontemporal_load((const GAS f32x4*)(src + (size_t)(32 * i + r) * ldw));
#pragma unroll
    for (int i = 0; i < 4; ++i) { const int kq = ks + 8 * i;
#pragma unroll
        for (int j = 0; j < 4; ++j) { const int n = 4 * n4 + j; S[n * 32 + 4 * ((kq >> 2) ^ n4) + (kq & 3)] = pk4_fp8(a[i][0][j] * scale, a[i][1][j] * scale, a[i][2][j] * scale, a[i][3][j] * scale); } }
    LDS_WAIT(); asm volatile("" ::: "memory");
    const int c = lane & 7;
#pragma unroll
    for (int j = 0; j < 4; ++j) { const int n = (lane >> 3) + 8 * j;
        const v4u o = *(const LAS v4u*)(S + n * 32 + 4 * (c ^ ((n >> 2) & 7)));
        const int dn = PAIR ? ((n & 7) + 8 * ((n >> 4) & 1) + 128 * ((n >> 3) & 1)) : n;
        *(GAS v4u*)(WT + (drow0 + dn) * (size_t)KdB + k0 + 16 * c) = o; }
    LDS_WAIT(); asm volatile("" ::: "memory");
}
__device__ __forceinline__ int in_dest_row(int n0) {
    if (n0 < KCOL_DL + 768 && n0 >= QCOL_DL) { const int reg = (n0 - QCOL_DL) / 768, c = (n0 - QCOL_DL) % 768, tile = c >> 8, hd = (c & 255) >> 6, dh = (c & 63) >> 5;
        return QCOL_DL + reg * 768 + tile * 256 + dh * 128 + hd * 32; }
    return n0;
}
constexpr int ITEMS_IN = 32 * 96, ITEMS_OUT = 32 * 32, ITEMS_E = 768, ITEMS_LAYER = ITEMS_IN + ITEMS_OUT + 65 * ITEMS_E;

__device__ __forceinline__ void p0_prologue(Frame& F) {
    float* mod = (float*)(F.ws + WS_MOD);
    const float* Fc = inptr<const float>(F, I_C); const float* Fw_ada = inptr<const float>(F, I_WADA); const float* Fb_ada = inptr<const float>(F, I_BADA);
    {
        LAS float* cact = (LAS float*)(F.lds);
        LAS float* part = (LAS float*)(F.lds + 65536);
        for (int i = F.tid; i < NB * D; i += NWAVES * 64) { const float v = Fc[i]; cact[i] = v / (1.f + __expf(-v)); }
        __syncthreads();
        const int cg = F.tid & 7, kq = F.tid >> 3;
        for (int item = blockIdx.x; item < 768; item += F.G) {
            const int l = item / 384, col0 = (item % 384) * 32;
            f32x4 acc[8];
#pragma unroll
            for (int b = 0; b < 8; ++b) acc[b] = (f32x4){0.f, 0.f, 0.f, 0.f};
            const float* wp = Fw_ada + ((size_t)l * D) * 12288 + col0 + 4 * cg;
#pragma unroll 4
            for (int i = 0; i < 32; ++i) { const int k = kq + 64 * i; const f32x4 w4 = *(const GAS f32x4*)(wp + (size_t)k * 12288);
#pragma unroll
                for (int b = 0; b < 8; ++b) { const float cv = cact[b * D + k]; acc[b] += w4 * cv; } }
#pragma unroll
            for (int b = 0; b < 8; ++b) *(LAS f32x4*)(part + (kq * 8 + b) * 32 + 4 * cg) = acc[b];
            __syncthreads();
            if (F.tid < 256) { const int b = F.tid >> 5, col = F.tid & 31; float s = 0.f;
                for (int q = 0; q < 64; ++q) s += part[(q * 8 + b) * 32 + col];
                mod[((size_t)l * 8 + b) * 12288 + col0 + col] = s + Fb_ada[(size_t)l * 12288 + col0 + col]; }
            __syncthreads();
        }
    }
    {
        float* tab = (float*)(F.ws + WS_TAB); const int* Fpos = inptr<const int>(F, I_POS);
        for (int idx = blockIdx.x * (NWAVES * 64) + F.tid; idx < T * 32; idx += F.G * NWAVES * 64) {
            const int t = idx >> 5, i = idx & 31;
            const float inv = exp2f(-(float)i * (13.287712379549449f / 32.f));
            const float ang = (float)Fpos[t] * inv;
            double rev = (double)ang * 0.15915494309189535; rev -= __builtin_rint(rev);
            tab[(size_t)t * 64 + i] = __builtin_amdgcn_cosf((float)rev); tab[(size_t)t * 64 + 32 + i] = __builtin_amdgcn_sinf((float)rev);
        }
    }
    {
        const float* Fwr = inptr<const float>(F, I_WROUTER);
        for (int idx = blockIdx.x * (NWAVES * 64) + F.tid; idx < 2 * 128 * 2 * 64; idx += F.G * NWAVES * 64) {
            const int ln = idx & 63, nt = (idx >> 6) & 1, ks = (idx >> 7) & 127, l = idx >> 14;
            const int e = 32 * nt + (ln & 31), k0 = 16 * ks + 8 * (ln >> 5);
            float w[8]; unsigned hb[8], lb[8];
#pragma unroll
            for (int j = 0; j < 8; ++j) { w[j] = Fwr[((size_t)l * D + k0 + j) * NE + e]; hb[j] = f2bf(w[j]); lb[j] = f2bf(w[j] - __builtin_bit_cast(float, hb[j] << 16)); }
            v4u oh, ol; oh.x = hb[0] | (hb[1] << 16); oh.y = hb[2] | (hb[3] << 16); oh.z = hb[4] | (hb[5] << 16); oh.w = hb[6] | (hb[7] << 16);
            ol.x = lb[0] | (lb[1] << 16); ol.y = lb[2] | (lb[3] << 16); ol.z = lb[4] | (lb[5] << 16); ol.w = lb[6] | (lb[7] << 16);
            unsigned char* dst = F.ws + WS_WR + (size_t)l * 524288 + (size_t)((ks * 2 + nt) * 2) * 1024 + ln * 16;
            *(GAS v4u*)dst = oh; *(GAS v4u*)(dst + 1024) = ol;
        }
    }
    {
        const float* Fwi = inptr<const float>(F, I_WIN);
        for (int idx = blockIdx.x * (NWAVES * 64) + F.tid; idx < 2 * 128 * 64; idx += F.G * NWAVES * 64) {
            const int ln = idx & 63, ks = (idx >> 6) & 127, l = idx >> 13;
            const int n = ln & 31, k0 = 16 * ks + 8 * (ln >> 5);
            unsigned hb[8], lb[8];
#pragma unroll
            for (int j = 0; j < 8; ++j) { const float w = (n < NFOX) ? Fwi[((size_t)l * D + k0 + j) * INW + NPROJ + n] : 0.f; hb[j] = f2bf(w); lb[j] = f2bf(w - __builtin_bit_cast(float, hb[j] << 16)); }
            v4u oh, ol; oh.x = hb[0] | (hb[1] << 16); oh.y = hb[2] | (hb[3] << 16); oh.z = hb[4] | (hb[5] << 16); oh.w = hb[6] | (hb[7] << 16);
            ol.x = lb[0] | (lb[1] << 16); ol.y = lb[2] | (lb[3] << 16); ol.z = lb[4] | (lb[5] << 16); ol.w = lb[6] | (lb[7] << 16);
            unsigned char* dst = F.ws + WS_WF + (size_t)l * 262144 + (size_t)(ks * 2) * 1024 + ln * 16;
            *(GAS v4u*)dst = oh; *(GAS v4u*)(dst + 1024) = ol;
        }
    }
    {
        LAS unsigned* scr = (LAS unsigned*)(F.lds + RING_OFF + F.wave * 16384);
        const int gw = blockIdx.x * NWAVES + F.wave, NGW = F.G * NWAVES;
        for (int it = gw; it < 2 * ITEMS_LAYER; it += NGW) {
            const int l = 1 - it / ITEMS_LAYER; int r = ITEMS_LAYER - 1 - it % ITEMS_LAYER;
            bf16* WL = (bf16*)(F.ws + WS_W + (size_t)l * W_LAYER);
            if (r < ITEMS_IN) { const float* Fw_in = inptr<const float>(F, I_WIN); const int kb = r / 96, nb = r % 96;
                p0_transpose_item(Fw_in + (size_t)l * D * INW, INW, 64 * kb, 64 * nb, WL + W_IN_OFF / 2, in_dest_row(64 * nb), in_dest_row(64 * nb + 32), D, scr, F.lane); continue; }
            r -= ITEMS_IN;
            if (r < ITEMS_OUT) { const int kb = r / 64, nb = r % 64; const float* Fw_out = inptr<const float>(F, I_WOUT);
                p0_transpose_item8<false>(Fw_out + (size_t)l * D * D, D, 128 * kb, 32 * nb, F.ws + WS_W + (size_t)l * W_LAYER + W_OUT_OFF, (size_t)(32 * nb), D, (float)(1 << WSHIFT), scr, F.lane); continue; }
            r -= ITEMS_OUT;
            const int e = r / ITEMS_E, q = r % ITEMS_E;
            unsigned char* WLb = F.ws + WS_W + (size_t)l * W_LAYER;
            if (q < 512) { const int up = q >> 8, qq = q & 255, kb = qq / 16, nb = qq % 16, n0 = 32 * nb;
                const float* src = (e < NE) ? (inptr<const float>(F, up ? I_WEU : I_WEG) + ((size_t)l * NE + e) * D * EH) : (inptr<const float>(F, up ? I_WSU : I_WSG) + (size_t)l * D * EH);
                const size_t dr = (size_t)e * 1024 + (n0 >> 7) * 256 + up * 128 + (n0 & 127);
                p0_transpose_item8<false>(src, EH, 128 * kb, n0, WLb + W_1_OFF, dr, D, (float)(1 << WSHIFT), scr, F.lane);
            } else { const int qq = q - 512, kb = qq / 64, nb = qq % 64;
                const float* src = (e < NE) ? (inptr<const float>(F, I_WED) + ((size_t)l * NE + e) * EH * D) : (inptr<const float>(F, I_WSD) + (size_t)l * EH * D);
                { const int n0 = 32 * nb, o = n0 & 255; p0_transpose_item8<true>(src, D, 128 * kb, n0, WLb + W_2_OFF, (size_t)e * 2048 + (n0 & ~255) + 32 * (o >> 6) + 16 * ((o >> 5) & 1), EH, (float)(1 << WSHIFT), scr, F.lane); } }
        }
    }
}

__device__ __forceinline__ void prep_row_from_regs(Frame& F, const f32x4 (&xv)[8], int m, int l, const LAS float* wf) {
    const float* mod = (const float*)(F.ws + WS_MOD) + ((size_t)l * 8 + (m >> 11)) * 12288;
    bf16* hrow = (bf16*)(F.ws + WS_H) + (size_t)m * D;
    float fl[12];
#pragma unroll
    for (int j = 0; j < 12; ++j) fl[j] = 0.f;
#pragma unroll
    for (int j = 0; j < 8; ++j) { int k = 4 * F.lane + 256 * j; asm volatile("" : "+v"(k));
        const f32x4 sh = *(const GAS f32x4*)(mod + k), sc = *(const GAS f32x4*)(mod + 2048 + k);
        const f32x4 h = xv[j] * (sc + 1.0f) + sh;
        v2u o; o.x = pk2(h.x, h.y); o.y = pk2(h.z, h.w); *(GAS v2u*)(hrow + k) = o;
#pragma unroll
        for (int e = 0; e < 4; ++e) { const LAS f32x4* wr = (const LAS f32x4*)(wf + (k + e) * 12); const f32x4 a = wr[0], b = wr[1], c = wr[2]; const float hv = h[e];
            fl[0] += hv * a.x; fl[1] += hv * a.y; fl[2] += hv * a.z; fl[3] += hv * a.w; fl[4] += hv * b.x; fl[5] += hv * b.y; fl[6] += hv * b.z; fl[7] += hv * b.w;
            fl[8] += hv * c.x; fl[9] += hv * c.y; fl[10] += hv * c.z; fl[11] += hv * c.w; }
        asm volatile("" ::: "memory"); }
    float mine = 0.f;
#pragma unroll
    for (int j = 0; j < 12; ++j) { const float s = wave_sum(fl[j]); if (F.lane == j) mine = s; }
    if (F.lane < 12) ((float*)(F.ws + WS_FLOG))[(size_t)m * 16 + F.lane] = mine;
}
__device__ __forceinline__ void load_wf(Frame& F, int l, LAS float* wf) {
    const float* src = inptr<const float>(F, I_WIN) + (size_t)l * D * INW + NPROJ;
    for (int i = F.tid; i < D * 12; i += NWAVES * 64) { const int k = i / 12, j = i % 12; wf[i] = src[(size_t)k * INW + j]; }
    __syncthreads();
}

constexpr int APITCH = 64;
__device__ __forceinline__ size_t hm_off(int cs, int Hg, int b, int h) { return (size_t)NB * SEQ * cs + ((size_t)(b * Hg + h) * SEQ) * 64; }
namespace att {
typedef float f32x16 __attribute__((ext_vector_type(16)));
typedef short s16x4 __attribute__((ext_vector_type(4)));
typedef LAS unsigned char* lptr;
typedef float f32x2_t __attribute__((ext_vector_type(2))); typedef __bf16 bf16x2_t __attribute__((ext_vector_type(2)));
__device__ __forceinline__ unsigned cvtpk(float lo, float hi) { f32x2_t v = {lo, hi}; bf16x2_t b = __builtin_convertvector(v, bf16x2_t); return __builtin_bit_cast(unsigned, b); }
typedef short v4i16_t __attribute__((ext_vector_type(4)));
__device__ __forceinline__ s16x4 vtr(const LAS unsigned char* p) { return __builtin_bit_cast(s16x4, __builtin_amdgcn_ds_read_tr16_b64_v4i16((LAS v4i16_t*)p)); }
__device__ __forceinline__ int crow(int r, int hi) { return (r & 3) + 8 * (r >> 2) + 4 * hi; }
__device__ __forceinline__ float max3f(float a, float b, float c) { float r; asm("v_max3_f32 %0, %1, %2, %3" : "=v"(r) : "v"(a), "v"(b), "v"(c)); return r; }
__device__ __forceinline__ float max2f(float a, float b) { float r; asm("v_max_f32_e32 %0, %1, %2" : "=v"(r) : "v"(a), "v"(b)); return r; }
__device__ __forceinline__ float rowmax32(const f32x16& p0, const f32x16& p1) {
    float a = max3f(p0[0], p0[1], p1[0]), b = max3f(p0[2], p0[3], p1[1]); a = max3f(a, p1[2], p1[3]);
#pragma unroll
    for (int r = 4; r < 16; r += 4) { a = max3f(a, p0[r], p0[r + 1]); b = max3f(b, p0[r + 2], p0[r + 3]); a = max3f(a, p1[r], p1[r + 1]); b = max3f(b, p1[r + 2], p1[r + 3]); }
    return max2f(a, b);
}
__device__ __forceinline__ float rowmax16(const f32x16& p0) {
    float a = max3f(p0[0], p0[1], p0[2]), b = max3f(p0[3], p0[4], p0[5]);
    a = max3f(a, p0[6], p0[7]); b = max3f(b, p0[8], p0[9]); a = max3f(a, p0[10], p0[11]); b = max3f(b, p0[12], p0[13]); a = max3f(a, p0[14], p0[15]);
    return max2f(a, b);
}
__device__ __forceinline__ float pswap_max(float m) { auto rr = __builtin_amdgcn_permlane32_swap(__float_as_uint(m), __float_as_uint(m), false, false); return max2f(__uint_as_float(rr[0]), __uint_as_float(rr[1])); }

#define ATT_PACK8(P, B) __builtin_bit_cast(bf16x8, (v4u){cvtpk(P[B], P[B + 1]), cvtpk(P[B + 2], P[B + 3]), cvtpk(P[B + 4], P[B + 5]), cvtpk(P[B + 6], P[B + 7])})

template <int DHS>
__device__ __forceinline__ void pv_step(f32x16 (&o)[2], const LAS unsigned char* vb, int vsw, int s, bf16x8 pa) {
#pragma unroll
    for (int d0 = 0; d0 < 2; ++d0) {
        const s16x4 lo = vtr(vb + d0 * (DHS + vsw) + s * 1024), hi = vtr(vb + d0 * (DHS + vsw) + s * 1024 + 512);
        const bf16x8 vf = (bf16x8){lo[0], lo[1], lo[2], lo[3], hi[0], hi[1], hi[2], hi[3]};
        o[d0] = __builtin_amdgcn_mfma_f32_32x32x16_bf16(pa, vf, o[d0], 0, 0, 0);
    }
}
__device__ __forceinline__ void epilogue(const f32x16 (&o)[2], float linv_lane  , lptr wl, LAS float* wsf, const float* gn, unsigned char* orow0  ,
                                         int tok0, int tstride, int lane) {
    const int r32 = lane & 31, hi = lane >> 5;
    LAS float* stg = (LAS float*)wl;
#pragma unroll
    for (int r = 0; r < 16; ++r) { const int q = crow(r, hi); stg[q * 68 + r32] = o[0][r]; stg[q * 68 + 32 + r32] = o[1][r]; }
    if (hi == 0) wsf[r32] = linv_lane;
    LDS_WAIT(); asm volatile("" ::: "memory");
    const int row = lane >> 1, hf = lane & 1;
    const float li = wsf[row];
    f32x4 v[8]; float ss = 0.f;
#pragma unroll
    for (int i = 0; i < 8; ++i) { v[i] = *(const LAS f32x4*)(stg + row * 68 + hf * 32 + 4 * i) * li; ss += (v[i].x * v[i].x + v[i].y * v[i].y) + (v[i].z * v[i].z + v[i].w * v[i].w); }
    ss += __shfl_xor(ss, 1);
    const float rn = 1.0f / sqrtf(ss * (1.0f / 64.0f) + RMS_EPS);
    unsigned char* op = orow0 + (size_t)(tok0 + tstride * row) * D + hf * 32;
    const float rq = rn * 16.0f;
    unsigned wq[8];
#pragma unroll
    for (int i = 0; i < 4; ++i) { const f32x4 g0 = *(const GAS f32x4*)(gn + hf * 32 + 8 * i), g1 = *(const GAS f32x4*)(gn + hf * 32 + 8 * i + 4); const f32x4 a = v[2 * i] * rq * g0, b = v[2 * i + 1] * rq * g1;
        wq[2 * i] = pk4_fp8(a.x, a.y, a.z, a.w); wq[2 * i + 1] = pk4_fp8(b.x, b.y, b.z, b.w); }
    { v4u w0, w1; w0.x = wq[0]; w0.y = wq[1]; w0.z = wq[2]; w0.w = wq[3]; w1.x = wq[4]; w1.y = wq[5]; w1.z = wq[6]; w1.w = wq[7]; *(GAS v4u*)(op) = w0; *(GAS v4u*)(op + 16) = w1; }
    LDS_WAIT(); asm volatile("" ::: "memory");
}

__device__ __forceinline__ void qk64(f32x16& p0, f32x16& p1, const bf16x8 (&qr)[4], const LAS unsigned char* kf, const f32x16& c0, const f32x16& c1) {
    p0 = c0; p1 = c1;
#pragma unroll
    for (int d0 = 0; d0 < 4; ++d0) { const bf16x8 k0 = *(const LAS bf16x8*)(kf + d0 * 2048), k1 = *(const LAS bf16x8*)(kf + d0 * 2048 + 512);
        p0 = __builtin_amdgcn_mfma_f32_32x32x16_bf16(k0, qr[d0], p0, 0, 0, 0); p1 = __builtin_amdgcn_mfma_f32_32x32x16_bf16(k1, qr[d0], p1, 0, 0, 0); }
}
__device__ __forceinline__ void load_kf64(bf16x8 (&kf)[8], const LAS unsigned char* kt, int r32, int hi) {
#pragma unroll
    for (int d0 = 0; d0 < 4; ++d0) { const int ch = 2 * d0 + hi; const LAS unsigned char* p = kt + ch * 1024 + ((r32 ^ ch) << 4); kf[2 * d0] = *(const LAS bf16x8*)p; kf[2 * d0 + 1] = *(const LAS bf16x8*)(p + 512); }
}
template <bool ZC>
__device__ __forceinline__ void qk64_regs(f32x16& p0, f32x16& p1, const bf16x8 (&qr)[4], const bf16x8 (&kf)[8], const f32x16& c0, const f32x16& c1) {
    if (ZC) { p0 = f32x16{}; p1 = f32x16{}; } else { p0 = c0; p1 = c1; }
#pragma unroll
    for (int d0 = 0; d0 < 4; ++d0) { p0 = __builtin_amdgcn_mfma_f32_32x32x16_bf16(kf[2 * d0], qr[d0], p0, 0, 0, 0); p1 = __builtin_amdgcn_mfma_f32_32x32x16_bf16(kf[2 * d0 + 1], qr[d0], p1, 0, 0, 0); }
}
__device__ __forceinline__ void load_vf64(bf16x8 (&vf)[8], const LAS unsigned char* vb) {
#pragma unroll
    for (int s = 0; s < 4; ++s)
#pragma unroll
        for (int d0 = 0; d0 < 2; ++d0) { const s16x4 lo = vtr(vb + d0 * 4096 + s * 1024), hi = vtr(vb + d0 * 4096 + s * 1024 + 512);
            vf[2 * s + d0] = (bf16x8){lo[0], lo[1], lo[2], lo[3], hi[0], hi[1], hi[2], hi[3]}; }
}
__device__ __forceinline__ void rescale_o(f32x16 (&o)[2], float alpha, LAS float* wsf, int r32, int hi) {
    if (hi == 0) wsf[r32] = alpha;
    LDS_WAIT(); asm volatile("" ::: "memory");
#pragma unroll
    for (int j = 0; j < 4; ++j) { const f32x4 a = *(const LAS f32x4*)(wsf + 8 * j + 4 * hi);
#pragma unroll
        for (int e = 0; e < 4; ++e) { o[0][4 * j + e] *= a[e]; o[1][4 * j + e] *= a[e]; } }
    LDS_WAIT(); asm volatile("" ::: "memory");
}
constexpr float RESC_THR = 8.0f;

__device__ __forceinline__ void fox_softmax(f32x16& p0, f32x16& p1, f32x16 (&o)[2], float& mrun, float& lrun, int kv0, int qtok, bool diag, LAS float* wsf, int r32, int hi) {
    if (__builtin_amdgcn_readfirstlane((int)diag)) {
#pragma unroll
        for (int r = 0; r < 16; ++r) { const int kv = kv0 + (r & 3) + 8 * (r >> 2); if (kv > qtok) p0[r] = -INFINITY; if (kv + 32 > qtok) p1[r] = -INFINITY; } }
    float mt = pswap_max(rowmax32(p0, p1));
    if (__any(mt > mrun + RESC_THR)) { const float mnew = max2f(mrun, mt), alpha = __builtin_amdgcn_exp2f(mrun - mnew); mrun = mnew; lrun *= alpha; rescale_o(o, alpha, wsf, r32, hi); }
    float rs = 0.f;
#pragma unroll
    for (int r = 0; r < 16; ++r) { p0[r] = __builtin_amdgcn_exp2f(p0[r] - mrun); p1[r] = __builtin_amdgcn_exp2f(p1[r] - mrun); rs += p0[r] + p1[r]; }
    lrun += rs;
}
__device__ __forceinline__ void sb_weights(f32x16& p0, f32x16& p1, float& R, int kv0, int qtok, bool diag, int hi) {
    float run = 1.f;
#pragma unroll
    for (int hh = 1; hh >= 0; --hh)
#pragma unroll
        for (int j = 3; j >= 0; --j) {
            float kk[4], bb[4];
#pragma unroll
            for (int e = 0; e < 4; ++e) { const float y = hh ? p1[4 * j + e] : p0[4 * j + e]; float yc; asm("v_min_f32_e32 %0, 0x42a00000, %1" : "=v"(yc) : "v"(y)); const float ex = __builtin_amdgcn_exp2f(yc); kk[e] = __builtin_amdgcn_rcpf(1.0f + ex); bb[e] = ex * kk[e];
                if (diag) { const int kv = kv0 + 32 * hh + 8 * j + e; if (kv >= qtok) { kk[e] = 1.f; bb[e] = 0.f; } } }
            const float s2 = kk[3], s1 = kk[3] * kk[2], s0 = s1 * kk[1], Gp = s0 * kk[0];
            auto rr = __builtin_amdgcn_permlane32_swap(__float_as_uint(Gp), __float_as_uint(Gp), false, false);
            const float ga = __uint_as_float(rr[0]), gb = __uint_as_float(rr[1]);
            const float after = R * run * (hi ? 1.0f : gb);
            if (hh) { p1[4 * j] = bb[0] * after * s0; p1[4 * j + 1] = bb[1] * after * s1; p1[4 * j + 2] = bb[2] * after * s2; p1[4 * j + 3] = bb[3] * after; }
            else { p0[4 * j] = bb[0] * after * s0; p0[4 * j + 1] = bb[1] * after * s1; p0[4 * j + 2] = bb[2] * after * s2; p0[4 * j + 3] = bb[3] * after; }
            run *= ga * gb;
        }
    R *= run;
}

template <int TYPE>
__device__ __forceinline__ void causal_wg_unit(const bf16* proj, const float* cum2, const float* gn, unsigned char* obuf, int b, int h, int qb, LAS unsigned char* kvbuf, LAS float* ncum, lptr wl, LAS float* wsf, int tid, int wave) {
    const int lane = tid & 63, r32 = lane & 31, hi = lane >> 5;
    constexpr int QC = TYPE == 0 ? QCOL_SB : QCOL_FX, KC = TYPE == 0 ? KCOL_SB : KCOL_FX, VC = TYPE == 0 ? VCOL_SB : VCOL_FX;
    constexpr int HG = TYPE == 0 ? 8 : 12;
    const bf16* Qp = proj + hm_off(QC, HG, b, h); const bf16* Kp = proj + hm_off(KC, HG, b, h); const bf16* Vp = proj + hm_off(VC, HG, b, h);
    const int qt = 8 * qb + wave, qtok = 32 * qt + r32;
    bf16x8 qr[4];
#pragma unroll
    for (int d0 = 0; d0 < 4; ++d0) qr[d0] = *(const GAS bf16x8*)(Qp + (size_t)qtok * APITCH + d0 * 16 + hi * 8);
    const int NT = 4 * qb + 4, my_tlast = qt >> 1;
    const unsigned lvoff = (unsigned)(((tid >> 3) * APITCH + (tid & 7) * 8) * 2);
    const int skey = tid >> 3, sch = tid & 7;
    const int kst = sch * 1024 + ((skey ^ sch) << 4), vst = 8192 + (sch >> 2) * 4096 + ((skey ^ (sch >> 2)) << 6) + (sch & 3) * 16;
    v4u kreg, vreg;
#define ATT_TILE(s_) (TYPE == 0 ? NT - 1 - (s_) : (s_))
#define ATT_LOAD(t) do { kreg = *(const GAS v4u*)((const char*)(Kp + (size_t)(64 * (t)) * APITCH) + lvoff); vreg = *(const GAS v4u*)((const char*)(Vp + (size_t)(64 * (t)) * APITCH) + lvoff); } while (0)
#define ATT_STORE(slot) do { *(LAS v4u*)(kvbuf + (slot) * 16384 + kst) = kreg; *(LAS v4u*)(kvbuf + (slot) * 16384 + vst) = vreg; } while (0)
    if (TYPE == 1) { const int n = 256 * (qb + 1); if (4 * tid < n) { const f32x4 c = *(const GAS f32x4*)(cum2 + 4 * tid); v4u w;
#pragma unroll
        for (int e = 0; e < 4; ++e) { const float v = -c[e]; const unsigned hb = f2bf(v); const unsigned lb = f2bf(v - __builtin_bit_cast(float, hb << 16)); w[e] = hb | (lb << 16); }
        *(LAS v4u*)(ncum + 4 * tid) = w; } }
    const bf16x8 qone = hi ? (bf16x8){0, 0, 0, 0, 0, 0, 0, 0} : (bf16x8){(short)0x3f80, (short)0x3f80, 0, 0, 0, 0, 0, 0};
    f32x16 o[2]; o[0] = f32x16{}; o[1] = f32x16{};
    float mrun = -1e30f, lrun = 0.f, R = 1.f;
    const int vbo = 8192 + ((lane >> 4) & 1) * 32 + (lane & 3) * 8 + (4 * hi + ((lane & 15) >> 2)) * 64, vsw = ((lane >> 2) & 1) ? -64 : 64;
    ATT_LOAD(ATT_TILE(0)); ATT_STORE(0);
    ATT_LOAD(ATT_TILE(1)); ATT_STORE(1);
    __syncthreads();
    f32x16 pc0 = f32x16{}, pc1 = f32x16{}, pn0 = f32x16{}, pn1 = f32x16{};
#define ATT_QK(P0, P1, s_) do { const int t_ = ATT_TILE(s_); const LAS unsigned char* kb_ = kvbuf + ((s_) % 3) * 16384; \
        if (TYPE == 1) { const LAS unsigned* cw_ = (const LAS unsigned*)ncum + 64 * t_ + r32; const unsigned w0_ = hi ? 0u : cw_[0], w1_ = hi ? 0u : cw_[32]; \
            const bf16x8 ka_ = __builtin_bit_cast(bf16x8, (v4u){w0_, 0u, 0u, 0u}), kb2_ = __builtin_bit_cast(bf16x8, (v4u){w1_, 0u, 0u, 0u}); \
            bf16x8 kf_[8]; load_kf64(kf_, kb_, r32, hi); \
            f32x16 c0_ = __builtin_amdgcn_mfma_f32_32x32x16_bf16(ka_, qone, f32x16{}, 0, 0, 0), c1_ = __builtin_amdgcn_mfma_f32_32x32x16_bf16(kb2_, qone, f32x16{}, 0, 0, 0); \
            qk64_regs<false>(P0, P1, qr, kf_, c0_, c1_); } \
        else { bf16x8 kf_[8]; load_kf64(kf_, kb_, r32, hi); qk64_regs<true>(P0, P1, qr, kf_, P0, P1); } } while (0)
    if (ATT_TILE(0) <= my_tlast) ATT_QK(pc0, pc1, 0);
    constexpr float SB_DEAD = 1e-30f;
    bool dead = false;
    LAS int* aflag = (LAS int*)ncum;
    for (int s = 0; s < NT; ++s) {
        const int t = ATT_TILE(s);
        if (s + 2 < NT) ATT_LOAD(ATT_TILE(s + 2));
        const bool act = !dead && t <= my_tlast, actn = !dead && (s + 1 < NT) && (ATT_TILE(s + 1) <= my_tlast);
        if (actn) ATT_QK(pn0, pn1, s + 1);
        if (act) {
            const int kv0 = 64 * t + 4 * hi; const bool diag = (t == my_tlast);
            if (TYPE == 1) fox_softmax(pc0, pc1, o, mrun, lrun, kv0, qtok, diag, wsf, r32, hi);
            else sb_weights(pc0, pc1, R, kv0, qtok, diag, hi);
            const bf16x8 pa0 = ATT_PACK8(pc0, 0), pa1 = ATT_PACK8(pc0, 8), pa2 = ATT_PACK8(pc1, 0), pa3 = ATT_PACK8(pc1, 8);
            const LAS unsigned char* vb = kvbuf + (s % 3) * 16384 + vbo;
            pv_step<4096>(o, vb, vsw, 0, pa0); pv_step<4096>(o, vb, vsw, 1, pa1); pv_step<4096>(o, vb, vsw, 2, pa2); pv_step<4096>(o, vb, vsw, 3, pa3);
        }
        if (s + 2 < NT) ATT_STORE((s + 2) % 3);
        if (TYPE == 0) { if (act && !__any(R >= SB_DEAD)) dead = true; if (lane == 0) aflag[(s & 1) * 8 + wave] = dead ? 0 : 1; }
        __syncthreads();
        if (TYPE == 0) { const v4u f0 = *(const LAS v4u*)(aflag + (s & 1) * 8), f1 = *(const LAS v4u*)(aflag + (s & 1) * 8 + 4);
            if (((f0.x | f0.y) | (f0.z | f0.w) | (f1.x | f1.y) | (f1.z | f1.w)) == 0u) break; }
        pc0 = pn0; pc1 = pn1;
    }
#undef ATT_QK
#undef ATT_TILE
#undef ATT_LOAD
#undef ATT_STORE
    float linv = 1.0f;
    if (TYPE == 1) { auto rr = __builtin_amdgcn_permlane32_swap(__float_as_uint(lrun), __float_as_uint(lrun), false, false); linv = 1.0f / (__uint_as_float(rr[0]) + __uint_as_float(rr[1])); }
    const int headcol = TYPE == 0 ? h : 8 + h;
    epilogue(o, linv, wl, wsf, gn + headcol * 64, obuf + (size_t)b * SEQ * D + headcol * 64, 32 * qt, 1, lane);
}

__device__ __forceinline__ void qk32(f32x16& p0, const bf16x8 (&qr)[4], const LAS unsigned char* kt, int r32, int hi) {
    p0 = f32x16{};
#pragma unroll
    for (int d0 = 0; d0 < 4; ++d0) { const int ch = 2 * d0 + hi; const bf16x8 k0 = *(const LAS bf16x8*)(kt + ch * 512 + ((r32 ^ ch) << 4)); p0 = __builtin_amdgcn_mfma_f32_32x32x16_bf16(k0, qr[d0], p0, 0, 0, 0); }
}
__device__ __forceinline__ void dil_softmax_pv(f32x16& p0, f32x16 (&o)[2], float& mrun, float& lrun, const LAS unsigned char* vb, int vsw, int jq, int jb, LAS float* wsf, int r32, int hi) {
#pragma unroll
    for (int r = 0; r < 16; ++r) { const int dist = jq - (jb + (r & 3) + 8 * (r >> 2)); if ((unsigned)dist > 128u) p0[r] = -INFINITY; }
    float mt = pswap_max(rowmax16(p0));
    if (__any(mt > mrun + RESC_THR)) { const float mnew = max2f(mrun, mt), alpha = __builtin_amdgcn_exp2f(mrun - mnew); mrun = mnew; lrun *= alpha; rescale_o(o, alpha, wsf, r32, hi); }
    float rs = 0.f;
#pragma unroll
    for (int r = 0; r < 16; ++r) { p0[r] = __builtin_amdgcn_exp2f(p0[r] - mrun); rs += p0[r]; }
    lrun += rs;
    const bf16x8 pa0 = ATT_PACK8(p0, 0), pa1 = ATT_PACK8(p0, 8);
    pv_step<2048>(o, vb, vsw, 0, pa0); pv_step<2048>(o, vb, vsw, 1, pa1);
}
#define DILP_LOAD(sh_, rst_, tt_) do { const unsigned lvo_ = (unsigned)((((lane >> 3) << (sh_)) * APITCH + (lane & 7) * 8) * 2); const size_t tok0_ = (size_t)((rst_) + ((32 * (tt_)) << (sh_))); \
        const char* kb_ = (const char*)(Kp + tok0_ * APITCH); const char* vb_ = (const char*)(Vp + tok0_ * APITCH); const size_t is_ = (size_t)(8 << (sh_)) * APITCH * 2; \
        _Pragma("unroll") for (int i = 0; i < 4; ++i) { kreg[i] = *(const GAS v4u*)(kb_ + i * is_ + lvo_); vreg[i] = *(const GAS v4u*)(vb_ + i * is_ + lvo_); } } while (0)
#define DILP_STORE() do { _Pragma("unroll") for (int i = 0; i < 4; ++i) { const int id = lane + 64 * i, key = id >> 3, ch = id & 7; \
        *(LAS v4u*)(wl + ch * 512 + ((key ^ ch) << 4)) = kreg[i]; *(LAS v4u*)(wl + 4096 + (ch >> 2) * 2048 + ((key ^ (ch >> 2)) << 6) + (ch & 3) * 16) = vreg[i]; } } while (0)
__device__ __forceinline__ void dil_a_unit(const bf16* proj, bf16* SO, float* SM, gu32* done, int b, int h, int qb, lptr wl, LAS float* wsf, int tid, int wave) {
    const int lane = tid & 63, r32 = lane & 31, hi = lane >> 5;
    const bf16* Qp = proj + hm_off(QCOL_DL, 12, b, h); const bf16* Kp = proj + hm_off(KCOL_DL, 12, b, h); const bf16* Vp = proj + hm_off(VCOL_DL, 12, b, h);
    const int qt = 8 * qb + wave, qtok = 32 * qt + r32;
    bf16x8 qr[4];
#pragma unroll
    for (int d0 = 0; d0 < 4; ++d0) qr[d0] = *(const GAS bf16x8*)(Qp + (size_t)qtok * APITCH + d0 * 16 + hi * 8);
    f32x16 o[2]; o[0] = f32x16{}; o[1] = f32x16{};
    float mrun = -1e30f, lrun = 0.f;
    const int vbo = 4096 + ((lane >> 4) & 1) * 32 + (lane & 3) * 8 + (4 * hi + ((lane & 15) >> 2)) * 64, vsw = ((lane >> 2) & 1) ? -64 : 64;
    v4u kreg[4], vreg[4];
    int tt = qt > 4 ? qt - 4 : 0;
    DILP_LOAD(0, 0, tt);
    for (;;) {
        DILP_STORE();
        const int jb = 32 * tt + 4 * hi; const bool more = tt < qt;
        if (more) { ++tt; DILP_LOAD(0, 0, tt); }
        f32x16 p0; qk32(p0, qr, wl, r32, hi);
        dil_softmax_pv(p0, o, mrun, lrun, wl + vbo, vsw, qtok, jb, wsf, r32, hi);
        if (!more) break;
    }
    { auto rr = __builtin_amdgcn_permlane32_swap(__float_as_uint(lrun), __float_as_uint(lrun), false, false); lrun = __uint_as_float(rr[0]) + __uint_as_float(rr[1]); }
    const size_t srow0 = ((size_t)(b * 12 + h) * SEQ + 32 * qt);
    if (hi == 0) __hip_atomic_store((unsigned long long*)(SM + (srow0 + r32) * 2), ((unsigned long long)__float_as_uint(lrun) << 32) | __float_as_uint(mrun), RLX_AGENT);
    LAS float* stg = (LAS float*)wl;
#pragma unroll
    for (int r = 0; r < 16; ++r) { const int q = crow(r, hi); stg[q * 68 + r32] = o[0][r]; stg[q * 68 + 32 + r32] = o[1][r]; }
    LDS_WAIT(); asm volatile("" ::: "memory");
    { const int row = lane >> 1, hf = lane & 1; bf16* op = SO + (srow0 + row) * 64 + hf * 32;
#pragma unroll
      for (int i = 0; i < 4; ++i) { const f32x4 a = *(const LAS f32x4*)(stg + row * 68 + hf * 32 + 8 * i), c = *(const LAS f32x4*)(stg + row * 68 + hf * 32 + 8 * i + 4);
          v4u w; w.x = pk2(a.x, a.y); w.y = pk2(a.z, a.w); w.z = pk2(c.x, c.y); w.w = pk2(c.z, c.w);
          asm volatile("global_store_dwordx4 %0, %1, off sc1" :: "v"(op + 8 * i), "v"(w) : "memory"); } }
    LDS_WAIT();
    asm volatile("s_waitcnt vmcnt(0)" ::: "memory");
    __syncthreads();
    if (tid == 0) __hip_atomic_fetch_add(done, 1u, RLX_AGENT);
}
__device__ __forceinline__ void dil_b_unit(const bf16* proj, const bf16* SO, const float* SM, gu32* done, gu32* tmo, const float* gn, unsigned char* obuf, int b, int h, int blk, int half, lptr wl, LAS float* wsf, int tid, int wave) {
    const int lane = tid & 63, r32 = lane & 31, hi = lane >> 5, r16 = 8 * half + wave;
    if (tid == 0) { unsigned sp = 0; while (__hip_atomic_load(done, RLX_AGENT) < 2u) { __builtin_amdgcn_s_sleep(2); if (++sp > (1u << 22)) { __hip_atomic_store(tmo, 1u, RLX_AGENT); break; } }
        __builtin_amdgcn_fence(__ATOMIC_ACQUIRE, "agent"); asm volatile("s_waitcnt vmcnt(0)" ::: "memory"); }
    __syncthreads();
    const bf16* Qp = proj + hm_off(QCOL_DL, 12, b, h); const bf16* Kp = proj + hm_off(KCOL_DL, 12, b, h); const bf16* Vp = proj + hm_off(VCOL_DL, 12, b, h);
    const int p0tok = 512 * blk + r16;
    bf16x8 qr[4];
#pragma unroll
    for (int d0 = 0; d0 < 4; ++d0) qr[d0] = *(const GAS bf16x8*)(Qp + (size_t)(p0tok + 16 * r32) * APITCH + d0 * 16 + hi * 8);
    const size_t srow0 = (size_t)(b * 12 + h) * SEQ + p0tok;
    const f32x2_t ml = *(const GAS f32x2_t*)(SM + (srow0 + 16 * r32) * 2);
    float mrun = ml.x, lrun = hi ? 0.f : ml.y;
    f32x16 o[2];
    { LAS float* stg = (LAS float*)wl; const int row = lane >> 1, hf = lane & 1; const bf16* ip = SO + (srow0 + 16 * row) * 64 + hf * 32;
#pragma unroll
      for (int i = 0; i < 4; ++i) { const v4u w = *(const GAS v4u*)(ip + 8 * i);
          *(LAS f32x4*)(stg + row * 68 + hf * 32 + 8 * i) = (f32x4){bflo(w.x), bfhi(w.x), bflo(w.y), bfhi(w.y)}; *(LAS f32x4*)(stg + row * 68 + hf * 32 + 8 * i + 4) = (f32x4){bflo(w.z), bfhi(w.z), bflo(w.w), bfhi(w.w)}; }
      LDS_WAIT(); asm volatile("" ::: "memory");
#pragma unroll
      for (int r = 0; r < 16; ++r) { const int q = crow(r, hi); o[0][r] = stg[q * 68 + r32]; o[1][r] = stg[q * 68 + 32 + r32]; }
      LDS_WAIT(); asm volatile("" ::: "memory"); }
    const int vbo = 4096 + ((lane >> 4) & 1) * 32 + (lane & 3) * 8 + (4 * hi + ((lane & 15) >> 2)) * 64, vsw = ((lane >> 2) & 1) ? -64 : 64;
    {
        int sh = 2, rst = r16 & 3, jq0 = (p0tok - rst) >> 2, dj = 4;
        int tt = (jq0 > 128 ? jq0 - 128 : 0) >> 5, thi = (jq0 + dj * 31) >> 5;
        v4u kreg[4], vreg[4];
        DILP_LOAD(sh, rst, tt);
        for (;;) {
            DILP_STORE();
            const int jq = jq0 + dj * r32, jb = 32 * tt + 4 * hi;
            bool more = true;
            if (tt < thi) ++tt;
            else if (sh == 2) { sh = 4; rst = r16; jq0 = (p0tok - rst) >> 4; dj = 1; tt = (jq0 > 128 ? jq0 - 128 : 0) >> 5; thi = (jq0 + 31) >> 5; }
            else more = false;
            if (more) DILP_LOAD(sh, rst, tt);
            f32x16 p0; qk32(p0, qr, wl, r32, hi);
            dil_softmax_pv(p0, o, mrun, lrun, wl + vbo, vsw, jq, jb, wsf, r32, hi);
            if (!more) break;
        }
    }
    auto rr = __builtin_amdgcn_permlane32_swap(__float_as_uint(lrun), __float_as_uint(lrun), false, false);
    const float linv = 1.0f / (__uint_as_float(rr[0]) + __uint_as_float(rr[1]));
    epilogue(o, linv, wl, wsf, gn + (20 + h) * 64, obuf + (size_t)b * SEQ * D + (20 + h) * 64, p0tok, 16, lane);
}
__device__ __forceinline__ void sb_wave_unit(const bf16* proj, const float* gn, unsigned char* obuf, int b, int h, int qt, lptr wl, LAS float* wsf, int lane) {
    const int r32 = lane & 31, hi = lane >> 5;
    const bf16* Qp = proj + hm_off(QCOL_SB, 8, b, h); const bf16* Kp = proj + hm_off(KCOL_SB, 8, b, h); const bf16* Vp = proj + hm_off(VCOL_SB, 8, b, h);
    const int qtok = 32 * qt + r32;
    bf16x8 qr[4];
#pragma unroll
    for (int d0 = 0; d0 < 4; ++d0) qr[d0] = *(const GAS bf16x8*)(Qp + (size_t)qtok * APITCH + d0 * 16 + hi * 8);
    f32x16 o[2]; o[0] = f32x16{}; o[1] = f32x16{};
    float R = 1.f;
    const int vbo = 4096 + ((lane >> 4) & 1) * 32 + (lane & 3) * 8 + (4 * hi + ((lane & 15) >> 2)) * 64, vsw = ((lane >> 2) & 1) ? -64 : 64;
    v4u kreg[4], vreg[4];
    int tt = qt;
    DILP_LOAD(0, 0, tt);
    for (;;) {
        DILP_STORE();
        const int kv0 = 32 * tt + 4 * hi; const bool diag = (tt == qt), more = tt > 0;
        if (more) { DILP_LOAD(0, 0, tt - 1); }
        f32x16 p0; qk32(p0, qr, wl, r32, hi);
        asm volatile("s_nop 15\n\ts_nop 7" : "+v"(p0));
        float run = 1.f;
#pragma unroll
        for (int j = 3; j >= 0; --j) {
            float kk[4], bb[4];
#pragma unroll
            for (int e = 0; e < 4; ++e) { float yc; asm("v_min_f32_e32 %0, 0x42a00000, %1" : "=v"(yc) : "v"(p0[4 * j + e])); const float ex = __builtin_amdgcn_exp2f(yc); kk[e] = __builtin_amdgcn_rcpf(1.0f + ex); bb[e] = ex * kk[e];
                if (diag) { const int kv = kv0 + 8 * j + e; if (kv >= qtok) { kk[e] = 1.f; bb[e] = 0.f; } } }
            const float s2 = kk[3], s1 = kk[3] * kk[2], s0 = s1 * kk[1], Gp = s0 * kk[0];
            auto rr = __builtin_amdgcn_permlane32_swap(__float_as_uint(Gp), __float_as_uint(Gp), false, false);
            const float ga = __uint_as_float(rr[0]), gb = __uint_as_float(rr[1]);
            const float after = R * run * (hi ? 1.0f : gb);
            p0[4 * j] = bb[0] * after * s0; p0[4 * j + 1] = bb[1] * after * s1; p0[4 * j + 2] = bb[2] * after * s2; p0[4 * j + 3] = bb[3] * after;
            run *= ga * gb;
        }
        R *= run;
        const bf16x8 pa0 = ATT_PACK8(p0, 0), pa1 = ATT_PACK8(p0, 8);
        pv_step<2048>(o, wl + vbo, vsw, 0, pa0); pv_step<2048>(o, wl + vbo, vsw, 1, pa1);
        if (!more || !__any(R >= 1e-30f)) break;
        --tt;
    }
    epilogue(o, 1.0f, wl, wsf, gn + h * 64, obuf + (size_t)b * SEQ * D + h * 64, 32 * qt, 1, lane);
}
#undef DILP_LOAD
#undef DILP_STORE
#undef ATT_PACK8
}

using pg8::Unit; using pg8::HALF; using pg8::BM; using pg8::cvt_pk_bf16;
struct EpiProj {
    static constexpr bool PERM = true;
    bf16* O; const float* tab;
    __device__ __forceinline__ bf16* dst(int row, int c) const {
        const int cs = c < 1536 ? (c >> 9) << 9 : 1536 + ((c - 1536) / 768) * 768, Hg = c < 1536 ? 8 : 12;
        const int hl = (c - cs) >> 6, d = c & 63, b = row >> 11, sq = row & 2047;
        return O + (size_t)NB * SEQ * cs + ((size_t)(b * Hg + hl) * SEQ + sq) * 64 + d;
    }
    __device__ __forceinline__ void operator()(const f32x4 (&acc)[2][2][4][2], const Unit& u, int wr, int wc, int fr, int fq) const {
        const int row0 = u.pm * BM + wr * 64 + fr, pn = u.pn;
        const bool isq = (pn < 2) || (pn >= 6 && pn < 9) || (pn >= 15 && pn < 18);
        const float sc = isq ? C2 : 1.0f;
        if (pn >= 15 && pn < 21) {
            const int col = pn * 256 + wc * 64 + 8 * fq;
            f32x4 tn[4];
            { const float* tr = tab + (size_t)row0 * 64 + 8 * fq; tn[0] = *(const GAS f32x4*)(tr); tn[1] = *(const GAS f32x4*)(tr + 4); tn[2] = *(const GAS f32x4*)(tr + 32); tn[3] = *(const GAS f32x4*)(tr + 36); }
#pragma unroll
            for (int ai = 0; ai < 2; ++ai)
#pragma unroll
                for (int m = 0; m < 4; ++m) { const int row = row0 + ai * HALF + m * 16;
                    const f32x4 c0 = tn[0], c1 = tn[1], s0 = tn[2], s1 = tn[3];
                    if (ai * 4 + m < 7) { const int rown = row0 + ((ai * 4 + m + 1) >> 2) * HALF + ((ai * 4 + m + 1) & 3) * 16; const float* tr = tab + (size_t)rown * 64 + 8 * fq;
                        tn[0] = *(const GAS f32x4*)(tr); tn[1] = *(const GAS f32x4*)(tr + 4); tn[2] = *(const GAS f32x4*)(tr + 32); tn[3] = *(const GAS f32x4*)(tr + 36); }
                    const f32x4 a0 = acc[ai][0][m][0] * sc, a1 = acc[ai][0][m][1] * sc, b0 = acc[ai][1][m][0] * sc, b1 = acc[ai][1][m][1] * sc;
                    const f32x4 l0 = a0 * c0 - b0 * s0, l1 = a1 * c1 - b1 * s1, h0 = a0 * s0 + b0 * c0, h1 = a1 * s1 + b1 * c1;
                    pg8::u32x4 wl, wh; wl.x = cvt_pk_bf16(l0[0], l0[1]); wl.y = cvt_pk_bf16(l0[2], l0[3]); wl.z = cvt_pk_bf16(l1[0], l1[1]); wl.w = cvt_pk_bf16(l1[2], l1[3]);
                    wh.x = cvt_pk_bf16(h0[0], h0[1]); wh.y = cvt_pk_bf16(h0[2], h0[3]); wh.z = cvt_pk_bf16(h1[0], h1[1]); wh.w = cvt_pk_bf16(h1[2], h1[3]);
                    bf16* rp = dst(row, col); *(pg8::u32x4*)rp = wl; *(pg8::u32x4*)(rp + 32) = wh;
                    asm volatile("" ::: "memory"); }
        } else {
            const int col0 = pn * 256 + wc * 32 + 8 * fq;
#pragma unroll
            for (int ai = 0; ai < 2; ++ai)
#pragma unroll
                for (int m = 0; m < 4; ++m) { const int row = row0 + ai * HALF + m * 16;
#pragma unroll
                    for (int bj = 0; bj < 2; ++bj) { const f32x4 v0 = acc[ai][bj][m][0] * sc, v1 = acc[ai][bj][m][1] * sc;
                        pg8::u32x4 w; w.x = cvt_pk_bf16(v0[0], v0[1]); w.y = cvt_pk_bf16(v0[2], v0[3]); w.z = cvt_pk_bf16(v1[0], v1[1]); w.w = cvt_pk_bf16(v1[2], v1[3]);
                        *(pg8::u32x4*)dst(row, col0 + bj * HALF) = w; } }
        }
    }
};
struct EpiMix {
    static constexpr bool PERM = true;
    bf16* O;
    __device__ __forceinline__ void operator()(const f32x4 (&acc)[2][2][4][2], const Unit& u, int wr, int wc, int fr, int fq) const {
        const int row0 = u.pm * BM + wr * 64 + fr, col0 = u.pn * BM + wc * 32 + 8 * fq;
#pragma unroll
        for (int ai = 0; ai < 2; ++ai)
#pragma unroll
            for (int m = 0; m < 4; ++m) { bf16* rowp = O + (size_t)(row0 + ai * HALF + m * 16) * D + col0;
#pragma unroll
                for (int bj = 0; bj < 2; ++bj) { const f32x4 v0 = acc[ai][bj][m][0], v1 = acc[ai][bj][m][1];
                    pg8::u32x4 w; w.x = cvt_pk_bf16(v0[0], v0[1]); w.y = cvt_pk_bf16(v0[2], v0[3]); w.z = cvt_pk_bf16(v1[0], v1[1]); w.w = cvt_pk_bf16(v1[2], v1[3]);
                    *(pg8::u32x4*)(rowp + bj * HALF) = w; } }
    }
};
struct EpiSwiglu {
    static constexpr bool PERM = true;
    unsigned char* O;
    __device__ __forceinline__ void operator()(const f32x4 (&acc)[2][2][4][2], const Unit& u, int wr, int wc, int fr, int fq) const {
        const int row0 = u.pm * BM + wr * 64 + fr, col0 = (u.pn & 3) * 128 + wc * 32 + 8 * fq;
#pragma unroll
        for (int ai = 0; ai < 2; ++ai)
#pragma unroll
            for (int m = 0; m < 4; ++m) { float r[8];
#pragma unroll
                for (int n = 0; n < 2; ++n)
#pragma unroll
                    for (int e = 0; e < 4; ++e) { const float g = acc[ai][0][m][n][e], up = acc[ai][1][m][n][e]; r[4 * n + e] = g * __builtin_amdgcn_rcpf(1.0f + __builtin_amdgcn_exp2f(-g * LOG2E)) * up * (float)(1 << ASHIFT); }
                v2u w; w.x = pk4_fp8(r[0], r[1], r[2], r[3]); w.y = pk4_fp8(r[4], r[5], r[6], r[7]);
                *(v2u*)(O + (size_t)(row0 + ai * HALF + m * 16) * EH + col0) = w; }
    }
};
struct EpiDown {
    static constexpr bool PERM = true;
    unsigned char* O;
    const LAS int* tileE; const LAS int* tb; const LAS int* cnt; const int* list2;
    __device__ __forceinline__ void operator()(const f32x4 (&acc)[2][2][4][2], const Unit& u, int wr, int wc, int fr, int fq) const {
        const int col0 = (u.pn & 7) * 256 + wc * 64 + 16 * fq;
        const int e = tileE[u.pm], lbase = (u.pm - tb[e]) * 256 + wr * 64 + fr, ce = cnt[e];
        const float ysc = (float)(1 << YSHIFT);
        int drow[2][4];
#pragma unroll
        for (int ai = 0; ai < 2; ++ai)
#pragma unroll
            for (int m = 0; m < 4; ++m) { const int local = lbase + ai * HALF + m * 16; drow[ai][m] = (e >= NE) ? (local * 7 + 6) : ((local < ce) ? list2[(size_t)e * LISTCAP + local] : 7 * T); }
#pragma unroll
        for (int ai = 0; ai < 2; ++ai)
#pragma unroll
            for (int m = 0; m < 4; ++m) { unsigned char* rowp = O + (size_t)drow[ai][m] * D + col0;
                const f32x4 a0 = acc[ai][0][m][0] * ysc, a1 = acc[ai][0][m][1] * ysc, b0 = acc[ai][1][m][0] * ysc, b1 = acc[ai][1][m][1] * ysc;
                v4u w; w.x = pk4_fp8(a0[0], a0[1], a0[2], a0[3]); w.y = pk4_fp8(a1[0], a1[1], a1[2], a1[3]); w.z = pk4_fp8(b0[0], b0[1], b0[2], b0[3]); w.w = pk4_fp8(b1[0], b1[1], b1[2], b1[3]);
                *(v4u*)rowp = w; }
    }
};
template <bool GATHER_, int NT>
struct MoeOrder {
    static constexpr bool GATHER = GATHER_;
    int G, c, nunits; const LAS int* tileE; const LAS int* tb; const LAS int* cnt; const int* list; unsigned K2;
    __device__ __forceinline__ bool next(int i, Unit& u) const {
        const int v = ((G & 7) == 0) ? (c & 7) * (G >> 3) + (c >> 3) : c;
        const int L = i * G + v; if (L >= nunits) return false;
        const int pm = L / NT, pl = L % NT; u.pm = pm; u.pn = tileE[pm] * NT + pl; return true;
    }
    __device__ __forceinline__ unsigned tok_off(const Unit& u, int r) const {
        const int e = tileE[u.pm], local = (u.pm - tb[e]) * 256 + r;
        int tok = local;
        if (e < NE) tok = (local < cnt[e]) ? list[(size_t)e * LISTCAP + local] : 0;
        return (unsigned)tok * K2;
    }
};
__device__ __forceinline__ void build_tables(Frame& F, int l) {
    LAS int* tileE = (LAS int*)(F.lds + TILEE_OFF); LAS int* tb = (LAS int*)(F.lds + TB_OFF); LAS int* cnt = (LAS int*)(F.lds + CNT_OFF);
    if (F.wave == 0) {
        int c = (int)__hip_atomic_load(F.ctl + CW_CURSOR + (l * 64 + F.lane) * 16, RLX_AGENT); if (c > LISTCAP) c = LISTCAP;
        const int tiles = (c + 255) >> 8; int inc = tiles;
#pragma unroll
        for (int o = 1; o < 64; o <<= 1) { const int t = __shfl_up(inc, o); if (F.lane >= o) inc += t; }
        cnt[F.lane] = c; tb[F.lane] = inc - tiles;
        if (F.lane == 63) { cnt[64] = T; tb[64] = inc; tb[65] = inc + 64; }
    }
    __syncthreads();
    const int nt = tb[65];
    for (int pm = F.tid; pm < nt; pm += NWAVES * 64) { int e = 0;
#pragma unroll 1
        for (int step = 64; step >= 1; step >>= 1) { const int q = e + step; if (q <= 64 && tb[q] <= pm) e = q; }
        tileE[pm] = e; }
    __syncthreads();
}

#if MK_ONE_LAUNCH
#define GRID_BAR() xcd_barrier(bar, F.tid == 0)
#else
#define GRID_BAR() do { } while (0)
#endif
#ifndef ONLY_PHASE
#define ONLY_PHASE -1
#endif
#define IN(k) ((ONLY_PHASE < 0 || ONLY_PHASE == ((k) < 1 ? (k) : 1 + ((k) - 1) % 8)) && lo <= (k) && (k) < hi)
#define BOTH(k) (IN(k) && IN((k) + 1))
#ifndef REPEAT_MASK
#define REPEAT_MASK 0
#endif
#define NREP(k) (1 + ((REPEAT_MASK >> (k)) & 1))
__device__ __forceinline__ int affine_item(int item_, int G) { if (G != 256) return item_; const int c = item_ & 255, i = item_ >> 8; return 64 * (c & 7) + (c >> 3) + 32 * i; }
template <int l>
__device__ __forceinline__ void layer_phases(Frame& F, const XcdBarrier& bar, const int lo, const int hi) {
    unsigned char* ws = F.ws;
    const int gw = blockIdx.x * NWAVES + F.wave, NGW = F.G * NWAVES;
    constexpr int pb = 2 + 8 * l;

        if (IN(pb - 1)) for (int rep = 0; rep < NREP(1); ++rep) {
            refresh(F);
            LAS unsigned char* hs = F.lds + RING_OFF;
            LAS float* part = (LAS float*)(F.lds + RING_OFF);
            const unsigned char* wff = ws + WS_WF + (size_t)l * 262144;
            const float* Fx = inptr<const float>(F, I_X); const bf16* Xb = (const bf16*)(ws + WS_X2B);
            bf16* hbuf = (bf16*)(ws + WS_H); float* flog = (float*)(ws + WS_FLOG);
            for (int item_ = blockIdx.x; item_ < T / 32; item_ += F.G) {
                const int ia_ = affine_item(item_, F.G);
                const int item = (l == 1) ? ((F.G == 256) ? ((ia_ & ~63) + 63 - (ia_ & 63)) : (T / 32 - 1 - item_)) : ia_;
                const int m0 = item * 32 + 4 * F.wave;
                int lq = F.lane; asm volatile("" : "+v"(lq));
                const int r32 = lq & 31, hi5 = lq >> 5;
                const float* mrow = (const float*)(ws + WS_MOD) + ((size_t)l * 8 + (m0 >> 11)) * 12288;
                f32x4 xv[4][8];
#pragma unroll
                for (int rr = 0; rr < 4; ++rr)
#pragma unroll
                    for (int j = 0; j < 8; ++j) { const size_t o0 = (size_t)(m0 + rr) * D + 4 * lq + 256 * j;
                        if (l == 0) xv[rr][j] = __builtin_nontemporal_load((const GAS f32x4*)(Fx + o0)); else { const v2u a = __builtin_nontemporal_load((const GAS v2u*)(Xb + o0)); xv[rr][j] = bf4(a.x, a.y); } }
#pragma unroll
                for (int j = 0; j < 8; ++j) { const int k = 4 * lq + 256 * j;
                    const f32x4 sh = *(const GAS f32x4*)(mrow + k), sc = *(const GAS f32x4*)(mrow + 2048 + k) + 1.0f;
#pragma unroll
                    for (int rr = 0; rr < 4; ++rr) { const int rloc = 4 * F.wave + rr; const f32x4 h = xv[rr][j] * sc + sh;
                        v2u o; o.x = pk2(h.x, h.y); o.y = pk2(h.z, h.w);
                        *(GAS v2u*)(hbuf + (size_t)(m0 + rr) * D + k) = o;
                        const int chunk = (lq >> 1) + 32 * j;
                        *(LAS v2u*)(hs + rloc * 4096 + ((chunk ^ (rloc & 15)) << 4) + (lq & 1) * 8) = o; } }
                asm volatile("" ::: "memory");
                bf16x8 bw[16][2];
                { const unsigned char* wb = wff + (size_t)(16 * F.wave) * 2048 + lq * 16;
#pragma unroll
                  for (int q = 0; q < 16; ++q) { bw[q][0] = *(const GAS bf16x8*)(wb + q * 2048); bw[q][1] = *(const GAS bf16x8*)(wb + q * 2048 + 1024); } }
                __syncthreads();
                att::f32x16 acc0 = att::f32x16{};
#pragma unroll
                for (int q = 0; q < 16; ++q) { const int ks = 16 * F.wave + q;
                    const bf16x8 af = *(const LAS bf16x8*)(hs + r32 * 4096 + (((2 * ks + hi5) ^ (r32 & 15)) << 4));
                    acc0 = __builtin_amdgcn_mfma_f32_32x32x16_bf16(af, bw[q][0], acc0, 0, 0, 0); acc0 = __builtin_amdgcn_mfma_f32_32x32x16_bf16(af, bw[q][1], acc0, 0, 0, 0); }
                __syncthreads();
#pragma unroll
                for (int r = 0; r < 16; ++r) part[(F.wave * 32 + att::crow(r, hi5)) * 32 + r32] = acc0[r];
                __syncthreads();
                if (F.tid < 32 * NFOX) { const int row = F.tid / NFOX, j = F.tid % NFOX; float sacc = 0.f;
#pragma unroll
                    for (int w = 0; w < 8; ++w) sacc += part[(w * 32 + row) * 32 + j];
                    flog[(size_t)(item * 32 + row) * 16 + j] = sacc; }
                __syncthreads();
            }
            __syncthreads();
            if (BOTH(pb - 1)) GRID_BAR();
        }
        if (IN(pb + 0)) for (int rep = 0; rep < NREP(2); ++rep) {
            refresh(F);
            if ((int)blockIdx.x < NB * NFOX) {
                const int b = blockIdx.x / NFOX, hh = blockIdx.x % NFOX;
                const float* fl = (const float*)(ws + WS_FLOG) + (size_t)b * SEQ * 16 + hh; const float bf = inptr<const float>(F, I_BFORGET)[l * NFOX + hh];
                LAS float* wtot = (LAS float*)(F.lds + RING_OFF);
                float v[4], run = 0.f;
#pragma unroll
                for (int i = 0; i < 4; ++i) { const float z = fl[(size_t)(4 * F.tid + i) * 16] + bf; const float ls = fminf(z, 0.f) - log1pf(__expf(-fabsf(z))); run += ls * LOG2E; v[i] = run; }
                float inc = run;
#pragma unroll
                for (int o = 1; o < 64; o <<= 1) { const float t = __shfl_up(inc, o); if (F.lane >= o) inc += t; }
                if (F.lane == 63) wtot[F.wave] = inc;
                __syncthreads();
                float basev = inc - run;
                for (int w = 0; w < F.wave; ++w) basev += wtot[w];
                float* co = (float*)(ws + WS_CUM) + (size_t)blockIdx.x * SEQ + 4 * F.tid;
#pragma unroll
                for (int i = 0; i < 4; ++i) co[i] = basev + v[i];
                __syncthreads();
            }
            const bf16* WL = (const bf16*)(ws + WS_W + (size_t)l * W_LAYER);
            pg8::Gemm g{(const void*)(ws + WS_H), (const void*)(WL + W_IN_OFF / 2), D * 2, 127, 127}; pg8::StaticOrder S; S.init(T, NPROJ, F.G, (int)blockIdx.x);
            EpiProj E{(bf16*)(ws + WS_PROJ), (const float*)(ws + WS_TAB)};
            pg8::gemm_phase<EpiProj, pg8::StaticOrder, true>(F.lds + RING_OFF, g, S, E, F.wave, F.lane);
            if (BOTH(pb + 0)) GRID_BAR();
        }
        if (IN(pb + 1)) for (int rep = 0; rep < NREP(3); ++rep) {
            refresh(F);
            const bf16* proj = (const bf16*)(ws + WS_PROJ); unsigned char* obuf = ws + WS_OBUF;
            const float* gn = inptr<const float>(F, I_HNG) + (size_t)l * D;
            LAS unsigned char* kvbuf = F.lds + RING_OFF; LAS float* ncum = (LAS float*)(F.lds + RING_OFF + 49152); att::lptr wl = F.lds + RING_OFF + 57344 + F.wave * 9216; LAS float* wsf = (LAS float*)(F.lds + WSF_OFF + F.wave * 256);
            volatile LAS unsigned* uslot = (volatile LAS unsigned*)(F.lds + MISC_OFF + 64);
            const int qid = blockIdx.x & 7;
#ifndef ATT_ONLY
#define ATT_ONLY -1
#endif
#define ATT_DEQ(ctrp, out) do { __syncthreads(); if (F.tid == 0) uslot[0] = __hip_atomic_fetch_add((ctrp), 1u, RLX_AGENT); __syncthreads(); (out) = (int)uslot[0] * 8 + qid; } while (0)
            bf16* dstO = (bf16*)(ws + WS_DST_O); float* dstM = (float*)(ws + WS_DST_M);
            if (rep == 0) { gu32* ctr = F.ctl + CW_AQ + ((l * 4 + 3) * 8 + qid) * 64;
              for (;;) { int gi; ATT_DEQ(ctr, gi); if (gi >= 768) break;
                  const int qb = gi / 96, bh = gi % 96;
                  att::dil_a_unit(proj, dstO, dstM, F.ctl + CW_DA + ((l * 96 + bh) * 4 + (qb >> 1)) * 16, bh / 12, bh % 12, qb, wl, wsf, F.tid, F.wave); } }
            if (ATT_ONLY < 0 || ATT_ONLY == 0) { gu32* ctr = F.ctl + CW_AQ + ((l * 4 + 0) * 8 + qid) * 64 + rep * 32;
              for (;;) { int gi; ATT_DEQ(ctr, gi); if (gi >= 512) break;
                  const int qb = 7 - gi / 64, bh = gi % 64;
                  att::sb_wave_unit(proj, gn, obuf, bh >> 3, bh & 7, 8 * qb + F.wave, wl, wsf, F.lane); } }
            if (ATT_ONLY < 0 || ATT_ONLY == 1) { gu32* ctr = F.ctl + CW_AQ + ((l * 4 + 1) * 8 + qid) * 64 + rep * 32;
              for (;;) { int gi; ATT_DEQ(ctr, gi); if (gi >= 768) break;
                  const int qb = 7 - gi / 96, bh = gi % 96;
                  att::causal_wg_unit<1>(proj, (const float*)(ws + WS_CUM) + (size_t)bh * SEQ, gn, obuf, bh / 12, bh % 12, qb, kvbuf, ncum, wl, wsf, F.tid, F.wave); } }
            if (ATT_ONLY < 0 || ATT_ONLY == 2) { gu32* ctr = F.ctl + CW_AQ + ((l * 4 + 2) * 8 + qid) * 64 + rep * 32;
              for (;;) { int gi; ATT_DEQ(ctr, gi); if (gi >= 768) break;
                  const int blk = 3 - gi / 192, rem = gi % 192, bh = rem >> 1, half = rem & 1;
                  att::dil_b_unit(proj, dstO, dstM, F.ctl + CW_DA + ((l * 96 + bh) * 4 + blk) * 16, F.ctl + CW_TMO, gn, obuf, bh / 12, bh % 12, blk, half, wl, wsf, F.tid, F.wave); } }
#undef ATT_DEQ
            __syncthreads();
            if (BOTH(pb + 1)) GRID_BAR();
        }
        if (IN(pb + 2)) for (int rep = 0; rep < NREP(4); ++rep) {
            refresh(F);
            const bf16* WL = (const bf16*)(ws + WS_W + (size_t)l * W_LAYER);
            pg8::Gemm g{(const void*)(ws + WS_OBUF), (const void*)(WL + W_OUT_OFF / 2), D, 127 - WSHIFT, 127 - ASHIFT}; pg8::StaticOrder S; S.init(T, D, F.G, (int)blockIdx.x);
            EpiMix E{(bf16*)(ws + WS_Y1)};
            pg8::gemm_phase<EpiMix, pg8::StaticOrder, true, true>(F.lds + RING_OFF, g, S, E, F.wave, F.lane);
            if (BOTH(pb + 2)) GRID_BAR();
        }
        if (IN(pb + 3)) for (int rep = 0; rep < NREP(5); ++rep) {
            refresh(F);
            const bf16* mixb = (const bf16*)(ws + WS_Y1); const float* xin = inptr<const float>(F, I_X); const bf16* xinb = (const bf16*)(ws + WS_X2B); bf16* x1 = (bf16*)(ws + WS_X1); unsigned char* h2q = ws + WS_H2;
            const float* g1 = inptr<const float>(F, I_LN1G) + (size_t)l * D; const float* b1 = inptr<const float>(F, I_LN1B) + (size_t)l * D;
            int* tinfo = (int*)(ws + WS_TINFO); float* gates = (float*)(ws + WS_GATE); int* list = (int*)(ws + WS_LIST); int* list2 = (int*)(ws + WS_LIST2);
            LAS unsigned char* h2s = F.lds + RING_OFF;
            LAS float* part = (LAS float*)(F.lds + RING_OFF);
            const unsigned char* wrf = ws + WS_WR + (size_t)l * 524288;
            const float rb = inptr<const float>(F, I_RBIAS)[l * NE + F.lane];
            for (int item_ = blockIdx.x; item_ < T / 32; item_ += F.G) {
                const int item = affine_item(item_, F.G);
                const int m0 = item * 32 + 4 * F.wave;
                int lq = F.lane; asm volatile("" : "+v"(lq));
                const int r32 = lq & 31, hi5 = lq >> 5;
                const float* mrow = (const float*)(ws + WS_MOD) + ((size_t)l * 8 + (m0 >> 11)) * 12288;
#pragma unroll
                for (int rp = 0; rp < 2; ++rp) {
                f32x4 vv[2][8];
#pragma unroll
                for (int rr = 0; rr < 2; ++rr)
#pragma unroll
                    for (int j = 0; j < 8; ++j) { const size_t off = (size_t)(m0 + 2 * rp + rr) * D + 4 * lq + 256 * j;
                        f32x4 xv; if (l == 0) xv = __builtin_nontemporal_load((const GAS f32x4*)(xin + off)); else { const v2u xw_ = __builtin_nontemporal_load((const GAS v2u*)(xinb + off)); xv = bf4(xw_.x, xw_.y); } const v2u mw = __builtin_nontemporal_load((const GAS v2u*)(mixb + off)); const f32x4 gv = *(const GAS f32x4*)(mrow + 4096 + 4 * lq + 256 * j);
                        vv[rr][j] = xv * ALPHA + gv * (f32x4){bflo(mw.x), bfhi(mw.x), bflo(mw.y), bfhi(mw.y)}; }
#pragma unroll
                for (int rq = 0; rq < 2; ++rq) { const int rr = 2 * rp + rq, m = m0 + rr, rloc = 4 * F.wave + rr;
                    f32x4 (&v)[8] = vv[rq]; float s = 0.f;
#pragma unroll
                    for (int j = 0; j < 8; ++j) s += (v[j].x + v[j].y) + (v[j].z + v[j].w);
                    const float mean = wave_sum(s) * (1.f / D); float s2 = 0.f;
#pragma unroll
                    for (int j = 0; j < 8; ++j) { v[j] = v[j] - mean; s2 += (v[j].x * v[j].x + v[j].y * v[j].y) + (v[j].z * v[j].z + v[j].w * v[j].w); }
                    const float rstd = 1.f / sqrtf(wave_sum(s2) * (1.f / D) + LN_EPS);
#pragma unroll
                    for (int j = 0; j < 8; ++j) { const int k = 4 * lq + 256 * j;
                        const f32x4 xv = v[j] * rstd * *(const GAS f32x4*)(g1 + k) + *(const GAS f32x4*)(b1 + k);
                        { v2u xo; xo.x = pk2(xv.x, xv.y); xo.y = pk2(xv.z, xv.w); *(GAS v2u*)(x1 + (size_t)m * D + k) = xo; }
                        const f32x4 hv = xv * (*(const GAS f32x4*)(mrow + 8192 + k) + 1.0f) + *(const GAS f32x4*)(mrow + 6144 + k);
                        v2u o; o.x = pk2(hv.x, hv.y); o.y = pk2(hv.z, hv.w);
                        *(GAS unsigned*)(h2q + (size_t)m * D + k) = pk4_fp8(hv.x, hv.y, hv.z, hv.w);
                        const int chunk = (lq >> 1) + 32 * j;
                        *(LAS v2u*)(h2s + rloc * 4096 + ((chunk ^ (rloc & 15)) << 4) + (lq & 1) * 8) = o; }
                }
                }
                bf16x8 bqa[4][4], bqb[4][4];
                const unsigned lo_ = lq * 16;
                const unsigned char* wbase = wrf + (size_t)(16 * F.wave) * 4096 + lo_;
#define P5_LDB(dst, q0) do { _Pragma("unroll") for (int q_ = 0; q_ < 4; ++q_) _Pragma("unroll") for (int c_ = 0; c_ < 4; ++c_) dst[q_][c_] = *(const GAS bf16x8*)(wbase + (size_t)((q0) + q_) * 4096 + c_ * 1024); } while (0)
#define P5_MMA(src, q0) do { _Pragma("unroll") for (int q_ = 0; q_ < 4; ++q_) { const int ks = 16 * F.wave + (q0) + q_; \
                    const bf16x8 af = *(const LAS bf16x8*)(h2s + r32 * 4096 + (((2 * ks + hi5) ^ (r32 & 15)) << 4)); \
                    acc0 = __builtin_amdgcn_mfma_f32_32x32x16_bf16(af, src[q_][0], acc0, 0, 0, 0); acc0 = __builtin_amdgcn_mfma_f32_32x32x16_bf16(af, src[q_][1], acc0, 0, 0, 0); \
                    acc1 = __builtin_amdgcn_mfma_f32_32x32x16_bf16(af, src[q_][2], acc1, 0, 0, 0); acc1 = __builtin_amdgcn_mfma_f32_32x32x16_bf16(af, src[q_][3], acc1, 0, 0, 0); } } while (0)
                asm volatile("" ::: "memory");
                P5_LDB(bqa, 0); P5_LDB(bqb, 4);
                __syncthreads();
                att::f32x16 acc0 = att::f32x16{}, acc1 = att::f32x16{};
                P5_MMA(bqa, 0); asm volatile("" ::: "memory"); P5_LDB(bqa, 8);
                P5_MMA(bqb, 4); asm volatile("" ::: "memory"); P5_LDB(bqb, 12);
                P5_MMA(bqa, 8); P5_MMA(bqb, 12);
#undef P5_LDB
#undef P5_MMA
                __syncthreads();
#pragma unroll
                for (int r = 0; r < 16; ++r) { const int row = att::crow(r, hi5); part[(F.wave * 32 + row) * 64 + r32] = acc0[r]; part[(F.wave * 32 + row) * 64 + 32 + r32] = acc1[r]; }
                __syncthreads();
                float score[4]; unsigned key[4]; int ek[4][6]; float sk[4][6];
#pragma unroll
                for (int rr = 0; rr < 4; ++rr) { const int rloc = 4 * F.wave + rr; float lg = 0.f;
#pragma unroll
                    for (int w = 0; w < 8; ++w) lg += part[(w * 32 + rloc) * 64 + F.lane];
                    score[rr] = 1.0f / (1.0f + __expf(-lg)); const float sel = score[rr] + rb;
                    unsigned ob = __float_as_uint(sel); ob = (ob & 0x80000000u) ? ~ob : (ob | 0x80000000u);
                    key[rr] = (ob & ~63u) | (unsigned)(63 - F.lane); }
#pragma unroll
                for (int k = 0; k < 6; ++k) {
                    unsigned mx[4];
#pragma unroll
                    for (int rr = 0; rr < 4; ++rr) mx[rr] = key[rr];
#pragma unroll
                    for (int o = 1; o < 64; o <<= 1) {
#pragma unroll
                        for (int rr = 0; rr < 4; ++rr) { const unsigned t = __shfl_xor(mx[rr], o); mx[rr] = t > mx[rr] ? t : mx[rr]; } }
#pragma unroll
                    for (int rr = 0; rr < 4; ++rr) { const int win = 63 - (int)(__builtin_amdgcn_readfirstlane((int)mx[rr]) & 63);
                        ek[rr][k] = win; sk[rr][k] = __uint_as_float((unsigned)__builtin_amdgcn_readlane((int)__float_as_uint(score[rr]), win)); if (F.lane == win) key[rr] = 0u; }
                }
#pragma unroll
                for (int rr = 0; rr < 4; ++rr) { const int m = m0 + rr;
                    const float ssum = ((sk[rr][0] + sk[rr][1]) + (sk[rr][2] + sk[rr][3])) + (sk[rr][4] + sk[rr][5]);
                    if (F.lane < 6 && rep == 0) { int e = ek[rr][0]; float sc = sk[rr][0];
#pragma unroll
                        for (int k = 1; k < 6; ++k) if (F.lane == k) { e = ek[rr][k]; sc = sk[rr][k]; }
                        const unsigned pos = __hip_atomic_fetch_add(F.ctl + CW_CURSOR + (l * 64 + e) * 16, 1u, RLX_AGENT);
                        if (pos < (unsigned)LISTCAP) { list[(size_t)e * LISTCAP + pos] = m; list2[(size_t)e * LISTCAP + pos] = m * 7 + F.lane; }
                        tinfo[(size_t)m * 6 + F.lane] = e | (int)(pos << 8); gates[(size_t)m * 6 + F.lane] = sc / ssum * ROUTED_SCALE; }
                }
                __syncthreads();
            }
            __syncthreads();
            if (BOTH(pb + 3)) GRID_BAR();
        }
        if (IN(pb + 4)) for (int rep = 0; rep < NREP(6); ++rep) {
            refresh(F);
            build_tables(F, l);
            const LAS int* tb = (const LAS int*)(F.lds + TB_OFF);
            MoeOrder<true, 4> S{F.G, (int)blockIdx.x, tb[65] * 4, (const LAS int*)(F.lds + TILEE_OFF), tb, (const LAS int*)(F.lds + CNT_OFF), (const int*)(ws + WS_LIST), (unsigned)D};
            const bf16* WL = (const bf16*)(ws + WS_W + (size_t)l * W_LAYER);
            pg8::Gemm g{(const void*)(ws + WS_H2), (const void*)(WL + W_1_OFF / 2), D, 127 - WSHIFT, 127};
            EpiSwiglu E{(unsigned char*)(ws + WS_ACT)};
            pg8::gemm_phase<EpiSwiglu, MoeOrder<true, 4>, true, true>(F.lds + RING_OFF, g, S, E, F.wave, F.lane);
            if (BOTH(pb + 4)) GRID_BAR();
        }
        if (IN(pb + 5)) for (int rep = 0; rep < NREP(7); ++rep) {
            refresh(F);
            build_tables(F, l);
            const LAS int* tb = (const LAS int*)(F.lds + TB_OFF);
            MoeOrder<false, 8> S{F.G, (int)blockIdx.x, tb[65] * 8, (const LAS int*)(F.lds + TILEE_OFF), tb, (const LAS int*)(F.lds + CNT_OFF), (const int*)(ws + WS_LIST), (unsigned)EH};
            const bf16* WL = (const bf16*)(ws + WS_W + (size_t)l * W_LAYER);
            pg8::Gemm g{(const void*)(ws + WS_ACT), (const void*)(WL + W_2_OFF / 2), EH, 127 - WSHIFT, 127 - ASHIFT};
            EpiDown E{(unsigned char*)(ws + WS_YBUF), (const LAS int*)(F.lds + TILEE_OFF), tb, (const LAS int*)(F.lds + CNT_OFF), (const int*)(ws + WS_LIST2)};
            pg8::gemm_phase<EpiDown, MoeOrder<false, 8>, true, true>(F.lds + RING_OFF, g, S, E, F.wave, F.lane);
            if (BOTH(pb + 5)) GRID_BAR();
        }
        if (IN(pb + 6)) for (int rep = 0; rep < NREP(8); ++rep) {
            refresh(F);
            build_tables(F, l);
            const LAS int* tb = (const LAS int*)(F.lds + TB_OFF);
            const unsigned char* yb = ws + WS_YBUF; const bf16* x1 = (const bf16*)(ws + WS_X1); bf16* x2b = (bf16*)(ws + WS_X2B);
            const int* tinfo = (const int*)(ws + WS_TINFO); const float* gates = (const float*)(ws + WS_GATE);
            const float* g2 = inptr<const float>(F, I_LN2G) + (size_t)l * D; const float* b2 = inptr<const float>(F, I_LN2B) + (size_t)l * D; float* Fout = inptr<float>(F, I_OUT);
            const int shared_row0 = tb[64] * 256;
            for (int m_ = gw; m_ < T; m_ += NGW) {
                const int m = (F.G == 256) ? (2048 * ((m_ >> 3) & 7) + 8 * ((m_ & 2047) >> 6) + (m_ & 7) + 256 * (m_ >> 11)) : m_;
                const float* mrow = (const float*)(ws + WS_MOD) + ((size_t)l * 8 + (m >> 11)) * 12288;
                size_t rows[7]; float gt[7];
                float gtv = 0.f; if (F.lane < 6) gtv = gates[(size_t)m * 6 + F.lane];
#pragma unroll
                for (int k = 0; k < 6; ++k) { rows[k] = (size_t)m * 7 + k; gt[k] = __uint_as_float((unsigned)__builtin_amdgcn_readlane((int)__float_as_uint(gtv), k)); }
                rows[6] = (size_t)m * 7 + 6; gt[6] = 1.0f;
                f32x4 v[8]; float s = 0.f;
#pragma unroll
                for (int jh = 0; jh < 2; ++jh) { const v4u xa = __builtin_nontemporal_load((const GAS v4u*)(x1 + (size_t)m * D + 16 * F.lane + 1024 * jh)), xb = __builtin_nontemporal_load((const GAS v4u*)(x1 + (size_t)m * D + 16 * F.lane + 1024 * jh + 8));
                    v[4 * jh] = bf4(xa.x, xa.y); v[4 * jh + 1] = bf4(xa.z, xa.w); v[4 * jh + 2] = bf4(xb.x, xb.y); v[4 * jh + 3] = bf4(xb.z, xb.w); }
#pragma unroll
                for (int jh = 0; jh < 2; ++jh) {
                    v4u yw[7];
#pragma unroll
                    for (int q = 0; q < 7; ++q) yw[q] = __builtin_nontemporal_load((const GAS v4u*)(yb + rows[q] * D + 16 * F.lane + 1024 * jh));
#pragma unroll
                    for (int i = 0; i < 4; ++i) { const int j = 4 * jh + i, k = 16 * F.lane + 1024 * jh + 4 * i; f32x4 f = (f32x4){0.f, 0.f, 0.f, 0.f};
#pragma unroll
                        for (int q = 0; q < 7; ++q) { const unsigned w = yw[q][i]; const float gq = gt[q];
                            const auto lo2 = __builtin_amdgcn_cvt_pk_f32_fp8((int)w, false), hi2 = __builtin_amdgcn_cvt_pk_f32_fp8((int)w, true);
                            f.x += gq * lo2[0]; f.y += gq * lo2[1]; f.z += gq * hi2[0]; f.w += gq * hi2[1]; }
                        v[j] = v[j] * ALPHA + *(const GAS f32x4*)(mrow + 10240 + k) * (f * (1.0f / (float)(1 << YSHIFT)));
                        s += (v[j].x + v[j].y) + (v[j].z + v[j].w); }
                    asm volatile("" ::: "memory");
                }
                const float mean = wave_sum(s) * (1.f / D); float s2 = 0.f;
#pragma unroll
                for (int j = 0; j < 8; ++j) { v[j] = v[j] - mean; s2 += (v[j].x * v[j].x + v[j].y * v[j].y) + (v[j].z * v[j].z + v[j].w * v[j].w); }
                const float rstd = 1.f / sqrtf(wave_sum(s2) * (1.f / D) + LN_EPS);
                float* orow = Fout + (size_t)m * D;
#pragma unroll
                for (int j = 0; j < 8; ++j) { const int k = 16 * F.lane + 1024 * (j >> 2) + 4 * (j & 3);
                    v[j] = v[j] * rstd * *(const GAS f32x4*)(g2 + k) + *(const GAS f32x4*)(b2 + k);
                    if (l == 1) { *(GAS f32x4*)(orow + k) = v[j]; if (j & 1) asm volatile("" ::: "memory"); } }
                if (l == 0) {
#pragma unroll
                    for (int jh = 0; jh < 2; ++jh) { v4u wa, wb; wa.x = pk2(v[4 * jh].x, v[4 * jh].y); wa.y = pk2(v[4 * jh].z, v[4 * jh].w); wa.z = pk2(v[4 * jh + 1].x, v[4 * jh + 1].y); wa.w = pk2(v[4 * jh + 1].z, v[4 * jh + 1].w);
                        wb.x = pk2(v[4 * jh + 2].x, v[4 * jh + 2].y); wb.y = pk2(v[4 * jh + 2].z, v[4 * jh + 2].w); wb.z = pk2(v[4 * jh + 3].x, v[4 * jh + 3].y); wb.w = pk2(v[4 * jh + 3].z, v[4 * jh + 3].w);
                        *(GAS v4u*)(x2b + (size_t)m * D + 16 * F.lane + 1024 * jh) = wa; *(GAS v4u*)(x2b + (size_t)m * D + 16 * F.lane + 1024 * jh + 8) = wb; } }
            }
            __syncthreads();
            if ((l == 0 || rep + 1 < NREP(8)) && BOTH(pb + 6)) GRID_BAR();
        }

}
struct Args { const void* in[21]; float* out; unsigned char* ws; int ph_lo, ph_hi; };
__global__ void __launch_bounds__(NWAVES * 64, 2) fwd_kernel(Args args) {
    extern __shared__ __attribute__((aligned(16))) unsigned char lds[];
    Frame F;
    F.lds = (LAS unsigned char*)lds;
    F.wave = __builtin_amdgcn_readfirstlane((int)(threadIdx.x >> 6)); refresh(F); F.G = gridDim.x;
    unsigned char* ws = args.ws; F.ws = ws; F.ctl = (gu32*)(ws + WS_CTL);
    for (int u = F.tid; u < (LDS_BYTES - LDSCTL_OFF) / 4; u += NWAVES * 64) ((LAS unsigned*)(F.lds + LDSCTL_OFF))[u] = 0u;
    __syncthreads();
    if (F.tid < 21) *(LAS unsigned long long*)(F.lds + PTR_OFF + 8 * F.tid) = (unsigned long long)args.in[F.tid];
    if (F.tid == 21) *(LAS unsigned long long*)(F.lds + PTR_OFF + 8 * 21) = (unsigned long long)args.out;
    __syncthreads();
    volatile LAS unsigned* MISC = (volatile LAS unsigned*)(F.lds + MISC_OFF);
    XcdBarrier bar; bar.bar = (unsigned*)(F.ctl + CW_BAR); bar.x = 0; bar.st = nullptr;
#if MK_ONE_LAUNCH
    bar = xcd_barrier_post((unsigned*)(F.ctl + CW_BAR), MISC + 8, F.tid == 0);
#endif
    const int lo = args.ph_lo, hi = args.ph_hi;
    const int gw = blockIdx.x * NWAVES + F.wave, NGW = F.G * NWAVES;

    if (IN(0)) for (int rep = 0; rep < NREP(0); ++rep) { refresh(F); p0_prologue(F); if (BOTH(0)) GRID_BAR(); }
    layer_phases<0>(F, bar, lo, hi);
    layer_phases<1>(F, bar, lo, hi);
#undef IN
#undef BOTH
}

extern "C" void kernel_launch(void* const* d_in, const int* in_sizes, int n_in, void* d_out, int out_size, void* d_ws, size_t ws_size, hipStream_t stream) {
    static int grid = 0;
    if (grid == 0) {
        if (n_in != 21 || out_size != T * D || ws_size < WS_END) { fprintf(stderr, "kernel_launch: unexpected sizes (n_in %d, out %d, ws %zu < %zu)\n", n_in, out_size, ws_size, (size_t)WS_END); grid = -1; return; }
        int dev = 0, cus = 0, per_cu = 0;
        if (hipGetDevice(&dev) != hipSuccess || hipDeviceGetAttribute(&cus, hipDeviceAttributeMultiprocessorCount, dev) != hipSuccess) { grid = -1; return; }
        if (hipFuncSetAttribute((const void*)fwd_kernel, hipFuncAttributeMaxDynamicSharedMemorySize, LDS_BYTES) != hipSuccess) { fprintf(stderr, "kernel_launch: hipFuncSetAttribute failed\n"); grid = -1; return; }
        if (hipOccupancyMaxActiveBlocksPerMultiprocessor(&per_cu, (const void*)fwd_kernel, NWAVES * 64, LDS_BYTES) != hipSuccess || per_cu < 1) { fprintf(stderr, "kernel_launch: occupancy query says %d\n", per_cu); }
        (void)hipGetLastError();
        grid = cus;
    }
    if (grid < 0) return;
    (void)in_sizes;
    hipMemsetAsync((char*)d_ws + WS_CTL, 0, CTL_ZERO_BYTES, stream);
    Args a{};
    for (int i = 0; i < 21; ++i) a.in[i] = d_in[i];
    a.out = (float*)d_out; a.ws = (unsigned char*)d_ws;
#if MK_ONE_LAUNCH
    a.ph_lo = 0; a.ph_hi = 17;
    hipLaunchKernelGGL(fwd_kernel, dim3(grid), dim3(NWAVES * 64), LDS_BYTES, stream, a);
#else
    for (int p = 0; p < 17; ++p) { a.ph_lo = p; a.ph_hi = p + 1; hipLaunchKernelGGL(fwd_kernel, dim3(grid), dim3(NWAVES * 64), LDS_BYTES, stream, a); }
#endif
}
```

```cpp
#include <hip/hip_runtime.h>
#include <hip/hip_bf16.h>
#include <cstdio>
#include <cstdint>

#ifndef MK_ONE_LAUNCH
#define MK_ONE_LAUNCH 1
#endif

namespace pg8 {
#define PG8_LAS __attribute__((address_space(3)))
typedef unsigned short bf16_t;
typedef short bf16x8 __attribute__((ext_vector_type(8)));
typedef float f32x4 __attribute__((ext_vector_type(4)));
typedef unsigned u32x4 __attribute__((ext_vector_type(4)));
constexpr int BM = 256, BK = 64, HALF = 128, HTB = HALF * BK * 2, STAGE_BYTES = 8 * HTB, NXCD = 8, WGM = 8;
constexpr int GOFF_REL = 137216;

__host__ __device__ __forceinline__ int lds_byte(int r, int c) { const int st = (r >> 4) * 2 + (c >> 5), rr = r & 15, cc = c & 31, ob = rr * 64 + cc * 2; return st * 1024 + (ob ^ (((ob >> 9) & 1) << 5)); }
__host__ __device__ __forceinline__ void stage_rc(int b, int& R, int& C) { const int st = b / 1024, sb = b % 1024, swz = sb ^ (((sb >> 9) & 1) << 5); R = (st >> 1) * 16 + swz / 64; C = (st & 1) * 32 + (swz % 64) / 2; }
__host__ __device__ __forceinline__ int perm32(int rho) { const int n = rho >> 4, i = rho & 15; return 8 * (i >> 2) + 4 * n + (i & 3); }

struct Unit { int pm, pn; };
struct Gemm { const void* A; const void* Bt; int KB; int sa, sb; };

struct StaticOrder {
    static constexpr bool GATHER = false;
    int nM, nN, nwg, G, c;
    __device__ void init(int M, int N, int G_, int c_) { nM = M / BM; nN = N / BM; nwg = nM * nN; G = G_; c = c_; }
    __device__ bool next(int i, Unit& u) const {
        const long L = (long)i * G + c; if (L >= nwg) return false;
        int wgid = (int)L; { const int q = nwg / NXCD, r = nwg % NXCD, xcd = wgid % NXCD, off = wgid / NXCD; wgid = (xcd < r ? xcd * (q + 1) : r * (q + 1) + (xcd - r) * q) + off; }
        const int nig = WGM * nN, gid = wgid / nig, fm = gid * WGM, gsz = (nM - fm) < WGM ? (nM - fm) : WGM;
        u.pm = fm + ((wgid % nig) % gsz); u.pn = (wgid % nig) / gsz; return true;
    }
    __device__ __forceinline__ unsigned tok_off(const Unit&, int) const { return 0u; }
};

typedef int v8i_t __attribute__((ext_vector_type(8))); typedef int v4i_t __attribute__((ext_vector_type(4)));
__device__ __forceinline__ v8i_t cat8(bf16x8 a, bf16x8 b) { const v4i_t x = __builtin_bit_cast(v4i_t, a), y = __builtin_bit_cast(v4i_t, b); return __builtin_shufflevector(x, y, 0, 1, 2, 3, 4, 5, 6, 7); }
__device__ __forceinline__ unsigned cvt_pk_bf16(float lo, float hi) { unsigned r; asm volatile("v_cvt_pk_bf16_f32 %0, %1, %2" : "=v"(r) : "v"(lo), "v"(hi)); return r; }

template <class Epi, class Sched, bool ALIGN_EPI, bool FP8 = false>
__device__ __forceinline__ void gemm_phase(PG8_LAS unsigned char* lds, const Gemm g, const Sched& S, const Epi& E, const int wid, const int lane) {
    constexpr bool GA = Sched::GATHER;
    const int tid = wid * 64 + lane, wr = wid >> 2, wc = wid & 3, fr = lane & 15, fq = lane >> 4;
    int KB = g.KB; asm volatile("" : "+s"(KB)); const int nt = KB / 128;
    unsigned voffA[2], voffB[2]; int rA[2]; unsigned cA2[2];
#pragma unroll
    for (int i = 0; i < 2; ++i) { int R, C; stage_rc(tid * 16 + i * 8192, R, C); const int Rb = Epi::PERM ? ((R & ~31) + perm32(R & 31)) : R;
        rA[i] = R; cA2[i] = (unsigned)C * 2u; voffA[i] = (unsigned)(R * KB + C * 2); voffB[i] = (unsigned)(Rb * KB + C * 2); }
    const size_t kstep = (size_t)(BK * 2);
    const size_t hstep = (size_t)HALF * KB;
    const size_t hstepA = GA ? (size_t)0 : hstep;
    const size_t tstep = 2 * hstep;
    const unsigned ldsw = (unsigned)wid * 1024u;
    const int aoff = lds_byte(wr * 64 + fr, fq * 8), boff = lds_byte(wc * 32 + fr, fq * 8);
#define PG8_SA(b, h) (((b) * 2 + (h)) * HTB)
#define PG8_SB(b, h) ((4 + (b) * 2 + (h)) * HTB)
    const unsigned ldsb = (unsigned)__builtin_amdgcn_readfirstlane((int)((unsigned)(__UINTPTR_TYPE__)lds + ldsw));
#define PG8_STAGE(bufoff, gbase, voff) do { _Pragma("unroll") for (int _i = 0; _i < 2; ++_i) { unsigned keep_; \
        asm volatile("s_mov_b32 %0, m0\n\ts_mov_b32 m0, %3\n\ts_nop 0\n\tglobal_load_lds_dwordx4 %1, %2\n\ts_mov_b32 m0, %0" : "=&s"(keep_) : "v"((voff)[_i]), "s"((const char*)(gbase)), "s"(ldsb + (unsigned)((bufoff) + _i * 8192)) : "memory"); } } while (0)
#define PG8_LDA(dst, b, h) do { _Pragma("unroll") for (int m = 0; m < 4; ++m) _Pragma("unroll") for (int k = 0; k < 2; ++k) dst[m][k] = *(const PG8_LAS bf16x8*)(lds + PG8_SA(b, h) + aoff + m * 2048 + k * 1024); } while (0)
#define PG8_LDB(dst, b, h) do { _Pragma("unroll") for (int n = 0; n < 2; ++n) _Pragma("unroll") for (int k = 0; k < 2; ++k) dst[n][k] = *(const PG8_LAS bf16x8*)(lds + PG8_SB(b, h) + boff + n * 2048 + k * 1024); } while (0)
#define PG8_MMA(ai, bj, At, Bt) do { __builtin_amdgcn_s_setprio(1); _Pragma("unroll") for (int m = 0; m < 4; ++m) _Pragma("unroll") for (int n = 0; n < 2; ++n) { \
        if constexpr (FP8) { asm volatile("v_mfma_scale_f32_16x16x128_f8f6f4 %0, %1, %2, %0, %3, %4 op_sel_hi:[0,0,0]" : "+v"(acc[ai][bj][m][n]) : "v"(cat8(Bt[n][0], Bt[n][1])), "v"(cat8(At[m][0], At[m][1])), "v"(sa_v), "v"(sb_v)); } \
        else { _Pragma("unroll") for (int k = 0; k < 2; ++k) acc[ai][bj][m][n] = __builtin_amdgcn_mfma_f32_16x16x32_bf16(Bt[n][k], At[m][k], acc[ai][bj][m][n], 0, 0, 0); } } \
        __builtin_amdgcn_s_setprio(0); } while (0)
#define PG8_WAIT_V(n) asm volatile("s_waitcnt vmcnt(" #n ")" ::: "memory")
#define PG8_WAIT_L(n) asm volatile("s_waitcnt lgkmcnt(" #n ")" ::: "memory")
#define PG8_BAR __builtin_amdgcn_s_barrier()
#define PG8_SCHED __builtin_amdgcn_sched_barrier(0)
    const int sa_v = g.sa, sb_v = g.sb;
    Unit cur, nxt; int ui = 0;
    if (!S.next(0, cur)) return;
    f32x4 acc[2][2][4][2];
#pragma unroll
    for (int a = 0; a < 2; ++a)
#pragma unroll
        for (int b = 0; b < 2; ++b)
#pragma unroll
            for (int m = 0; m < 4; ++m)
#pragma unroll
                for (int n = 0; n < 2; ++n) acc[a][b][m][n] = (f32x4){0.f, 0.f, 0.f, 0.f};
    bf16x8 At[4][2], B0[2][2], B1[2][2];
    unsigned vc0[2], vc1[2];
    PG8_LAS u32x4* gslot = (PG8_LAS u32x4*)(lds + GOFF_REL) + tid;
#pragma unroll
    for (int i = 0; i < 2; ++i) {
        if (GA) { vc0[i] = S.tok_off(cur, rA[i]) + cA2[i]; vc1[i] = S.tok_off(cur, HALF + rA[i]) + cA2[i]; }
        else { vc0[i] = voffA[i]; vc1[i] = voffA[i]; } }
    if (GA) asm volatile("" : "+v"(vc0[0]), "+v"(vc0[1]), "+v"(vc1[0]), "+v"(vc1[1]));
    const char* cA = GA ? (const char*)g.A : (const char*)g.A + (size_t)cur.pm * tstep; const char* cB = (const char*)g.Bt + (size_t)cur.pn * tstep;
    PG8_STAGE(PG8_SB(0, 0), cB, voffB); PG8_STAGE(PG8_SB(0, 1), cB + hstep, voffB); PG8_STAGE(PG8_SA(0, 0), cA, vc0); PG8_STAGE(PG8_SA(0, 1), cA + hstepA, vc1);
    if (wr == 1) PG8_BAR;
    PG8_WAIT_V(2); PG8_BAR;
    PG8_STAGE(PG8_SB(1, 0), cB + kstep, voffB); PG8_STAGE(PG8_SA(1, 0), cA + kstep, vc0); PG8_STAGE(PG8_SB(1, 1), cB + hstep + kstep, voffB);
    PG8_WAIT_V(6); PG8_BAR;
    for (;;) {
        const bool has_next = S.next(ui + 1, nxt);
        const char* nA = GA ? (const char*)g.A : (has_next ? (const char*)g.A + (size_t)nxt.pm * tstep : cA); const char* nB = has_next ? (const char*)g.Bt + (size_t)nxt.pn * tstep : cB;
        if (GA && has_next) {
            u32x4 q; q.x = S.tok_off(nxt, rA[0]) + cA2[0]; q.y = S.tok_off(nxt, rA[1]) + cA2[1]; q.z = S.tok_off(nxt, HALF + rA[0]) + cA2[0]; q.w = S.tok_off(nxt, HALF + rA[1]) + cA2[1];
            *gslot = q;
        }
#pragma clang loop unroll(disable)
        for (int t = 0; t < nt; t += 2) {
            const bool last = (t == nt - 2);
            const char* a1 = cA + (size_t)(t + 1) * kstep;
            const char* a2 = last ? nA : cA + (size_t)(t + 2) * kstep; const char* b2 = last ? nB : cB + (size_t)(t + 2) * kstep;
            const char* a3 = a2 + kstep; const char* b3 = b2 + kstep;
            PG8_LDB(B0, 0, 0); PG8_LDB(B1, 0, 1); PG8_SCHED; PG8_LDA(At, 0, 0); PG8_STAGE(PG8_SA(1, 1), a1 + hstepA, vc1);
            if (GA && last && has_next) { const u32x4 q = *gslot; vc0[0] = q.x; vc0[1] = q.y; vc1[0] = q.z; vc1[1] = q.w; }
            PG8_WAIT_V(8); PG8_WAIT_L(0); PG8_BAR; PG8_MMA(0, 0, At, B0); PG8_MMA(0, 1, At, B1); PG8_BAR; PG8_SCHED;
            PG8_LDA(At, 0, 1); PG8_STAGE(PG8_SB(0, 0), b2, voffB); PG8_STAGE(PG8_SB(0, 1), b2 + hstep, voffB); PG8_STAGE(PG8_SA(0, 0), a2, vc0);
            PG8_WAIT_V(8); PG8_WAIT_L(0); PG8_BAR; PG8_MMA(1, 0, At, B0); PG8_MMA(1, 1, At, B1); PG8_BAR; PG8_SCHED;
            PG8_LDB(B0, 1, 0); PG8_LDB(B1, 1, 1); PG8_SCHED; PG8_LDA(At, 1, 0); PG8_STAGE(PG8_SA(0, 1), a2 + hstepA, vc1);
            PG8_WAIT_V(8); PG8_WAIT_L(0); PG8_BAR; PG8_MMA(0, 0, At, B0); PG8_MMA(0, 1, At, B1); PG8_BAR; PG8_SCHED;
            PG8_LDA(At, 1, 1); PG8_STAGE(PG8_SB(1, 0), b3, voffB); PG8_STAGE(PG8_SB(1, 1), b3 + hstep, voffB); PG8_STAGE(PG8_SA(1, 0), a3, vc0);
            PG8_WAIT_V(8); PG8_WAIT_L(0); PG8_BAR; PG8_MMA(1, 0, At, B0); PG8_MMA(1, 1, At, B1); PG8_BAR; PG8_SCHED;
        }
        if constexpr (ALIGN_EPI) { if (wr == 0) PG8_BAR; }
        if constexpr (FP8) {
#pragma unroll
            for (int a = 0; a < 2; ++a)
#pragma unroll
                for (int b = 0; b < 2; ++b) asm volatile("s_nop 15\n\ts_nop 15" : "+v"(acc[a][b][0][0]), "+v"(acc[a][b][0][1]), "+v"(acc[a][b][1][0]), "+v"(acc[a][b][1][1]), "+v"(acc[a][b][2][0]), "+v"(acc[a][b][2][1]), "+v"(acc[a][b][3][0]), "+v"(acc[a][b][3][1]));
        }
        E(acc, cur, wr, wc, fr, fq);
        if (!has_next) break;
#pragma unroll
        for (int a = 0; a < 2; ++a)
#pragma unroll
            for (int b = 0; b < 2; ++b)
#pragma unroll
                for (int m = 0; m < 4; ++m)
#pragma unroll
                    for (int n = 0; n < 2; ++n) acc[a][b][m][n] = (f32x4){0.f, 0.f, 0.f, 0.f};
        cur = nxt; cA = nA; cB = nB; ++ui;
        if constexpr (ALIGN_EPI) { if (wr == 1) PG8_BAR; }
    }
    PG8_WAIT_V(0);
    if constexpr (!ALIGN_EPI) { if (wr == 0) PG8_BAR; }
    PG8_BAR;
#undef PG8_SA
#undef PG8_SB
#undef PG8_STAGE
#undef PG8_LDA
#undef PG8_LDB
#undef PG8_MMA
#undef PG8_WAIT_V
#undef PG8_WAIT_L
#undef PG8_BAR
#undef PG8_SCHED
}
}

constexpr int NWAVES = 8;
constexpr int T = 16384, D = 2048, NB = 8, SEQ = 2048, NPROJ = 6144, INW = 6156, NFOX = 12;
constexpr int NE = 64, TOPK = 6, EH = 512, LISTCAP = 16384;
constexpr int QCOL_SB = 0, KCOL_SB = 512, VCOL_SB = 1024, QCOL_FX = 1536, KCOL_FX = 2304, VCOL_FX = 3072, QCOL_DL = 3840, KCOL_DL = 4608, VCOL_DL = 5376;
constexpr float LN_EPS = 1e-5f, RMS_EPS = 1e-6f, ALPHA = 1.4142135623730951f, ROUTED_SCALE = 2.5f;
constexpr float LOG2E = 1.4426950408889634f;
constexpr int WSHIFT = 6, ASHIFT = 4, YSHIFT = 4;
constexpr float C2 = 0.125f * 1.4426950408889634f;

constexpr size_t MiB = 1u << 20;
constexpr size_t WS_CTL = 0, CTL_ZERO_BYTES = 1 * MiB;
constexpr size_t WS_MOD = 1 * MiB;
constexpr size_t WS_TAB = 2 * MiB;
constexpr size_t WS_FLOG = 6 * MiB;
constexpr size_t WS_CUM = 7 * MiB;
constexpr size_t WS_TINFO = 8 * MiB;
constexpr size_t WS_GATE = 9 * MiB;
constexpr size_t WS_LIST = 10 * MiB;
constexpr size_t WS_WR = 14 * MiB;
constexpr size_t WS_W = 16 * MiB;
constexpr size_t W_IN_OFF = 0, W_OUT_OFF = 24 * MiB, W_1_OFF = 32 * MiB, W_2_OFF = 292 * MiB, W_LAYER = 422 * MiB;
constexpr size_t WS_H = 860 * MiB;
constexpr size_t WS_X1 = 924 * MiB;
constexpr size_t WS_X2B = 988 * MiB;
constexpr size_t WS_H2 = 1052 * MiB;
constexpr size_t WS_R1 = 1116 * MiB;
constexpr size_t WS_PROJ = WS_R1, WS_OBUF = WS_R1 + 192 * MiB, WS_Y1 = WS_R1 + 256 * MiB;
constexpr size_t WS_ACT = WS_R1, WS_YBUF = WS_R1 + 128 * MiB;
constexpr size_t WS_DST_O = WS_R1 + 640 * MiB;
constexpr size_t WS_DST_M = WS_DST_O + 24 * MiB;
constexpr size_t WS_LIST2 = WS_DST_M + 2 * MiB;
constexpr size_t WS_WF = WS_LIST2 + 4 * MiB;
constexpr size_t WS_END = WS_WF + 1 * MiB;
constexpr int MAXTILES = 512;

constexpr int CW_TMO = 0, CW_CODE = 1;
constexpr int CW_BAR = 4096;
constexpr int CW_CURSOR = 8192;
constexpr int CW_AQ = 12288;
constexpr int CW_DA = 20480;

constexpr int RING_OFF = 0, RING_BYTES = 131072;
constexpr int WSF_OFF = 131072;
constexpr int TILEE_OFF = WSF_OFF + 2048;
constexpr int TB_OFF = TILEE_OFF + 2048;
constexpr int CNT_OFF = TB_OFF + 512;
constexpr int PTR_OFF = CNT_OFF + 512;
constexpr int MISC_OFF = PTR_OFF + 256;
constexpr int GOFF_OFF = 137216;
static_assert(GOFF_OFF >= MISC_OFF + 128 && GOFF_OFF + 8192 <= 147456 && GOFF_OFF == RING_OFF + pg8::GOFF_REL, "gather slots");
constexpr int LDSCTL_OFF = WSF_OFF;
constexpr int LDS_BYTES = 147456;
static_assert(MISC_OFF + 128 <= LDS_BYTES, "LDS map");
typedef unsigned v2u_early __attribute__((ext_vector_type(2)));

#define GAS __attribute__((address_space(1)))
#define LAS __attribute__((address_space(3)))
typedef unsigned short bf16;
typedef unsigned v4u __attribute__((ext_vector_type(4)));
typedef unsigned v2u __attribute__((ext_vector_type(2)));
typedef float f32x4 __attribute__((ext_vector_type(4)));
typedef short bf16x8 __attribute__((ext_vector_type(8)));
typedef GAS unsigned gu32;
#define RLX_AGENT __ATOMIC_RELAXED, __HIP_MEMORY_SCOPE_AGENT
#define LDS_WAIT() asm volatile("s_waitcnt lgkmcnt(0)" ::: "memory")
#define VM_WAIT() asm volatile("s_waitcnt vmcnt(0)" ::: "memory")
__device__ __forceinline__ unsigned f2bf(float f) { unsigned u = __builtin_bit_cast(unsigned, f); return (u + 0x7fffu + ((u >> 16) & 1u)) >> 16; }
__device__ __forceinline__ unsigned pk2(float lo, float hi) { return f2bf(lo) | (f2bf(hi) << 16); }
__device__ __forceinline__ unsigned pk4_fp8(float a, float b, float c, float d) { int r = __builtin_amdgcn_cvt_pk_fp8_f32(a, b, 0, false); r = __builtin_amdgcn_cvt_pk_fp8_f32(c, d, r, true); return (unsigned)r; }
__device__ __forceinline__ f32x4 bf4(unsigned a, unsigned b);
__device__ __forceinline__ float bflo(unsigned w) { return __builtin_bit_cast(float, w << 16); }
__device__ __forceinline__ float bfhi(unsigned w) { return __builtin_bit_cast(float, w & 0xffff0000u); }
__device__ __forceinline__ f32x4 bf4(unsigned a, unsigned b) { return (f32x4){bflo(a), bfhi(a), bflo(b), bfhi(b)}; }

#define XB_TMO      128
#define XB_XCNT(j)  (256  + 64 * (j))
#define XB_XSUB(j)  (1280 + 64 * (j))
#define XB_XGEN(j)  (2304 + 64 * (j))
#define XB_TOP      3328
#define XB_TOPGEN   3392
#define XCD_BAR_WORDS 3456
#define XB_SPIN_CAP (1u << 20)

__device__ __forceinline__ unsigned xb_ld(unsigned* p)              { return __hip_atomic_load(p, __ATOMIC_RELAXED, __HIP_MEMORY_SCOPE_AGENT); }
__device__ __forceinline__ unsigned xb_add(unsigned* p, unsigned v) { return __hip_atomic_fetch_add(p, v, __ATOMIC_RELAXED, __HIP_MEMORY_SCOPE_AGENT); }
__device__ __forceinline__ unsigned xb_xcc_id() { return (unsigned)__builtin_amdgcn_s_getreg((3 << 11) | 20) & 0xFu; }
#define XB_SPIN(cond, bar) do { unsigned _sp = 0; while (cond) { __builtin_amdgcn_s_sleep(1); \
    if ((++_sp & 255u) == 0u) { if (xb_ld(&(bar)[XB_TMO])) break; if (_sp > XB_SPIN_CAP) { atomicAdd(&(bar)[XB_TMO], 1u); break; } } } } while (0)

struct XcdBarrier { unsigned* bar; unsigned x; volatile LAS unsigned* st; };

__device__ __forceinline__ XcdBarrier xcd_barrier_post(unsigned* bar, volatile LAS unsigned* st, bool leader) {
    XcdBarrier b; b.bar = bar; b.x = xb_xcc_id(); b.st = st;
    if (leader) (void)xb_add(&bar[XB_XCNT(b.x)], 1u);
    return b;
}
__device__ __forceinline__ void xcd_barrier_complete(unsigned* bar, unsigned x, unsigned& nloc, unsigned& nx) {
    const unsigned G = gridDim.x * gridDim.y * gridDim.z;
    unsigned sum, cnt, mine, sp = 0u;
    for (;;) {
        sum = 0u; cnt = 0u; mine = 0u;
#pragma unroll
        for (unsigned j = 0; j < 16; ++j) { const unsigned c = xb_ld(&bar[XB_XCNT(j)]); sum += c; cnt += (c > 0u) ? 1u : 0u; mine = (j == x) ? c : mine; }
        if (sum == G) break;
        __builtin_amdgcn_s_sleep(1);
        if ((++sp & 255u) == 0u) { if (xb_ld(&bar[XB_TMO])) break; if (sp > XB_SPIN_CAP) { atomicAdd(&bar[XB_TMO], 1u); break; } }
    }
    nloc = mine > 0u ? mine : 1u; nx = cnt > 0u ? cnt : 1u;
}
__device__ __forceinline__ void xcd_barrier(const XcdBarrier& b, bool leader  ) {
    asm volatile("s_waitcnt vmcnt(0)" ::: "memory");
    __syncthreads();
    if (leader) {
        unsigned* bar = b.bar;
        __builtin_amdgcn_s_waitcnt(0);
        unsigned nloc = b.st[0], nx = b.st[1];
        if (nloc == 0u) { xcd_barrier_complete(bar, b.x, nloc, nx); b.st[0] = nloc; b.st[1] = nx; }
        const unsigned old = xb_add(&bar[XB_XSUB(b.x)], 1u);
        const unsigned gen = old / nloc;
        if (old + 1u == (gen + 1u) * nloc) {
            __builtin_amdgcn_fence(__ATOMIC_RELEASE, "agent");
            asm volatile("s_waitcnt vmcnt(0)" ::: "memory");
            const unsigned og = xb_add(&bar[XB_TOP], 1u);
            const unsigned tg = og / nx;
            if (og + 1u == (tg + 1u) * nx) xb_add(&bar[XB_TOPGEN], 1u);
            else XB_SPIN(xb_ld(&bar[XB_TOPGEN]) == tg, bar);
            __builtin_amdgcn_fence(__ATOMIC_ACQUIRE, "agent");
            xb_add(&bar[XB_XGEN(b.x)], 1u);
            asm volatile("s_waitcnt vmcnt(0)" ::: "memory");
        } else {
            XB_SPIN(xb_ld(&bar[XB_XGEN(b.x)]) == gen, bar);
            __builtin_amdgcn_fence(__ATOMIC_ACQUIRE, "agent");
            asm volatile("s_waitcnt vmcnt(0)" ::: "memory");
        }
    }
    __syncthreads();
}

struct Frame {
    LAS unsigned char* lds;
    gu32* ctl;
    int tid, lane, wave, G;
    unsigned char* ws;
};
enum { I_X = 0, I_C, I_POS, I_WADA, I_BADA, I_WIN, I_BFORGET, I_HNG, I_WOUT, I_LN1G, I_LN1B, I_WROUTER, I_RBIAS, I_WEG, I_WEU, I_WED, I_WSG, I_WSU, I_WSD, I_LN2G, I_LN2B, I_OUT, I_NPTR };
template <class TP> __device__ __forceinline__ TP* inptr(const Frame& F, int i) {
    const v2u v = *(const LAS v2u*)(F.lds + PTR_OFF + 8 * i);
    const unsigned long long p = ((unsigned long long)(unsigned)__builtin_amdgcn_readfirstlane((int)v.y) << 32) | (unsigned)__builtin_amdgcn_readfirstlane((int)v.x);
    return (TP*)p;
}
__device__ __forceinline__ void refresh(Frame& F) { int l = (int)__builtin_amdgcn_mbcnt_hi(~0u, __builtin_amdgcn_mbcnt_lo(~0u, 0u)); asm volatile("" : "+v"(l)); F.lane = l; F.tid = F.wave * 64 + l; }
__device__ __forceinline__ float wave_sum(float v) {
#pragma unroll
    for (int o = 1; o < 64; o <<= 1) v += __shfl_xor(v, o);
    return v;
}

__device__ __forceinline__ void p0_transpose_item(const float* W, size_t ldw, int k0, int n0, bf16* WT, size_t drowA, size_t drowB, int Kd, LAS unsigned* S, int lane) {
    const int n4 = lane & 15, ks = lane >> 4;
    const float* src = W + (size_t)(k0 + 2 * ks) * ldw + n0 + 4 * n4;
    f32x4 a[8], b[8];
#pragma unroll
    for (int i = 0; i < 8; ++i) { a[i] = __builtin_nontemporal_load((const GAS f32x4*)(src + (size_t)(8 * i) * ldw)); b[i] = __builtin_nontemporal_load((const GAS f32x4*)(src + (size_t)(8 * i + 1) * ldw)); }
#pragma unroll
    for (int i = 0; i < 8; ++i) { const int kp = 4 * i + ks;
#pragma unroll
        for (int j = 0; j < 4; ++j) { const int n = 4 * n4 + j; S[n * 32 + 4 * ((kp >> 2) ^ (n4 & 7)) + (kp & 3)] = pg8::cvt_pk_bf16(a[i][j], b[i][j]); } }
    LDS_WAIT(); asm volatile("" ::: "memory");
    const int c = lane & 7;
#pragma unroll
    for (int j = 0; j < 8; ++j) { const int n = (lane >> 3) + 8 * j;
        const v4u o = *(const LAS v4u*)(S + n * 32 + 4 * (c ^ ((n >> 2) & 7)));
        const size_t drow = (n < 32 ? drowA + n : drowB + (n - 32));
        *(GAS v4u*)(WT + drow * (size_t)Kd + k0 + 8 * c) = o; }
    LDS_WAIT(); asm volatile("" ::: "memory");
}
template <bool PAIR>
__device__ __forceinline__ void p0_transpose_item8(const float* W, size_t ldw, int k0, int n0, unsigned char* WT, size_t drow0, int KdB, float scale, LAS unsigned* S, int lane) {
    const int n4 = lane & 7, ks = lane >> 3;
    const float* src = W + (size_t)(k0 + 4 * ks) * ldw + n0 + 4 * n4;
    f32x4 a[4][4];
#pragma unroll
    for (int i = 0; i < 4; ++i)
#pragma unroll
        for (int r = 0; r < 4; ++r) a[i][r] = __builtin_nontemporal_load((const GAS f32x4*)(src + (size_t)(32 * i + r) * ldw));
#pragma unroll
    for (int i = 0; i < 4; ++i) { const int kq = ks + 8 * i;
#pragma unroll
        for (int j = 0; j < 4; ++j) { const int n = 4 * n4 + j; S[n * 32 + 4 * ((kq >> 2) ^ n4) + (kq & 3)] = pk4_fp8(a[i][0][j] * scale, a[i][1][j] * scale, a[i][2][j] * scale, a[i][3][j] * scale); } }
    LDS_WAIT(); asm volatile("" ::: "memory");
    const int c = lane & 7;
#pragma unroll
    for (int j = 0; j < 4; ++j) { const int n = (lane >> 3) + 8 * j;
        const v4u o = *(const LAS v4u*)(S + n * 32 + 4 * (c ^ ((n >> 2) & 7)));
        const int dn = PAIR ? ((n & 7) + 8 * ((n >> 4) & 1) + 128 * ((n >> 3) & 1)) : n;
        *(GAS v4u*)(WT + (drow0 + dn) * (size_t)KdB + k0 + 16 * c) = o; }
    LDS_WAIT(); asm volatile("" ::: "memory");
}
__device__ __forceinline__ int in_dest_row(int n0) {
    if (n0 < KCOL_DL + 768 && n0 >= QCOL_DL) { const int reg = (n0 - QCOL_DL) / 768, c = (n0 - QCOL_DL) % 768, tile = c >> 8, hd = (c & 255) >> 6, dh = (c & 63) >> 5;
        return QCOL_DL + reg * 768 + tile * 256 + dh * 128 + hd * 32; }
    return n0;
}
constexpr int ITEMS_IN = 32 * 96, ITEMS_OUT = 32 * 32, ITEMS_E = 768, ITEMS_LAYER = ITEMS_IN + ITEMS_OUT + 65 * ITEMS_E;

__device__ __forceinline__ void p0_prologue(Frame& F) {
    float* mod = (float*)(F.ws + WS_MOD);
    const float* Fc = inptr<const float>(F, I_C); const float* Fw_ada = inptr<const float>(F, I_WADA); const float* Fb_ada = inptr<const float>(F, I_BADA);
    {
        LAS float* cact = (LAS float*)(F.lds);
        LAS float* part = (LAS float*)(F.lds + 65536);
        for (int i = F.tid; i < NB * D; i += NWAVES * 64) { const float v = Fc[i]; cact[i] = v / (1.f + __expf(-v)); }
        __syncthreads();
        const int cg = F.tid & 7, kq = F.tid >> 3;
        for (int item = blockIdx.x; item < 768; item += F.G) {
            const int l = item / 384, col0 = (item % 384) * 32;
            f32x4 acc[8];
#pragma unroll
            for (int b = 0; b < 8; ++b) acc[b] = (f32x4){0.f, 0.f, 0.f, 0.f};
            const float* wp = Fw_ada + ((size_t)l * D) * 12288 + col0 + 4 * cg;
#pragma unroll 4
            for (int i = 0; i < 32; ++i) { const int k = kq + 64 * i; const f32x4 w4 = *(const GAS f32x4*)(wp + (size_t)k * 12288);
#pragma unroll
                for (int b = 0; b < 8; ++b) { const float cv = cact[b * D + k]; acc[b] += w4 * cv; } }
#pragma unroll
            for (int b = 0; b < 8; ++b) *(LAS f32x4*)(part + (kq * 8 + b) * 32 + 4 * cg) = acc[b];
            __syncthreads();
            if (F.tid < 256) { const int b = F.tid >> 5, col = F.tid & 31; float s = 0.f;
                for (int q = 0; q < 64; ++q) s += part[(q * 8 + b) * 32 + col];
                mod[((size_t)l * 8 + b) * 12288 + col0 + col] = s + Fb_ada[(size_t)l * 12288 + col0 + col]; }
            __syncthreads();
        }
    }
    {
        float* tab = (float*)(F.ws + WS_TAB); const int* Fpos = inptr<const int>(F, I_POS);
        for (int idx = blockIdx.x * (NWAVES * 64) + F.tid; idx < T * 32; idx += F.G * NWAVES * 64) {
            const int t = idx >> 5, i = idx & 31;
            const float inv = exp2f(-(float)i * (13.287712379549449f / 32.f));
            const float ang = (float)Fpos[t] * inv;
            double rev = (double)ang * 0.15915494309189535; rev -= __builtin_rint(rev);
            tab[(size_t)t * 64 + i] = __builtin_amdgcn_cosf((float)rev); tab[(size_t)t * 64 + 32 + i] = __builtin_amdgcn_sinf((float)rev);
        }
    }
    {
        const float* Fwr = inptr<const float>(F, I_WROUTER);
        for (int idx = blockIdx.x * (NWAVES * 64) + F.tid; idx < 2 * 128 * 2 * 64; idx += F.G * NWAVES * 64) {
            const int ln = idx & 63, nt = (idx >> 6) & 1, ks = (idx >> 7) & 127, l = idx >> 14;
            const int e = 32 * nt + (ln & 31), k0 = 16 * ks + 8 * (ln >> 5);
            float w[8]; unsigned hb[8], lb[8];
#pragma unroll
            for (int j = 0; j < 8; ++j) { w[j] = Fwr[((size_t)l * D + k0 + j) * NE + e]; hb[j] = f2bf(w[j]); lb[j] = f2bf(w[j] - __builtin_bit_cast(float, hb[j] << 16)); }
            v4u oh, ol; oh.x = hb[0] | (hb[1] << 16); oh.y = hb[2] | (hb[3] << 16); oh.z = hb[4] | (hb[5] << 16); oh.w = hb[6] | (hb[7] << 16);
            ol.x = lb[0] | (lb[1] << 16); ol.y = lb[2] | (lb[3] << 16); ol.z = lb[4] | (lb[5] << 16); ol.w = lb[6] | (lb[7] << 16);
            unsigned char* dst = F.ws + WS_WR + (size_t)l * 524288 + (size_t)((ks * 2 + nt) * 2) * 1024 + ln * 16;
            *(GAS v4u*)dst = oh; *(GAS v4u*)(dst + 1024) = ol;
        }
    }
    {
        const float* Fwi = inptr<const float>(F, I_WIN);
        for (int idx = blockIdx.x * (NWAVES * 64) + F.tid; idx < 2 * 128 * 64; idx += F.G * NWAVES * 64) {
            const int ln = idx & 63, ks = (idx >> 6) & 127, l = idx >> 13;
            const int n = ln & 31, k0 = 16 * ks + 8 * (ln >> 5);
            unsigned hb[8], lb[8];
#pragma unroll
            for (int j = 0; j < 8; ++j) { const float w = (n < NFOX) ? Fwi[((size_t)l * D + k0 + j) * INW + NPROJ + n] : 0.f; hb[j] = f2bf(w); lb[j] = f2bf(w - __builtin_bit_cast(float, hb[j] << 16)); }
            v4u oh, ol; oh.x = hb[0] | (hb[1] << 16); oh.y = hb[2] | (hb[3] << 16); oh.z = hb[4] | (hb[5] << 16); oh.w = hb[6] | (hb[7] << 16);
            ol.x = lb[0] | (lb[1] << 16); ol.y = lb[2] | (lb[3] << 16); ol.z = lb[4] | (lb[5] << 16); ol.w = lb[6] | (lb[7] << 16);
            unsigned char* dst = F.ws + WS_WF + (size_t)l * 262144 + (size_t)(ks * 2) * 1024 + ln * 16;
            *(GAS v4u*)dst = oh; *(GAS v4u*)(dst + 1024) = ol;
        }
    }
    {
        LAS unsigned* scr = (LAS unsigned*)(F.lds + RING_OFF + F.wave * 16384);
        const int gw = blockIdx.x * NWAVES + F.wave, NGW = F.G * NWAVES;
        for (int it = gw; it < 2 * ITEMS_LAYER; it += NGW) {
            const int l = 1 - it / ITEMS_LAYER; int r = ITEMS_LAYER - 1 - it % ITEMS_LAYER;
            bf16* WL = (bf16*)(F.ws + WS_W + (size_t)l * W_LAYER);
            if (r < ITEMS_IN) { const float* Fw_in = inptr<const float>(F, I_WIN); const int kb = r / 96, nb = r % 96;
                p0_transpose_item(Fw_in + (size_t)l * D * INW, INW, 64 * kb, 64 * nb, WL + W_IN_OFF / 2, in_dest_row(64 * nb), in_dest_row(64 * nb + 32), D, scr, F.lane); continue; }
            r -= ITEMS_IN;
            if (r < ITEMS_OUT) { const int kb = r / 64, nb = r % 64; const float* Fw_out = inptr<const float>(F, I_WOUT);
                p0_transpose_item8<false>(Fw_out + (size_t)l * D * D, D, 128 * kb, 32 * nb, F.ws + WS_W + (size_t)l * W_LAYER + W_OUT_OFF, (size_t)(32 * nb), D, (float)(1 << WSHIFT), scr, F.lane); continue; }
            r -= ITEMS_OUT;
            const int e = r / ITEMS_E, q = r % ITEMS_E;
            unsigned char* WLb = F.ws + WS_W + (size_t)l * W_LAYER;
            if (q < 512) { const int up = q >> 8, qq = q & 255, kb = qq / 16, nb = qq % 16, n0 = 32 * nb;
                const float* src = (e < NE) ? (inptr<const float>(F, up ? I_WEU : I_WEG) + ((size_t)l * NE + e) * D * EH) : (inptr<const float>(F, up ? I_WSU : I_WSG) + (size_t)l * D * EH);
                const size_t dr = (size_t)e * 1024 + (n0 >> 7) * 256 + up * 128 + (n0 & 127);
                p0_transpose_item8<false>(src, EH, 128 * kb, n0, WLb + W_1_OFF, dr, D, (float)(1 << WSHIFT), scr, F.lane);
            } else { const int qq = q - 512, kb = qq / 64, nb = qq % 64;
                const float* src = (e < NE) ? (inptr<const float>(F, I_WED) + ((size_t)l * NE + e) * EH * D) : (inptr<const float>(F, I_WSD) + (size_t)l * EH * D);
                { const int n0 = 32 * nb, o = n0 & 255; p0_transpose_item8<true>(src, D, 128 * kb, n0, WLb + W_2_OFF, (size_t)e * 2048 + (n0 & ~255) + 32 * (o >> 6) + 16 * ((o >> 5) & 1), EH, (float)(1 << WSHIFT), scr, F.lane); } }
        }
    }
}

__device__ __forceinline__ void prep_row_from_regs(Frame& F, const f32x4 (&xv)[8], int m, int l, const LAS float* wf) {
    const float* mod = (const float*)(F.ws + WS_MOD) + ((size_t)l * 8 + (m >> 11)) * 12288;
    bf16* hrow = (bf16*)(F.ws + WS_H) + (size_t)m * D;
    float fl[12];
#pragma unroll
    for (int j = 0; j < 12; ++j) fl[j] = 0.f;
#pragma unroll
    for (int j = 0; j < 8; ++j) { int k = 4 * F.lane + 256 * j; asm volatile("" : "+v"(k));
        const f32x4 sh = *(const GAS f32x4*)(mod + k), sc = *(const GAS f32x4*)(mod + 2048 + k);
        const f32x4 h = xv[j] * (sc + 1.0f) + sh;
        v2u o; o.x = pk2(h.x, h.y); o.y = pk2(h.z, h.w); *(GAS v2u*)(hrow + k) = o;
#pragma unroll
        for (int e = 0; e < 4; ++e) { const LAS f32x4* wr = (const LAS f32x4*)(wf + (k + e) * 12); const f32x4 a = wr[0], b = wr[1], c = wr[2]; const float hv = h[e];
            fl[0] += hv * a.x; fl[1] += hv * a.y; fl[2] += hv * a.z; fl[3] += hv * a.w; fl[4] += hv * b.x; fl[5] += hv * b.y; fl[6] += hv * b.z; fl[7] += hv * b.w;
            fl[8] += hv * c.x; fl[9] += hv * c.y; fl[10] += hv * c.z; fl[11] += hv * c.w; }
        asm volatile("" ::: "memory"); }
    float mine = 0.f;
#pragma unroll
    for (int j = 0; j < 12; ++j) { const float s = wave_sum(fl[j]); if (F.lane == j) mine = s; }
    if (F.lane < 12) ((float*)(F.ws + WS_FLOG))[(size_t)m * 16 + F.lane] = mine;
}
__device__ __forceinline__ void load_wf(Frame& F, int l, LAS float* wf) {
    const float* src = inptr<const float>(F, I_WIN) + (size_t)l * D * INW + NPROJ;
    for (int i = F.tid; i < D * 12; i += NWAVES * 64) { const int k = i / 12, j = i % 12; wf[i] = src[(size_t)k * INW + j]; }
    __syncthreads();
}

constexpr int APITCH = 64;
__device__ __forceinline__ size_t hm_off(int cs, int Hg, int b, int h) { return (size_t)NB * SEQ * cs + ((size_t)(b * Hg + h) * SEQ) * 64; }
namespace att {
typedef float f32x16 __attribute__((ext_vector_type(16)));
typedef short s16x4 __attribute__((ext_vector_type(4)));
typedef LAS unsigned char* lptr;
typedef float f32x2_t __attribute__((ext_vector_type(2))); typedef __bf16 bf16x2_t __attribute__((ext_vector_type(2)));
__device__ __forceinline__ unsigned cvtpk(float lo, float hi) { f32x2_t v = {lo, hi}; bf16x2_t b = __builtin_convertvector(v, bf16x2_t); return __builtin_bit_cast(unsigned, b); }
typedef short v4i16_t __attribute__((ext_vector_type(4)));
__device__ __forceinline__ s16x4 vtr(const LAS unsigned char* p) { return __builtin_bit_cast(s16x4, __builtin_amdgcn_ds_read_tr16_b64_v4i16((LAS v4i16_t*)p)); }
__device__ __forceinline__ int crow(int r, int hi) { return (r & 3) + 8 * (r >> 2) + 4 * hi; }
__device__ __forceinline__ float max3f(float a, float b, float c) { float r; asm("v_max3_f32 %0, %1, %2, %3" : "=v"(r) : "v"(a), "v"(b), "v"(c)); return r; }
__device__ __forceinline__ float max2f(float a, float b) { float r; asm("v_max_f32_e32 %0, %1, %2" : "=v"(r) : "v"(a), "v"(b)); return r; }
__device__ __forceinline__ float rowmax32(const f32x16& p0, const f32x16& p1) {
    float a = max3f(p0[0], p0[1], p1[0]), b = max3f(p0[2], p0[3], p1[1]); a = max3f(a, p1[2], p1[3]);
#pragma unroll
    for (int r = 4; r < 16; r += 4) { a = max3f(a, p0[r], p0[r + 1]); b = max3f(b, p0[r + 2], p0[r + 3]); a = max3f(a, p1[r], p1[r + 1]); b = max3f(b, p1[r + 2], p1[r + 3]); }
    return max2f(a, b);
}
__device__ __forceinline__ float rowmax16(const f32x16& p0) {
    float a = max3f(p0[0], p0[1], p0[2]), b = max3f(p0[3], p0[4], p0[5]);
    a = max3f(a, p0[6], p0[7]); b = max3f(b, p0[8], p0[9]); a = max3f(a, p0[10], p0[11]); b = max3f(b, p0[12], p0[13]); a = max3f(a, p0[14], p0[15]);
    return max2f(a, b);
}
__device__ __forceinline__ float pswap_max(float m) { auto rr = __builtin_amdgcn_permlane32_swap(__float_as_uint(m), __float_as_uint(m), false, false); return max2f(__uint_as_float(rr[0]), __uint_as_float(rr[1])); }

#define ATT_PACK8(P, B) __builtin_bit_cast(bf16x8, (v4u){cvtpk(P[B], P[B + 1]), cvtpk(P[B + 2], P[B + 3]), cvtpk(P[B + 4], P[B + 5]), cvtpk(P[B + 6], P[B + 7])})

template <int DHS>
__device__ __forceinline__ void pv_step(f32x16 (&o)[2], const LAS unsigned char* vb, int vsw, int s, bf16x8 pa) {
#pragma unroll
    for (int d0 = 0; d0 < 2; ++d0) {
        const s16x4 lo = vtr(vb + d0 * (DHS + vsw) + s * 1024), hi = vtr(vb + d0 * (DHS + vsw) + s * 1024 + 512);
        const bf16x8 vf = (bf16x8){lo[0], lo[1], lo[2], lo[3], hi[0], hi[1], hi[2], hi[3]};
        o[d0] = __builtin_amdgcn_mfma_f32_32x32x16_bf16(pa, vf, o[d0], 0, 0, 0);
    }
}
__device__ __forceinline__ void epilogue(const f32x16 (&o)[2], float linv_lane  , lptr wl, LAS float* wsf, const float* gn, unsigned char* orow0  ,
                                         int tok0, int tstride, int lane) {
    const int r32 = lane & 31, hi = lane >> 5;
    LAS float* stg = (LAS float*)wl;
#pragma unroll
    for (int r = 0; r < 16; ++r) { const int q = crow(r, hi); stg[q * 68 + r32] = o[0][r]; stg[q * 68 + 32 + r32] = o[1][r]; }
    if (hi == 0) wsf[r32] = linv_lane;
    LDS_WAIT(); asm volatile("" ::: "memory");
    const int row = lane >> 1, hf = lane & 1;
    const float li = wsf[row];
    f32x4 v[8]; float ss = 0.f;
#pragma unroll
    for (int i = 0; i < 8; ++i) { v[i] = *(const LAS f32x4*)(stg + row * 68 + hf * 32 + 4 * i) * li; ss += (v[i].x * v[i].x + v[i].y * v[i].y) + (v[i].z * v[i].z + v[i].w * v[i].w); }
    ss += __shfl_xor(ss, 1);
    const float rn = 1.0f / sqrtf(ss * (1.0f / 64.0f) + RMS_EPS);
    unsigned char* op = orow0 + (size_t)(tok0 + tstride * row) * D + hf * 32;
    const float rq = rn * 16.0f;
    unsigned wq[8];
#pragma unroll
    for (int i = 0; i < 4; ++i) { const f32x4 g0 = *(const GAS f32x4*)(gn + hf * 32 + 8 * i), g1 = *(const GAS f32x4*)(gn + hf * 32 + 8 * i + 4); const f32x4 a = v[2 * i] * rq * g0, b = v[2 * i + 1] * rq * g1;
        wq[2 * i] = pk4_fp8(a.x, a.y, a.z, a.w); wq[2 * i + 1] = pk4_fp8(b.x, b.y, b.z, b.w); }
    { v4u w0, w1; w0.x = wq[0]; w0.y = wq[1]; w0.z = wq[2]; w0.w = wq[3]; w1.x = wq[4]; w1.y = wq[5]; w1.z = wq[6]; w1.w = wq[7]; *(GAS v4u*)(op) = w0; *(GAS v4u*)(op + 16) = w1; }
    LDS_WAIT(); asm volatile("" ::: "memory");
}

__device__ __forceinline__ void qk64(f32x16& p0, f32x16& p1, const bf16x8 (&qr)[4], const LAS unsigned char* kf, const f32x16& c0, const f32x16& c1) {
    p0 = c0; p1 = c1;
#pragma unroll
    for (int d0 = 0; d0 < 4; ++d0) { const bf16x8 k0 = *(const LAS bf16x8*)(kf + d0 * 2048), k1 = *(const LAS bf16x8*)(kf + d0 * 2048 + 512);
        p0 = __builtin_amdgcn_mfma_f32_32x32x16_bf16(k0, qr[d0], p0, 0, 0, 0); p1 = __builtin_amdgcn_mfma_f32_32x32x16_bf16(k1, qr[d0], p1, 0, 0, 0); }
}
__device__ __forceinline__ void load_kf64(bf16x8 (&kf)[8], const LAS unsigned char* kt, int r32, int hi) {
#pragma unroll
    for (int d0 = 0; d0 < 4; ++d0) { const int ch = 2 * d0 + hi; const LAS unsigned char* p = kt + ch * 1024 + ((r32 ^ ch) << 4); kf[2 * d0] = *(const LAS bf16x8*)p; kf[2 * d0 + 1] = *(const LAS bf16x8*)(p + 512); }
}
template <bool ZC>
__device__ __forceinline__ void qk64_regs(f32x16& p0, f32x16& p1, const bf16x8 (&qr)[4], const bf16x8 (&kf)[8], const f32x16& c0, const f32x16& c1) {
    if (ZC) { p0 = f32x16{}; p1 = f32x16{}; } else { p0 = c0; p1 = c1; }
#pragma unroll
    for (int d0 = 0; d0 < 4; ++d0) { p0 = __builtin_amdgcn_mfma_f32_32x32x16_bf16(kf[2 * d0], qr[d0], p0, 0, 0, 0); p1 = __builtin_amdgcn_mfma_f32_32x32x16_bf16(kf[2 * d0 + 1], qr[d0], p1, 0, 0, 0); }
}
__device__ __forceinline__ void load_vf64(bf16x8 (&vf)[8], const LAS unsigned char* vb) {
#pragma unroll
    for (int s = 0; s < 4; ++s)
#pragma unroll
        for (int d0 = 0; d0 < 2; ++d0) { const s16x4 lo = vtr(vb + d0 * 4096 + s * 1024), hi = vtr(vb + d0 * 4096 + s * 1024 + 512);
            vf[2 * s + d0] = (bf16x8){lo[0], lo[1], lo[2], lo[3], hi[0], hi[1], hi[2], hi[3]}; }
}
__device__ __forceinline__ void rescale_o(f32x16 (&o)[2], float alpha, LAS float* wsf, int r32, int hi) {
    if (hi == 0) wsf[r32] = alpha;
    LDS_WAIT(); asm volatile("" ::: "memory");
#pragma unroll
    for (int j = 0; j < 4; ++j) { const f32x4 a = *(const LAS f32x4*)(wsf + 8 * j + 4 * hi);
#pragma unroll
        for (int e = 0; e < 4; ++e) { o[0][4 * j + e] *= a[e]; o[1][4 * j + e] *= a[e]; } }
    LDS_WAIT(); asm volatile("" ::: "memory");
}
constexpr float RESC_THR = 8.0f;

__device__ __forceinline__ void fox_softmax(f32x16& p0, f32x16& p1, f32x16 (&o)[2], float& mrun, float& lrun, int kv0, int qtok, bool diag, LAS float* wsf, int r32, int hi) {
    if (__builtin_amdgcn_readfirstlane((int)diag)) {
#pragma unroll
        for (int r = 0; r < 16; ++r) { const int kv = kv0 + (r & 3) + 8 * (r >> 2); if (kv > qtok) p0[r] = -INFINITY; if (kv + 32 > qtok) p1[r] = -INFINITY; } }
    float mt = pswap_max(rowmax32(p0, p1));
    if (__any(mt > mrun + RESC_THR)) { const float mnew = max2f(mrun, mt), alpha = __builtin_amdgcn_exp2f(mrun - mnew); mrun = mnew; lrun *= alpha; rescale_o(o, alpha, wsf, r32, hi); }
    float rs = 0.f;
#pragma unroll
    for (int r = 0; r < 16; ++r) { p0[r] = __builtin_amdgcn_exp2f(p0[r] - mrun); p1[r] = __builtin_amdgcn_exp2f(p1[r] - mrun); rs += p0[r] + p1[r]; }
    lrun += rs;
}
__device__ __forceinline__ void sb_weights(f32x16& p0, f32x16& p1, float& R, int kv0, int qtok, bool diag, int hi) {
    float run = 1.f;
#pragma unroll
    for (int hh = 1; hh >= 0; --hh)
#pragma unroll
        for (int j = 3; j >= 0; --j) {
            float kk[4], bb[4];
#pragma unroll
            for (int e = 0; e < 4; ++e) { const float y = hh ? p1[4 * j + e] : p0[4 * j + e]; float yc; asm("v_min_f32_e32 %0, 0x42a00000, %1" : "=v"(yc) : "v"(y)); const float ex = __builtin_amdgcn_exp2f(yc); kk[e] = __builtin_amdgcn_rcpf(1.0f + ex); bb[e] = ex * kk[e];
                if (diag) { const int kv = kv0 + 32 * hh + 8 * j + e; if (kv >= qtok) { kk[e] = 1.f; bb[e] = 0.f; } } }
            const float s2 = kk[3], s1 = kk[3] * kk[2], s0 = s1 * kk[1], Gp = s0 * kk[0];
            auto rr = __builtin_amdgcn_permlane32_swap(__float_as_uint(Gp), __float_as_uint(Gp), false, false);
            const float ga = __uint_as_float(rr[0]), gb = __uint_as_float(rr[1]);
            const float after = R * run * (hi ? 1.0f : gb);
            if (hh) { p1[4 * j] = bb[0] * after * s0; p1[4 * j + 1] = bb[1] * after * s1; p1[4 * j + 2] = bb[2] * after * s2; p1[4 * j + 3] = bb[3] * after; }
            else { p0[4 * j] = bb[0] * after * s0; p0[4 * j + 1] = bb[1] * after * s1; p0[4 * j + 2] = bb[2] * after * s2; p0[4 * j + 3] = bb[3] * after; }
            run *= ga * gb;
        }
    R *= run;
}

template <int TYPE>
__device__ __forceinline__ void causal_wg_unit(const bf16* proj, const float* cum2, const float* gn, unsigned char* obuf, int b, int h, int qb, LAS unsigned char* kvbuf, LAS float* ncum, lptr wl, LAS float* wsf, int tid, int wave) {
    const int lane = tid & 63, r32 = lane & 31, hi = lane >> 5;
    constexpr int QC = TYPE == 0 ? QCOL_SB : QCOL_FX, KC = TYPE == 0 ? KCOL_SB : KCOL_FX, VC = TYPE == 0 ? VCOL_SB : VCOL_FX;
    constexpr int HG = TYPE == 0 ? 8 : 12;
    const bf16* Qp = proj + hm_off(QC, HG, b, h); const bf16* Kp = proj + hm_off(KC, HG, b, h); const bf16* Vp = proj + hm_off(VC, HG, b, h);
    const int qt = 8 * qb + wave, qtok = 32 * qt + r32;
    bf16x8 qr[4];
#pragma unroll
    for (int d0 = 0; d0 < 4; ++d0) qr[d0] = *(const GAS bf16x8*)(Qp + (size_t)qtok * APITCH + d0 * 16 + hi * 8);
    const int NT = 4 * qb + 4, my_tlast = qt >> 1;
    const unsigned lvoff = (unsigned)(((tid >> 3) * APITCH + (tid & 7) * 8) * 2);
    const int skey = tid >> 3, sch = tid & 7;
    const int kst = sch * 1024 + ((skey ^ sch) << 4), vst = 8192 + (sch >> 2) * 4096 + ((skey ^ (sch >> 2)) << 6) + (sch & 3) * 16;
    v4u kreg, vreg;
#define ATT_TILE(s_) (TYPE == 0 ? NT - 1 - (s_) : (s_))
#define ATT_LOAD(t) do { kreg = *(const GAS v4u*)((const char*)(Kp + (size_t)(64 * (t)) * APITCH) + lvoff); vreg = *(const GAS v4u*)((const char*)(Vp + (size_t)(64 * (t)) * APITCH) + lvoff); } while (0)
#define ATT_STORE(slot) do { *(LAS v4u*)(kvbuf + (slot) * 16384 + kst) = kreg; *(LAS v4u*)(kvbuf + (slot) * 16384 + vst) = vreg; } while (0)
    if (TYPE == 1) { const int n = 256 * (qb + 1); if (4 * tid < n) { const f32x4 c = *(const GAS f32x4*)(cum2 + 4 * tid); v4u w;
#pragma unroll
        for (int e = 0; e < 4; ++e) { const float v = -c[e]; const unsigned hb = f2bf(v); const unsigned lb = f2bf(v - __builtin_bit_cast(float, hb << 16)); w[e] = hb | (lb << 16); }
        *(LAS v4u*)(ncum + 4 * tid) = w; } }
    const bf16x8 qone = hi ? (bf16x8){0, 0, 0, 0, 0, 0, 0, 0} : (bf16x8){(short)0x3f80, (short)0x3f80, 0, 0, 0, 0, 0, 0};
    f32x16 o[2]; o[0] = f32x16{}; o[1] = f32x16{};
    float mrun = -1e30f, lrun = 0.f, R = 1.f;
    const int vbo = 8192 + ((lane >> 4) & 1) * 32 + (lane & 3) * 8 + (4 * hi + ((lane & 15) >> 2)) * 64, vsw = ((lane >> 2) & 1) ? -64 : 64;
    ATT_LOAD(ATT_TILE(0)); ATT_STORE(0);
    ATT_LOAD(ATT_TILE(1)); ATT_STORE(1);
    __syncthreads();
    f32x16 pc0 = f32x16{}, pc1 = f32x16{}, pn0 = f32x16{}, pn1 = f32x16{};
#define ATT_QK(P0, P1, s_) do { const int t_ = ATT_TILE(s_); const LAS unsigned char* kb_ = kvbuf + ((s_) % 3) * 16384; \
        if (TYPE == 1) { const LAS unsigned* cw_ = (const LAS unsigned*)ncum + 64 * t_ + r32; const unsigned w0_ = hi ? 0u : cw_[0], w1_ = hi ? 0u : cw_[32]; \
            const bf16x8 ka_ = __builtin_bit_cast(bf16x8, (v4u){w0_, 0u, 0u, 0u}), kb2_ = __builtin_bit_cast(bf16x8, (v4u){w1_, 0u, 0u, 0u}); \
            bf16x8 kf_[8]; load_kf64(kf_, kb_, r32, hi); \
            f32x16 c0_ = __builtin_amdgcn_mfma_f32_32x32x16_bf16(ka_, qone, f32x16{}, 0, 0, 0), c1_ = __builtin_amdgcn_mfma_f32_32x32x16_bf16(kb2_, qone, f32x16{}, 0, 0, 0); \
            qk64_regs<false>(P0, P1, qr, kf_, c0_, c1_); } \
        else { bf16x8 kf_[8]; load_kf64(kf_, kb_, r32, hi); qk64_regs<true>(P0, P1, qr, kf_, P0, P1); } } while (0)
    if (ATT_TILE(0) <= my_tlast) ATT_QK(pc0, pc1, 0);
    constexpr float SB_DEAD = 1e-30f;
    bool dead = false;
    LAS int* aflag = (LAS int*)ncum;
    for (int s = 0; s < NT; ++s) {
        const int t = ATT_TILE(s);
        if (s + 2 < NT) ATT_LOAD(ATT_TILE(s + 2));
        const bool act = !dead && t <= my_tlast, actn = !dead && (s + 1 < NT) && (ATT_TILE(s + 1) <= my_tlast);
        if (actn) ATT_QK(pn0, pn1, s + 1);
        if (act) {
            const int kv0 = 64 * t + 4 * hi; const bool diag = (t == my_tlast);
            if (TYPE == 1) fox_softmax(pc0, pc1, o, mrun, lrun, kv0, qtok, diag, wsf, r32, hi);
            else sb_weights(pc0, pc1, R, kv0, qtok, diag, hi);
            const bf16x8 pa0 = ATT_PACK8(pc0, 0), pa1 = ATT_PACK8(pc0, 8), pa2 = ATT_PACK8(pc1, 0), pa3 = ATT_PACK8(pc1, 8);
            const LAS unsigned char* vb = kvbuf + (s % 3) * 16384 + vbo;
            pv_step<4096>(o, vb, vsw, 0, pa0); pv_step<4096>(o, vb, vsw, 1, pa1); pv_step<4096>(o, vb, vsw, 2, pa2); pv_step<4096>(o, vb, vsw, 3, pa3);
        }
        if (s + 2 < NT) ATT_STORE((s + 2) % 3);
        if (TYPE == 0) { if (act && !__any(R >= SB_DEAD)) dead = true; if (lane == 0) aflag[(s & 1) * 8 + wave] = dead ? 0 : 1; }
        __syncthreads();
        if (TYPE == 0) { const v4u f0 = *(const LAS v4u*)(aflag + (s & 1) * 8), f1 = *(const LAS v4u*)(aflag + (s & 1) * 8 + 4);
            if (((f0.x | f0.y) | (f0.z | f0.w) | (f1.x | f1.y) | (f1.z | f1.w)) == 0u) break; }
        pc0 = pn0; pc1 = pn1;
    }
#undef ATT_QK
#undef ATT_TILE
#undef ATT_LOAD
#undef ATT_STORE
    float linv = 1.0f;
    if (TYPE == 1) { auto rr = __builtin_amdgcn_permlane32_swap(__float_as_uint(lrun), __float_as_uint(lrun), false, false); linv = 1.0f / (__uint_as_float(rr[0]) + __uint_as_float(rr[1])); }
    const int headcol = TYPE == 0 ? h : 8 + h;
    epilogue(o, linv, wl, wsf, gn + headcol * 64, obuf + (size_t)b * SEQ * D + headcol * 64, 32 * qt, 1, lane);
}

__device__ __forceinline__ void qk32(f32x16& p0, const bf16x8 (&qr)[4], const LAS unsigned char* kt, int r32, int hi) {
    p0 = f32x16{};
#pragma unroll
    for (int d0 = 0; d0 < 4; ++d0) { const int ch = 2 * d0 + hi; const bf16x8 k0 = *(const LAS bf16x8*)(kt + ch * 512 + ((r32 ^ ch) << 4)); p0 = __builtin_amdgcn_mfma_f32_32x32x16_bf16(k0, qr[d0], p0, 0, 0, 0); }
}
__device__ __forceinline__ void dil_softmax_pv(f32x16& p0, f32x16 (&o)[2], float& mrun, float& lrun, const LAS unsigned char* vb, int vsw, int jq, int jb, LAS float* wsf, int r32, int hi) {
#pragma unroll
    for (int r = 0; r < 16; ++r) { const int dist = jq - (jb + (r & 3) + 8 * (r >> 2)); if ((unsigned)dist > 128u) p0[r] = -INFINITY; }
    float mt = pswap_max(rowmax16(p0));
    if (__any(mt > mrun + RESC_THR)) { const float mnew = max2f(mrun, mt), alpha = __builtin_amdgcn_exp2f(mrun - mnew); mrun = mnew; lrun *= alpha; rescale_o(o, alpha, wsf, r32, hi); }
    float rs = 0.f;
#pragma unroll
    for (int r = 0; r < 16; ++r) { p0[r] = __builtin_amdgcn_exp2f(p0[r] - mrun); rs += p0[r]; }
    lrun += rs;
    const bf16x8 pa0 = ATT_PACK8(p0, 0), pa1 = ATT_PACK8(p0, 8);
    pv_step<2048>(o, vb, vsw, 0, pa0); pv_step<2048>(o, vb, vsw, 1, pa1);
}
#define DILP_LOAD(sh_, rst_, tt_) do { const unsigned lvo_ = (unsigned)((((lane >> 3) << (sh_)) * APITCH + (lane & 7) * 8) * 2); const size_t tok0_ = (size_t)((rst_) + ((32 * (tt_)) << (sh_))); \
        const char* kb_ = (const char*)(Kp + tok0_ * APITCH); const char* vb_ = (const char*)(Vp + tok0_ * APITCH); const size_t is_ = (size_t)(8 << (sh_)) * APITCH * 2; \
        _Pragma("unroll") for (int i = 0; i < 4; ++i) { kreg[i] = *(const GAS v4u*)(kb_ + i * is_ + lvo_); vreg[i] = *(const GAS v4u*)(vb_ + i * is_ + lvo_); } } while (0)
#define DILP_STORE() do { _Pragma("unroll") for (int i = 0; i < 4; ++i) { const int id = lane + 64 * i, key = id >> 3, ch = id & 7; \
        *(LAS v4u*)(wl + ch * 512 + ((key ^ ch) << 4)) = kreg[i]; *(LAS v4u*)(wl + 4096 + (ch >> 2) * 2048 + ((key ^ (ch >> 2)) << 6) + (ch & 3) * 16) = vreg[i]; } } while (0)
__device__ __forceinline__ void dil_a_unit(const bf16* proj, bf16* SO, float* SM, gu32* done, int b, int h, int qb, lptr wl, LAS float* wsf, int tid, int wave) {
    const int lane = tid & 63, r32 = lane & 31, hi = lane >> 5;
    const bf16* Qp = proj + hm_off(QCOL_DL, 12, b, h); const bf16* Kp = proj + hm_off(KCOL_DL, 12, b, h); const bf16* Vp = proj + hm_off(VCOL_DL, 12, b, h);
    const int qt = 8 * qb + wave, qtok = 32 * qt + r32;
    bf16x8 qr[4];
#pragma unroll
    for (int d0 = 0; d0 < 4; ++d0) qr[d0] = *(const GAS bf16x8*)(Qp + (size_t)qtok * APITCH + d0 * 16 + hi * 8);
    f32x16 o[2]; o[0] = f32x16{}; o[1] = f32x16{};
    float mrun = -1e30f, lrun = 0.f;
    const int vbo = 4096 + ((lane >> 4) & 1) * 32 + (lane & 3) * 8 + (4 * hi + ((lane & 15) >> 2)) * 64, vsw = ((lane >> 2) & 1) ? -64 : 64;
    v4u kreg[4], vreg[4];
    int tt = qt > 4 ? qt - 4 : 0;
    DILP_LOAD(0, 0, tt);
    for (;;) {
        DILP_STORE();
        const int jb = 32 * tt + 4 * hi; const bool more = tt < qt;
        if (more) { ++tt; DILP_LOAD(0, 0, tt); }
        f32x16 p0; qk32(p0, qr, wl, r32, hi);
        dil_softmax_pv(p0, o, mrun, lrun, wl + vbo, vsw, qtok, jb, wsf, r32, hi);
        if (!more) break;
    }
    { auto rr = __builtin_amdgcn_permlane32_swap(__float_as_uint(lrun), __float_as_uint(lrun), false, false); lrun = __uint_as_float(rr[0]) + __uint_as_float(rr[1]); }
    const size_t srow0 = ((size_t)(b * 12 + h) * SEQ + 32 * qt);
    if (hi == 0) __hip_atomic_store((unsigned long long*)(SM + (srow0 + r32) * 2), ((unsigned long long)__float_as_uint(lrun) << 32) | __float_as_uint(mrun), RLX_AGENT);
    LAS float* stg = (LAS float*)wl;
#pragma unroll
    for (int r = 0; r < 16; ++r) { const int q = crow(r, hi); stg[q * 68 + r32] = o[0][r]; stg[q * 68 + 32 + r32] = o[1][r]; }
    LDS_WAIT(); asm volatile("" ::: "memory");
    { const int row = lane >> 1, hf = lane & 1; bf16* op = SO + (srow0 + row) * 64 + hf * 32;
#pragma unroll
      for (int i = 0; i < 4; ++i) { const f32x4 a = *(const LAS f32x4*)(stg + row * 68 + hf * 32 + 8 * i), c = *(const LAS f32x4*)(stg + row * 68 + hf * 32 + 8 * i + 4);
          v4u w; w.x = pk2(a.x, a.y); w.y = pk2(a.z, a.w); w.z = pk2(c.x, c.y); w.w = pk2(c.z, c.w);
          asm volatile("global_store_dwordx4 %0, %1, off sc1" :: "v"(op + 8 * i), "v"(w) : "memory"); } }
    LDS_WAIT();
    asm volatile("s_waitcnt vmcnt(0)" ::: "memory");
    __syncthreads();
    if (tid == 0) __hip_atomic_fetch_add(done, 1u, RLX_AGENT);
}
__device__ __forceinline__ void dil_b_unit(const bf16* proj, const bf16* SO, const float* SM, gu32* done, gu32* tmo, const float* gn, unsigned char* obuf, int b, int h, int blk, int half, lptr wl, LAS float* wsf, int tid, int wave) {
    const int lane = tid & 63, r32 = lane & 31, hi = lane >> 5, r16 = 8 * half + wave;
    if (tid == 0) { unsigned sp = 0; while (__hip_atomic_load(done, RLX_AGENT) < 2u) { __builtin_amdgcn_s_sleep(2); if (++sp > (1u << 22)) { __hip_atomic_store(tmo, 1u, RLX_AGENT); break; } }
        __builtin_amdgcn_fence(__ATOMIC_ACQUIRE, "agent"); asm volatile("s_waitcnt vmcnt(0)" ::: "memory"); }
    __syncthreads();
    const bf16* Qp = proj + hm_off(QCOL_DL, 12, b, h); const bf16* Kp = proj + hm_off(KCOL_DL, 12, b, h); const bf16* Vp = proj + hm_off(VCOL_DL, 12, b, h);
    const int p0tok = 512 * blk + r16;
    bf16x8 qr[4];
#pragma unroll
    for (int d0 = 0; d0 < 4; ++d0) qr[d0] = *(const GAS bf16x8*)(Qp + (size_t)(p0tok + 16 * r32) * APITCH + d0 * 16 + hi * 8);
    const size_t srow0 = (size_t)(b * 12 + h) * SEQ + p0tok;
    const f32x2_t ml = *(const GAS f32x2_t*)(SM + (srow0 + 16 * r32) * 2);
    float mrun = ml.x, lrun = hi ? 0.f : ml.y;
    f32x16 o[2];
    { LAS float* stg = (LAS float*)wl; const int row = lane >> 1, hf = lane & 1; const bf16* ip = SO + (srow0 + 16 * row) * 64 + hf * 32;
#pragma unroll
      for (int i = 0; i < 4; ++i) { const v4u w = *(const GAS v4u*)(ip + 8 * i);
          *(LAS f32x4*)(stg + row * 68 + hf * 32 + 8 * i) = (f32x4){bflo(w.x), bfhi(w.x), bflo(w.y), bfhi(w.y)}; *(LAS f32x4*)(stg + row * 68 + hf * 32 + 8 * i + 4) = (f32x4){bflo(w.z), bfhi(w.z), bflo(w.w), bfhi(w.w)}; }
      LDS_WAIT(); asm volatile("" ::: "memory");
#pragma unroll
      for (int r = 0; r < 16; ++r) { const int q = crow(r, hi); o[0][r] = stg[q * 68 + r32]; o[1][r] = stg[q * 68 + 32 + r32]; }
      LDS_WAIT(); asm volatile("" ::: "memory"); }
    const int vbo = 4096 + ((lane >> 4) & 1) * 32 + (lane & 3) * 8 + (4 * hi + ((lane & 15) >> 2)) * 64, vsw = ((lane >> 2) & 1) ? -64 : 64;
    {
        int sh = 2, rst = r16 & 3, jq0 = (p0tok - rst) >> 2, dj = 4;
        int tt = (jq0 > 128 ? jq0 - 128 : 0) >> 5, thi = (jq0 + dj * 31) >> 5;
        v4u kreg[4], vreg[4];
        DILP_LOAD(sh, rst, tt);
        for (;;) {
            DILP_STORE();
            const int jq = jq0 + dj * r32, jb = 32 * tt + 4 * hi;
            bool more = true;
            if (tt < thi) ++tt;
            else if (sh == 2) { sh = 4; rst = r16; jq0 = (p0tok - rst) >> 4; dj = 1; tt = (jq0 > 128 ? jq0 - 128 : 0) >> 5; thi = (jq0 + 31) >> 5; }
            else more = false;
            if (more) DILP_LOAD(sh, rst, tt);
            f32x16 p0; qk32(p0, qr, wl, r32, hi);
            dil_softmax_pv(p0, o, mrun, lrun, wl + vbo, vsw, jq, jb, wsf, r32, hi);
            if (!more) break;
        }
    }
    auto rr = __builtin_amdgcn_permlane32_swap(__float_as_uint(lrun), __float_as_uint(lrun), false, false);
    const float linv = 1.0f / (__uint_as_float(rr[0]) + __uint_as_float(rr[1]));
    epilogue(o, linv, wl, wsf, gn + (20 + h) * 64, obuf + (size_t)b * SEQ * D + (20 + h) * 64, p0tok, 16, lane);
}
__device__ __forceinline__ void sb_wave_unit(const bf16* proj, const float* gn, unsigned char* obuf, int b, int h, int qt, lptr wl, LAS float* wsf, int lane) {
    const int r32 = lane & 31, hi = lane >> 5;
    const bf16* Qp = proj + hm_off(QCOL_SB, 8, b, h); const bf16* Kp = proj + hm_off(KCOL_SB, 8, b, h); const bf16* Vp = proj + hm_off(VCOL_SB, 8, b, h);
    const int qtok = 32 * qt + r32;
    bf16x8 qr[4];
#pragma unroll
    for (int d0 = 0; d0 < 4; ++d0) qr[d0] = *(const GAS bf16x8*)(Qp + (size_t)qtok * APITCH + d0 * 16 + hi * 8);
    f32x16 o[2]; o[0] = f32x16{}; o[1] = f32x16{};
    float R = 1.f;
    const int vbo = 4096 + ((lane >> 4) & 1) * 32 + (lane & 3) * 8 + (4 * hi + ((lane & 15) >> 2)) * 64, vsw = ((lane >> 2) & 1) ? -64 : 64;
    v4u kreg[4], vreg[4];
    int tt = qt;
    DILP_LOAD(0, 0, tt);
    for (;;) {
        DILP_STORE();
        const int kv0 = 32 * tt + 4 * hi; const bool diag = (tt == qt), more = tt > 0;
        if (more) { DILP_LOAD(0, 0, tt - 1); }
        f32x16 p0; qk32(p0, qr, wl, r32, hi);
        asm volatile("s_nop 15\n\ts_nop 7" : "+v"(p0));
        float run = 1.f;
#pragma unroll
        for (int j = 3; j >= 0; --j) {
            float kk[4], bb[4];
#pragma unroll
            for (int e = 0; e < 4; ++e) { float yc; asm("v_min_f32_e32 %0, 0x42a00000, %1" : "=v"(yc) : "v"(p0[4 * j + e])); const float ex = __builtin_amdgcn_exp2f(yc); kk[e] = __builtin_amdgcn_rcpf(1.0f + ex); bb[e] = ex * kk[e];
                if (diag) { const int kv = kv0 + 8 * j + e; if (kv >= qtok) { kk[e] = 1.f; bb[e] = 0.f; } } }
            const float s2 = kk[3], s1 = kk[3] * kk[2], s0 = s1 * kk[1], Gp = s0 * kk[0];
            auto rr = __builtin_amdgcn_permlane32_swap(__float_as_uint(Gp), __float_as_uint(Gp), false, false);
            const float ga = __uint_as_float(rr[0]), gb = __uint_as_float(rr[1]);
            const float after = R * run * (hi ? 1.0f : gb);
            p0[4 * j] = bb[0] * after * s0; p0[4 * j + 1] = bb[1] * after * s1; p0[4 * j + 2] = bb[2] * after * s2; p0[4 * j + 3] = bb[3] * after;
            run *= ga * gb;
        }
        R *= run;
        const bf16x8 pa0 = ATT_PACK8(p0, 0), pa1 = ATT_PACK8(p0, 8);
        pv_step<2048>(o, wl + vbo, vsw, 0, pa0); pv_step<2048>(o, wl + vbo, vsw, 1, pa1);
        if (!more || !__any(R >= 1e-30f)) break;
        --tt;
    }
    epilogue(o, 1.0f, wl, wsf, gn + h * 64, obuf + (size_t)b * SEQ * D + h * 64, 32 * qt, 1, lane);
}
#undef DILP_LOAD
#undef DILP_STORE
#undef ATT_PACK8
}

using pg8::Unit; using pg8::HALF; using pg8::BM; using pg8::cvt_pk_bf16;
struct EpiProj {
    static constexpr bool PERM = true;
    bf16* O; const float* tab;
    __device__ __forceinline__ bf16* dst(int row, int c) const {
        const int cs = c < 1536 ? (c >> 9) << 9 : 1536 + ((c - 1536) / 768) * 768, Hg = c < 1536 ? 8 : 12;
        const int hl = (c - cs) >> 6, d = c & 63, b = row >> 11, sq = row & 2047;
        return O + (size_t)NB * SEQ * cs + ((size_t)(b * Hg + hl) * SEQ + sq) * 64 + d;
    }
    __device__ __forceinline__ void operator()(const f32x4 (&acc)[2][2][4][2], const Unit& u, int wr, int wc, int fr, int fq) const {
        const int row0 = u.pm * BM + wr * 64 + fr, pn = u.pn;
        const bool isq = (pn < 2) || (pn >= 6 && pn < 9) || (pn >= 15 && pn < 18);
        const float sc = isq ? C2 : 1.0f;
        if (pn >= 15 && pn < 21) {
            const int col = pn * 256 + wc * 64 + 8 * fq;
            f32x4 tn[4];
            { const float* tr = tab + (size_t)row0 * 64 + 8 * fq; tn[0] = *(const GAS f32x4*)(tr); tn[1] = *(const GAS f32x4*)(tr + 4); tn[2] = *(const GAS f32x4*)(tr + 32); tn[3] = *(const GAS f32x4*)(tr + 36); }
#pragma unroll
            for (int ai = 0; ai < 2; ++ai)
#pragma unroll
                for (int m = 0; m < 4; ++m) { const int row = row0 + ai * HALF + m * 16;
                    const f32x4 c0 = tn[0], c1 = tn[1], s0 = tn[2], s1 = tn[3];
                    if (ai * 4 + m < 7) { const int rown = row0 + ((ai * 4 + m + 1) >> 2) * HALF + ((ai * 4 + m + 1) & 3) * 16; const float* tr = tab + (size_t)rown * 64 + 8 * fq;
                        tn[0] = *(const GAS f32x4*)(tr); tn[1] = *(const GAS f32x4*)(tr + 4); tn[2] = *(const GAS f32x4*)(tr + 32); tn[3] = *(const GAS f32x4*)(tr + 36); }
                    const f32x4 a0 = acc[ai][0][m][0] * sc, a1 = acc[ai][0][m][1] * sc, b0 = acc[ai][1][m][0] * sc, b1 = acc[ai][1][m][1] * sc;
                    const f32x4 l0 = a0 * c0 - b0 * s0, l1 = a1 * c1 - b1 * s1, h0 = a0 * s0 + b0 * c0, h1 = a1 * s1 + b1 * c1;
                    pg8::u32x4 wl, wh; wl.x = cvt_pk_bf16(l0[0], l0[1]); wl.y = cvt_pk_bf16(l0[2], l0[3]); wl.z = cvt_pk_bf16(l1[0], l1[1]); wl.w = cvt_pk_bf16(l1[2], l1[3]);
                    wh.x = cvt_pk_bf16(h0[0], h0[1]); wh.y = cvt_pk_bf16(h0[2], h0[3]); wh.z = cvt_pk_bf16(h1[0], h1[1]); wh.w = cvt_pk_bf16(h1[2], h1[3]);
                    bf16* rp = dst(row, col); *(pg8::u32x4*)rp = wl; *(pg8::u32x4*)(rp + 32) = wh;
                    asm volatile("" ::: "memory"); }
        } else {
            const int col0 = pn * 256 + wc * 32 + 8 * fq;
#pragma unroll
            for (int ai = 0; ai < 2; ++ai)
#pragma unroll
                for (int m = 0; m < 4; ++m) { const int row = row0 + ai * HALF + m * 16;
#pragma unroll
                    for (int bj = 0; bj < 2; ++bj) { const f32x4 v0 = acc[ai][bj][m][0] * sc, v1 = acc[ai][bj][m][1] * sc;
                        pg8::u32x4 w; w.x = cvt_pk_bf16(v0[0], v0[1]); w.y = cvt_pk_bf16(v0[2], v0[3]); w.z = cvt_pk_bf16(v1[0], v1[1]); w.w = cvt_pk_bf16(v1[2], v1[3]);
                        *(pg8::u32x4*)dst(row, col0 + bj * HALF) = w; } }
        }
    }
};
struct EpiMix {
    static constexpr bool PERM = true;
    bf16* O;
    __device__ __forceinline__ void operator()(const f32x4 (&acc)[2][2][4][2], const Unit& u, int wr, int wc, int fr, int fq) const {
        const int row0 = u.pm * BM + wr * 64 + fr, col0 = u.pn * BM + wc * 32 + 8 * fq;
#pragma unroll
        for (int ai = 0; ai < 2; ++ai)
#pragma unroll
            for (int m = 0; m < 4; ++m) { bf16* rowp = O + (size_t)(row0 + ai * HALF + m * 16) * D + col0;
#pragma unroll
                for (int bj = 0; bj < 2; ++bj) { const f32x4 v0 = acc[ai][bj][m][0], v1 = acc[ai][bj][m][1];
                    pg8::u32x4 w; w.x = cvt_pk_bf16(v0[0], v0[1]); w.y = cvt_pk_bf16(v0[2], v0[3]); w.z = cvt_pk_bf16(v1[0], v1[1]); w.w = cvt_pk_bf16(v1[2], v1[3]);
                    *(pg8::u32x4*)(rowp + bj * HALF) = w; } }
    }
};
struct EpiSwiglu {
    static constexpr bool PERM = true;
    unsigned char* O;
    __device__ __forceinline__ void operator()(const f32x4 (&acc)[2][2][4][2], const Unit& u, int wr, int wc, int fr, int fq) const {
        const int row0 = u.pm * BM + wr * 64 + fr, col0 = (u.pn & 3) * 128 + wc * 32 + 8 * fq;
#pragma unroll
        for (int ai = 0; ai < 2; ++ai)
#pragma unroll
            for (int m = 0; m < 4; ++m) { float r[8];
#pragma unroll
                for (int n = 0; n < 2; ++n)
#pragma unroll
                    for (int e = 0; e < 4; ++e) { const float g = acc[ai][0][m][n][e], up = acc[ai][1][m][n][e]; r[4 * n + e] = g * __builtin_amdgcn_rcpf(1.0f + __builtin_amdgcn_exp2f(-g * LOG2E)) * up * (float)(1 << ASHIFT); }
                v2u w; w.x = pk4_fp8(r[0], r[1], r[2], r[3]); w.y = pk4_fp8(r[4], r[5], r[6], r[7]);
                *(v2u*)(O + (size_t)(row0 + ai * HALF + m * 16) * EH + col0) = w; }
    }
};
struct EpiDown {
    static constexpr bool PERM = true;
    unsigned char* O;
    const LAS int* tileE; const LAS int* tb; const LAS int* cnt; const int* list2;
    __device__ __forceinline__ void operator()(const f32x4 (&acc)[2][2][4][2], const Unit& u, int wr, int wc, int fr, int fq) const {
        const int col0 = (u.pn & 7) * 256 + wc * 64 + 16 * fq;
        const int e = tileE[u.pm], lbase = (u.pm - tb[e]) * 256 + wr * 64 + fr, ce = cnt[e];
        const float ysc = (float)(1 << YSHIFT);
        int drow[2][4];
#pragma unroll
        for (int ai = 0; ai < 2; ++ai)
#pragma unroll
            for (int m = 0; m < 4; ++m) { const int local = lbase + ai * HALF + m * 16; drow[ai][m] = (e >= NE) ? (local * 7 + 6) : ((local < ce) ? list2[(size_t)e * LISTCAP + local] : 7 * T); }
#pragma unroll
        for (int ai = 0; ai < 2; ++ai)
#pragma unroll
            for (int m = 0; m < 4; ++m) { unsigned char* rowp = O + (size_t)drow[ai][m] * D + col0;
                const f32x4 a0 = acc[ai][0][m][0] * ysc, a1 = acc[ai][0][m][1] * ysc, b0 = acc[ai][1][m][0] * ysc, b1 = acc[ai][1][m][1] * ysc;
                v4u w; w.x = pk4_fp8(a0[0], a0[1], a0[2], a0[3]); w.y = pk4_fp8(a1[0], a1[1], a1[2], a1[3]); w.z = pk4_fp8(b0[0], b0[1], b0[2], b0[3]); w.w = pk4_fp8(b1[0], b1[1], b1[2], b1[3]);
                *(v4u*)rowp = w; }
    }
};
template <bool GATHER_, int NT>
struct MoeOrder {
    static constexpr bool GATHER = GATHER_;
    int G, c, nunits; const LAS int* tileE; const LAS int* tb; const LAS int* cnt; const int* list; unsigned K2;
    __device__ __forceinline__ bool next(int i, Unit& u) const {
        const int v = ((G & 7) == 0) ? (c & 7) * (G >> 3) + (c >> 3) : c;
        const int L = i * G + v; if (L >= nunits) return false;
        const int pm = L / NT, pl = L % NT; u.pm = pm; u.pn = tileE[pm] * NT + pl; return true;
    }
    __device__ __forceinline__ unsigned tok_off(const Unit& u, int r) const {
        const int e = tileE[u.pm], local = (u.pm - tb[e]) * 256 + r;
        int tok = local;
        if (e < NE) tok = (local < cnt[e]) ? list[(size_t)e * LISTCAP + local] : 0;
        return (unsigned)tok * K2;
    }
};
__device__ __forceinline__ void build_tables(Frame& F, int l) {
    LAS int* tileE = (LAS int*)(F.lds + TILEE_OFF); LAS int* tb = (LAS int*)(F.lds + TB_OFF); LAS int* cnt = (LAS int*)(F.lds + CNT_OFF);
    if (F.wave == 0) {
        int c = (int)__hip_atomic_load(F.ctl + CW_CURSOR + (l * 64 + F.lane) * 16, RLX_AGENT); if (c > LISTCAP) c = LISTCAP;
        const int tiles = (c + 255) >> 8; int inc = tiles;
#pragma unroll
        for (int o = 1; o < 64; o <<= 1) { const int t = __shfl_up(inc, o); if (F.lane >= o) inc += t; }
        cnt[F.lane] = c; tb[F.lane] = inc - tiles;
        if (F.lane == 63) { cnt[64] = T; tb[64] = inc; tb[65] = inc + 64; }
    }
    __syncthreads();
    const int nt = tb[65];
    for (int pm = F.tid; pm < nt; pm += NWAVES * 64) { int e = 0;
#pragma unroll 1
        for (int step = 64; step >= 1; step >>= 1) { const int q = e + step; if (q <= 64 && tb[q] <= pm) e = q; }
        tileE[pm] = e; }
    __syncthreads();
}

#if MK_ONE_LAUNCH
#define GRID_BAR() xcd_barrier(bar, F.tid == 0)
#else
#define GRID_BAR() do { } while (0)
#endif
#ifndef ONLY_PHASE
#define ONLY_PHASE -1
#endif
#define IN(k) ((ONLY_PHASE < 0 || ONLY_PHASE == ((k) < 1 ? (k) : 1 + ((k) - 1) % 8)) && lo <= (k) && (k) < hi)
#define BOTH(k) (IN(k) && IN((k) + 1))
#ifndef REPEAT_MASK
#define REPEAT_MASK 0
#endif
#define NREP(k) (1 + ((REPEAT_MASK >> (k)) & 1))
__device__ __forceinline__ int affine_item(int item_, int G) { if (G != 256) return item_; const int c = item_ & 255, i = item_ >> 8; return 64 * (c & 7) + (c >> 3) + 32 * i; }
template <int l>
__device__ __forceinline__ void layer_phases(Frame& F, const XcdBarrier& bar, const int lo, const int hi) {
    unsigned char* ws = F.ws;
    const int gw = blockIdx.x * NWAVES + F.wave, NGW = F.G * NWAVES;
    constexpr int pb = 2 + 8 * l;

        if (IN(pb - 1)) for (int rep = 0; rep < NREP(1); ++rep) {
            refresh(F);
            LAS unsigned char* hs = F.lds + RING_OFF;
            LAS float* part = (LAS float*)(F.lds + RING_OFF);
            const unsigned char* wff = ws + WS_WF + (size_t)l * 262144;
            const float* Fx = inptr<const float>(F, I_X); const bf16* Xb = (const bf16*)(ws + WS_X2B);
            bf16* hbuf = (bf16*)(ws + WS_H); float* flog = (float*)(ws + WS_FLOG);
            for (int item_ = blockIdx.x; item_ < T / 32; item_ += F.G) {
                const int ia_ = affine_item(item_, F.G);
                const int item = (l == 1) ? ((F.G == 256) ? ((ia_ & ~63) + 63 - (ia_ & 63)) : (T / 32 - 1 - item_)) : ia_;
                const int m0 = item * 32 + 4 * F.wave;
                int lq = F.lane; asm volatile("" : "+v"(lq));
                const int r32 = lq & 31, hi5 = lq >> 5;
                const float* mrow = (const float*)(ws + WS_MOD) + ((size_t)l * 8 + (m0 >> 11)) * 12288;
                f32x4 xv[4][8];
#pragma unroll
                for (int rr = 0; rr < 4; ++rr)
#pragma unroll
                    for (int j = 0; j < 8; ++j) { const size_t o0 = (size_t)(m0 + rr) * D + 4 * lq + 256 * j;
                        if (l == 0) xv[rr][j] = __builtin_nontemporal_load((const GAS f32x4*)(Fx + o0)); else { const v2u a = __builtin_nontemporal_load((const GAS v2u*)(Xb + o0)); xv[rr][j] = bf4(a.x, a.y); } }
#pragma unroll
                for (int j = 0; j < 8; ++j) { const int k = 4 * lq + 256 * j;
                    const f32x4 sh = *(const GAS f32x4*)(mrow + k), sc = *(const GAS f32x4*)(mrow + 2048 + k) + 1.0f;
#pragma unroll
                    for (int rr = 0; rr < 4; ++rr) { const int rloc = 4 * F.wave + rr; const f32x4 h = xv[rr][j] * sc + sh;
                        v2u o; o.x = pk2(h.x, h.y); o.y = pk2(h.z, h.w);
                        *(GAS v2u*)(hbuf + (size_t)(m0 + rr) * D + k) = o;
                        const int chunk = (lq >> 1) + 32 * j;
                        *(LAS v2u*)(hs + rloc * 4096 + ((chunk ^ (rloc & 15)) << 4) + (lq & 1) * 8) = o; } }
                asm volatile("" ::: "memory");
                bf16x8 bw[16][2];
                { const unsigned char* wb = wff + (size_t)(16 * F.wave) * 2048 + lq * 16;
#pragma unroll
                  for (int q = 0; q < 16; ++q) { bw[q][0] = *(const GAS bf16x8*)(wb + q * 2048); bw[q][1] = *(const GAS bf16x8*)(wb + q * 2048 + 1024); } }
                __syncthreads();
                att::f32x16 acc0 = att::f32x16{};
#pragma unroll
                for (int q = 0; q < 16; ++q) { const int ks = 16 * F.wave + q;
                    const bf16x8 af = *(const LAS bf16x8*)(hs + r32 * 4096 + (((2 * ks + hi5) ^ (r32 & 15)) << 4));
                    acc0 = __builtin_amdgcn_mfma_f32_32x32x16_bf16(af, bw[q][0], acc0, 0, 0, 0); acc0 = __builtin_amdgcn_mfma_f32_32x32x16_bf16(af, bw[q][1], acc0, 0, 0, 0); }
                __syncthreads();
#pragma unroll
                for (int r = 0; r < 16; ++r) part[(F.wave * 32 + att::crow(r, hi5)) * 32 + r32] = acc0[r];
                __syncthreads();
                if (F.tid < 32 * NFOX) { const int row = F.tid / NFOX, j = F.tid % NFOX; float sacc = 0.f;
#pragma unroll
                    for (int w = 0; w < 8; ++w) sacc += part[(w * 32 + row) * 32 + j];
                    flog[(size_t)(item * 32 + row) * 16 + j] = sacc; }
                __syncthreads();
            }
            __syncthreads();
            if (BOTH(pb - 1)) GRID_BAR();
        }
        if (IN(pb + 0)) for (int rep = 0; rep < NREP(2); ++rep) {
            refresh(F);
            if ((int)blockIdx.x < NB * NFOX) {
                const int b = blockIdx.x / NFOX, hh = blockIdx.x % NFOX;
                const float* fl = (const float*)(ws + WS_FLOG) + (size_t)b * SEQ * 16 + hh; const float bf = inptr<const float>(F, I_BFORGET)[l * NFOX + hh];
                LAS float* wtot = (LAS float*)(F.lds + RING_OFF);
                float v[4], run = 0.f;
#pragma unroll
                for (int i = 0; i < 4; ++i) { const float z = fl[(size_t)(4 * F.tid + i) * 16] + bf; const float ls = fminf(z, 0.f) - log1pf(__expf(-fabsf(z))); run += ls * LOG2E; v[i] = run; }
                float inc = run;
#pragma unroll
                for (int o = 1; o < 64; o <<= 1) { const float t = __shfl_up(inc, o); if (F.lane >= o) inc += t; }
                if (F.lane == 63) wtot[F.wave] = inc;
                __syncthreads();
                float basev = inc - run;
                for (int w = 0; w < F.wave; ++w) basev += wtot[w];
                float* co = (float*)(ws + WS_CUM) + (size_t)blockIdx.x * SEQ + 4 * F.tid;
#pragma unroll
                for (int i = 0; i < 4; ++i) co[i] = basev + v[i];
                __syncthreads();
            }
            const bf16* WL = (const bf16*)(ws + WS_W + (size_t)l * W_LAYER);
            pg8::Gemm g{(const void*)(ws + WS_H), (const void*)(WL + W_IN_OFF / 2), D * 2, 127, 127}; pg8::StaticOrder S; S.init(T, NPROJ, F.G, (int)blockIdx.x);
            EpiProj E{(bf16*)(ws + WS_PROJ), (const float*)(ws + WS_TAB)};
            pg8::gemm_phase<EpiProj, pg8::StaticOrder, true>(F.lds + RING_OFF, g, S, E, F.wave, F.lane);
            if (BOTH(pb + 0)) GRID_BAR();
        }
        if (IN(pb + 1)) for (int rep = 0; rep < NREP(3); ++rep) {
            refresh(F);
            const bf16* proj = (const bf16*)(ws + WS_PROJ); unsigned char* obuf = ws + WS_OBUF;
            const float* gn = inptr<const float>(F, I_HNG) + (size_t)l * D;
            LAS unsigned char* kvbuf = F.lds + RING_OFF; LAS float* ncum = (LAS float*)(F.lds + RING_OFF + 49152); att::lptr wl = F.lds + RING_OFF + 57344 + F.wave * 9216; LAS float* wsf = (LAS float*)(F.lds + WSF_OFF + F.wave * 256);
            volatile LAS unsigned* uslot = (volatile LAS unsigned*)(F.lds + MISC_OFF + 64);
            const int qid = blockIdx.x & 7;
#ifndef ATT_ONLY
#define ATT_ONLY -1
#endif
#define ATT_DEQ(ctrp, out) do { __syncthreads(); if (F.tid == 0) uslot[0] = __hip_atomic_fetch_add((ctrp), 1u, RLX_AGENT); __syncthreads(); (out) = (int)uslot[0] * 8 + qid; } while (0)
            bf16* dstO = (bf16*)(ws + WS_DST_O); float* dstM = (float*)(ws + WS_DST_M);
            if (rep == 0) { gu32* ctr = F.ctl + CW_AQ + ((l * 4 + 3) * 8 + qid) * 64;
              for (;;) { int gi; ATT_DEQ(ctr, gi); if (gi >= 768) break;
                  const int sl_ = gi >> 3, qb = sl_ / 12, bh = 12 * (gi & 7) + sl_ % 12;
                  att::dil_a_unit(proj, dstO, dstM, F.ctl + CW_DA + ((l * 96 + bh) * 4 + (qb >> 1)) * 16, bh / 12, bh % 12, qb, wl, wsf, F.tid, F.wave); } }
            if (ATT_ONLY < 0 || ATT_ONLY == 0) { gu32* ctr = F.ctl + CW_AQ + ((l * 4 + 0) * 8 + qid) * 64 + rep * 32;
              for (;;) { int gi; ATT_DEQ(ctr, gi); if (gi >= 512) break;
                  const int sl_ = gi >> 3, qb = 7 - sl_ / 8, bh = 8 * (gi & 7) + (sl_ & 7);
                  att::sb_wave_unit(proj, gn, obuf, bh >> 3, bh & 7, 8 * qb + F.wave, wl, wsf, F.lane); } }
            if (ATT_ONLY < 0 || ATT_ONLY == 1) { gu32* ctr = F.ctl + CW_AQ + ((l * 4 + 1) * 8 + qid) * 64 + rep * 32;
              for (;;) { int gi; ATT_DEQ(ctr, gi); if (gi >= 768) break;
                  const int sl_ = gi >> 3, qb = 7 - sl_ / 12, bh = 12 * (gi & 7) + sl_ % 12;
                  att::causal_wg_unit<1>(proj, (const float*)(ws + WS_CUM) + (size_t)bh * SEQ, gn, obuf, bh / 12, bh % 12, qb, kvbuf, ncum, wl, wsf, F.tid, F.wave); } }
            if (ATT_ONLY < 0 || ATT_ONLY == 2) { gu32* ctr = F.ctl + CW_AQ + ((l * 4 + 2) * 8 + qid) * 64 + rep * 32;
              for (;;) { int gi; ATT_DEQ(ctr, gi); if (gi >= 768) break;
                  const int sl_ = gi >> 3, blk = 3 - sl_ / 24, r_ = sl_ % 24, bh = 12 * (gi & 7) + (r_ >> 1), half = r_ & 1;
                  att::dil_b_unit(proj, dstO, dstM, F.ctl + CW_DA + ((l * 96 + bh) * 4 + blk) * 16, F.ctl + CW_TMO, gn, obuf, bh / 12, bh % 12, blk, half, wl, wsf, F.tid, F.wave); } }
#undef ATT_DEQ
            __syncthreads();
            if (BOTH(pb + 1)) GRID_BAR();
        }
        if (IN(pb + 2)) for (int rep = 0; rep < NREP(4); ++rep) {
            refresh(F);
            const bf16* WL = (const bf16*)(ws + WS_W + (size_t)l * W_LAYER);
            pg8::Gemm g{(const void*)(ws + WS_OBUF), (const void*)(WL + W_OUT_OFF / 2), D, 127 - WSHIFT, 127 - ASHIFT}; pg8::StaticOrder S; S.init(T, D, F.G, (int)blockIdx.x);
            EpiMix E{(bf16*)(ws + WS_Y1)};
            pg8::gemm_phase<EpiMix, pg8::StaticOrder, true, true>(F.lds + RING_OFF, g, S, E, F.wave, F.lane);
            if (BOTH(pb + 2)) GRID_BAR();
        }
        if (IN(pb + 3)) for (int rep = 0; rep < NREP(5); ++rep) {
            refresh(F);
            const bf16* mixb = (const bf16*)(ws + WS_Y1); const float* xin = inptr<const float>(F, I_X); const bf16* xinb = (const bf16*)(ws + WS_X2B); bf16* x1 = (bf16*)(ws + WS_X1); unsigned char* h2q = ws + WS_H2;
            const float* g1 = inptr<const float>(F, I_LN1G) + (size_t)l * D; const float* b1 = inptr<const float>(F, I_LN1B) + (size_t)l * D;
            int* tinfo = (int*)(ws + WS_TINFO); float* gates = (float*)(ws + WS_GATE); int* list = (int*)(ws + WS_LIST); int* list2 = (int*)(ws + WS_LIST2);
            LAS unsigned char* h2s = F.lds + RING_OFF;
            LAS float* part = (LAS float*)(F.lds + RING_OFF);
            const unsigned char* wrf = ws + WS_WR + (size_t)l * 524288;
            const float rb = inptr<const float>(F, I_RBIAS)[l * NE + F.lane];
            for (int item_ = blockIdx.x; item_ < T / 32; item_ += F.G) {
                const int item = affine_item(item_, F.G);
                const int m0 = item * 32 + 4 * F.wave;
                int lq = F.lane; asm volatile("" : "+v"(lq));
                const int r32 = lq & 31, hi5 = lq >> 5;
                const float* mrow = (const float*)(ws + WS_MOD) + ((size_t)l * 8 + (m0 >> 11)) * 12288;
#pragma unroll
                for (int rp = 0; rp < 2; ++rp) {
                f32x4 vv[2][8];
#pragma unroll
                for (int rr = 0; rr < 2; ++rr)
#pragma unroll
                    for (int j = 0; j < 8; ++j) { const size_t off = (size_t)(m0 + 2 * rp + rr) * D + 4 * lq + 256 * j;
                        f32x4 xv; if (l == 0) xv = __builtin_nontemporal_load((const GAS f32x4*)(xin + off)); else { const v2u xw_ = __builtin_nontemporal_load((const GAS v2u*)(xinb + off)); xv = bf4(xw_.x, xw_.y); } const v2u mw = __builtin_nontemporal_load((const GAS v2u*)(mixb + off)); const f32x4 gv = *(const GAS f32x4*)(mrow + 4096 + 4 * lq + 256 * j);
                        vv[rr][j] = xv * ALPHA + gv * (f32x4){bflo(mw.x), bfhi(mw.x), bflo(mw.y), bfhi(mw.y)}; }
#pragma unroll
                for (int rq = 0; rq < 2; ++rq) { const int rr = 2 * rp + rq, m = m0 + rr, rloc = 4 * F.wave + rr;
                    f32x4 (&v)[8] = vv[rq]; float s = 0.f;
#pragma unroll
                    for (int j = 0; j < 8; ++j) s += (v[j].x + v[j].y) + (v[j].z + v[j].w);
                    const float mean = wave_sum(s) * (1.f / D); float s2 = 0.f;
#pragma unroll
                    for (int j = 0; j < 8; ++j) { v[j] = v[j] - mean; s2 += (v[j].x * v[j].x + v[j].y * v[j].y) + (v[j].z * v[j].z + v[j].w * v[j].w); }
                    const float rstd = 1.f / sqrtf(wave_sum(s2) * (1.f / D) + LN_EPS);
#pragma unroll
                    for (int j = 0; j < 8; ++j) { const int k = 4 * lq + 256 * j;
                        const f32x4 xv = v[j] * rstd * *(const GAS f32x4*)(g1 + k) + *(const GAS f32x4*)(b1 + k);
                        { v2u xo; xo.x = pk2(xv.x, xv.y); xo.y = pk2(xv.z, xv.w); *(GAS v2u*)(x1 + (size_t)m * D + k) = xo; }
                        const f32x4 hv = xv * (*(const GAS f32x4*)(mrow + 8192 + k) + 1.0f) + *(const GAS f32x4*)(mrow + 6144 + k);
                        v2u o; o.x = pk2(hv.x, hv.y); o.y = pk2(hv.z, hv.w);
                        *(GAS unsigned*)(h2q + (size_t)m * D + k) = pk4_fp8(hv.x, hv.y, hv.z, hv.w);
                        const int chunk = (lq >> 1) + 32 * j;
                        *(LAS v2u*)(h2s + rloc * 4096 + ((chunk ^ (rloc & 15)) << 4) + (lq & 1) * 8) = o; }
                }
                }
                bf16x8 bqa[4][4], bqb[4][4];
                const unsigned lo_ = lq * 16;
                const unsigned char* wbase = wrf + (size_t)(16 * F.wave) * 4096 + lo_;
#define P5_LDB(dst, q0) do { _Pragma("unroll") for (int q_ = 0; q_ < 4; ++q_) _Pragma("unroll") for (int c_ = 0; c_ < 4; ++c_) dst[q_][c_] = *(const GAS bf16x8*)(wbase + (size_t)((q0) + q_) * 4096 + c_ * 1024); } while (0)
#define P5_MMA(src, q0) do { _Pragma("unroll") for (int q_ = 0; q_ < 4; ++q_) { const int ks = 16 * F.wave + (q0) + q_; \
                    const bf16x8 af = *(const LAS bf16x8*)(h2s + r32 * 4096 + (((2 * ks + hi5) ^ (r32 & 15)) << 4)); \
                    acc0 = __builtin_amdgcn_mfma_f32_32x32x16_bf16(af, src[q_][0], acc0, 0, 0, 0); acc0 = __builtin_amdgcn_mfma_f32_32x32x16_bf16(af, src[q_][1], acc0, 0, 0, 0); \
                    acc1 = __builtin_amdgcn_mfma_f32_32x32x16_bf16(af, src[q_][2], acc1, 0, 0, 0); acc1 = __builtin_amdgcn_mfma_f32_32x32x16_bf16(af, src[q_][3], acc1, 0, 0, 0); } } while (0)
                asm volatile("" ::: "memory");
                P5_LDB(bqa, 0); P5_LDB(bqb, 4);
                __syncthreads();
                att::f32x16 acc0 = att::f32x16{}, acc1 = att::f32x16{};
                P5_MMA(bqa, 0); asm volatile("" ::: "memory"); P5_LDB(bqa, 8);
                P5_MMA(bqb, 4); asm volatile("" ::: "memory"); P5_LDB(bqb, 12);
                P5_MMA(bqa, 8); P5_MMA(bqb, 12);
#undef P5_LDB
#undef P5_MMA
                __syncthreads();
#pragma unroll
                for (int r = 0; r < 16; ++r) { const int row = att::crow(r, hi5); part[(F.wave * 32 + row) * 64 + r32] = acc0[r]; part[(F.wave * 32 + row) * 64 + 32 + r32] = acc1[r]; }
                __syncthreads();
                float score[4]; unsigned key[4]; int ek[4][6]; float sk[4][6];
#pragma unroll
                for (int rr = 0; rr < 4; ++rr) { const int rloc = 4 * F.wave + rr; float lg = 0.f;
#pragma unroll
                    for (int w = 0; w < 8; ++w) lg += part[(w * 32 + rloc) * 64 + F.lane];
                    score[rr] = 1.0f / (1.0f + __expf(-lg)); const float sel = score[rr] + rb;
                    unsigned ob = __float_as_uint(sel); ob = (ob & 0x80000000u) ? ~ob : (ob | 0x80000000u);
                    key[rr] = (ob & ~63u) | (unsigned)(63 - F.lane); }
#pragma unroll
                for (int k = 0; k < 6; ++k) {
                    unsigned mx[4];
#pragma unroll
                    for (int rr = 0; rr < 4; ++rr) mx[rr] = key[rr];
#pragma unroll
                    for (int o = 1; o < 64; o <<= 1) {
#pragma unroll
                        for (int rr = 0; rr < 4; ++rr) { const unsigned t = __shfl_xor(mx[rr], o); mx[rr] = t > mx[rr] ? t : mx[rr]; } }
#pragma unroll
                    for (int rr = 0; rr < 4; ++rr) { const int win = 63 - (int)(__builtin_amdgcn_readfirstlane((int)mx[rr]) & 63);
                        ek[rr][k] = win; sk[rr][k] = __uint_as_float((unsigned)__builtin_amdgcn_readlane((int)__float_as_uint(score[rr]), win)); if (F.lane == win) key[rr] = 0u; }
                }
#pragma unroll
                for (int rr = 0; rr < 4; ++rr) { const int m = m0 + rr;
                    const float ssum = ((sk[rr][0] + sk[rr][1]) + (sk[rr][2] + sk[rr][3])) + (sk[rr][4] + sk[rr][5]);
                    if (F.lane < 6 && rep == 0) { int e = ek[rr][0]; float sc = sk[rr][0];
#pragma unroll
                        for (int k = 1; k < 6; ++k) if (F.lane == k) { e = ek[rr][k]; sc = sk[rr][k]; }
                        const unsigned pos = __hip_atomic_fetch_add(F.ctl + CW_CURSOR + (l * 64 + e) * 16, 1u, RLX_AGENT);
                        if (pos < (unsigned)LISTCAP) { list[(size_t)e * LISTCAP + pos] = m; list2[(size_t)e * LISTCAP + pos] = m * 7 + F.lane; }
                        tinfo[(size_t)m * 6 + F.lane] = e | (int)(pos << 8); gates[(size_t)m * 6 + F.lane] = sc / ssum * ROUTED_SCALE; }
                }
                __syncthreads();
            }
            __syncthreads();
            if (BOTH(pb + 3)) GRID_BAR();
        }
        if (IN(pb + 4)) for (int rep = 0; rep < NREP(6); ++rep) {
            refresh(F);
            build_tables(F, l);
            const LAS int* tb = (const LAS int*)(F.lds + TB_OFF);
            MoeOrder<true, 4> S{F.G, (int)blockIdx.x, tb[65] * 4, (const LAS int*)(F.lds + TILEE_OFF), tb, (const LAS int*)(F.lds + CNT_OFF), (const int*)(ws + WS_LIST), (unsigned)D};
            const bf16* WL = (const bf16*)(ws + WS_W + (size_t)l * W_LAYER);
            pg8::Gemm g{(const void*)(ws + WS_H2), (const void*)(WL + W_1_OFF / 2), D, 127 - WSHIFT, 127};
            EpiSwiglu E{(unsigned char*)(ws + WS_ACT)};
            pg8::gemm_phase<EpiSwiglu, MoeOrder<true, 4>, true, true>(F.lds + RING_OFF, g, S, E, F.wave, F.lane);
            if (BOTH(pb + 4)) GRID_BAR();
        }
        if (IN(pb + 5)) for (int rep = 0; rep < NREP(7); ++rep) {
            refresh(F);
            build_tables(F, l);
            const LAS int* tb = (const LAS int*)(F.lds + TB_OFF);
            MoeOrder<false, 8> S{F.G, (int)blockIdx.x, tb[65] * 8, (const LAS int*)(F.lds + TILEE_OFF), tb, (const LAS int*)(F.lds + CNT_OFF), (const int*)(ws + WS_LIST), (unsigned)EH};
            const bf16* WL = (const bf16*)(ws + WS_W + (size_t)l * W_LAYER);
            pg8::Gemm g{(const void*)(ws + WS_ACT), (const void*)(WL + W_2_OFF / 2), EH, 127 - WSHIFT, 127 - ASHIFT};
            EpiDown E{(unsigned char*)(ws + WS_YBUF), (const LAS int*)(F.lds + TILEE_OFF), tb, (const LAS int*)(F.lds + CNT_OFF), (const int*)(ws + WS_LIST2)};
            pg8::gemm_phase<EpiDown, MoeOrder<false, 8>, true, true>(F.lds + RING_OFF, g, S, E, F.wave, F.lane);
            if (BOTH(pb + 5)) GRID_BAR();
        }
        if (IN(pb + 6)) for (int rep = 0; rep < NREP(8); ++rep) {
            refresh(F);
            build_tables(F, l);
            const LAS int* tb = (const LAS int*)(F.lds + TB_OFF);
            const unsigned char* yb = ws + WS_YBUF; const bf16* x1 = (const bf16*)(ws + WS_X1); bf16* x2b = (bf16*)(ws + WS_X2B);
            const int* tinfo = (const int*)(ws + WS_TINFO); const float* gates = (const float*)(ws + WS_GATE);
            const float* g2 = inptr<const float>(F, I_LN2G) + (size_t)l * D; const float* b2 = inptr<const float>(F, I_LN2B) + (size_t)l * D; float* Fout = inptr<float>(F, I_OUT);
            const int shared_row0 = tb[64] * 256;
            for (int m_ = gw; m_ < T; m_ += NGW) {
                const int m = (F.G == 256) ? (2048 * ((m_ >> 3) & 7) + 8 * ((m_ & 2047) >> 6) + (m_ & 7) + 256 * (m_ >> 11)) : m_;
                const float* mrow = (const float*)(ws + WS_MOD) + ((size_t)l * 8 + (m >> 11)) * 12288;
                size_t rows[7]; float gt[7];
                float gtv = 0.f; if (F.lane < 6) gtv = gates[(size_t)m * 6 + F.lane];
#pragma unroll
                for (int k = 0; k < 6; ++k) { rows[k] = (size_t)m * 7 + k; gt[k] = __uint_as_float((unsigned)__builtin_amdgcn_readlane((int)__float_as_uint(gtv), k)); }
                rows[6] = (size_t)m * 7 + 6; gt[6] = 1.0f;
                f32x4 v[8]; float s = 0.f;
#pragma unroll
                for (int jh = 0; jh < 2; ++jh) { const v4u xa = __builtin_nontemporal_load((const GAS v4u*)(x1 + (size_t)m * D + 16 * F.lane + 1024 * jh)), xb = __builtin_nontemporal_load((const GAS v4u*)(x1 + (size_t)m * D + 16 * F.lane + 1024 * jh + 8));
                    v[4 * jh] = bf4(xa.x, xa.y); v[4 * jh + 1] = bf4(xa.z, xa.w); v[4 * jh + 2] = bf4(xb.x, xb.y); v[4 * jh + 3] = bf4(xb.z, xb.w); }
#pragma unroll
                for (int jh = 0; jh < 2; ++jh) {
                    v4u yw[7];
#pragma unroll
                    for (int q = 0; q < 7; ++q) yw[q] = __builtin_nontemporal_load((const GAS v4u*)(yb + rows[q] * D + 16 * F.lane + 1024 * jh));
#pragma unroll
                    for (int i = 0; i < 4; ++i) { const int j = 4 * jh + i, k = 16 * F.lane + 1024 * jh + 4 * i; f32x4 f = (f32x4){0.f, 0.f, 0.f, 0.f};
#pragma unroll
                        for (int q = 0; q < 7; ++q) { const unsigned w = yw[q][i]; const float gq = gt[q];
                            const auto lo2 = __builtin_amdgcn_cvt_pk_f32_fp8((int)w, false), hi2 = __builtin_amdgcn_cvt_pk_f32_fp8((int)w, true);
                            f.x += gq * lo2[0]; f.y += gq * lo2[1]; f.z += gq * hi2[0]; f.w += gq * hi2[1]; }
                        v[j] = v[j] * ALPHA + *(const GAS f32x4*)(mrow + 10240 + k) * (f * (1.0f / (float)(1 << YSHIFT)));
                        s += (v[j].x + v[j].y) + (v[j].z + v[j].w); }
                    asm volatile("" ::: "memory");
                }
                const float mean = wave_sum(s) * (1.f / D); float s2 = 0.f;
#pragma unroll
                for (int j = 0; j < 8; ++j) { v[j] = v[j] - mean; s2 += (v[j].x * v[j].x + v[j].y * v[j].y) + (v[j].z * v[j].z + v[j].w * v[j].w); }
                const float rstd = 1.f / sqrtf(wave_sum(s2) * (1.f / D) + LN_EPS);
                float* orow = Fout + (size_t)m * D;
#pragma unroll
                for (int j = 0; j < 8; ++j) { const int k = 16 * F.lane + 1024 * (j >> 2) + 4 * (j & 3);
                    v[j] = v[j] * rstd * *(const GAS f32x4*)(g2 + k) + *(const GAS f32x4*)(b2 + k);
                    if (l == 1) { *(GAS f32x4*)(orow + k) = v[j]; if (j & 1) asm volatile("" ::: "memory"); } }
                if (l == 0) {
#pragma unroll
                    for (int jh = 0; jh < 2; ++jh) { v4u wa, wb; wa.x = pk2(v[4 * jh].x, v[4 * jh].y); wa.y = pk2(v[4 * jh].z, v[4 * jh].w); wa.z = pk2(v[4 * jh + 1].x, v[4 * jh + 1].y); wa.w = pk2(v[4 * jh + 1].z, v[4 * jh + 1].w);
                        wb.x = pk2(v[4 * jh + 2].x, v[4 * jh + 2].y); wb.y = pk2(v[4 * jh + 2].z, v[4 * jh + 2].w); wb.z = pk2(v[4 * jh + 3].x, v[4 * jh + 3].y); wb.w = pk2(v[4 * jh + 3].z, v[4 * jh + 3].w);
                        *(GAS v4u*)(x2b + (size_t)m * D + 16 * F.lane + 1024 * jh) = wa; *(GAS v4u*)(x2b + (size_t)m * D + 16 * F.lane + 1024 * jh + 8) = wb; } }
            }
            __syncthreads();
            if ((l == 0 || rep + 1 < NREP(8)) && BOTH(pb + 6)) GRID_BAR();
        }

}
struct Args { const void* in[21]; float* out; unsigned char* ws; int ph_lo, ph_hi; };
__global__ void __launch_bounds__(NWAVES * 64, 2) fwd_kernel(Args args) {
    extern __shared__ __attribute__((aligned(16))) unsigned char lds[];
    Frame F;
    F.lds = (LAS unsigned char*)lds;
    F.wave = __builtin_amdgcn_readfirstlane((int)(threadIdx.x >> 6)); refresh(F); F.G = gridDim.x;
    unsigned char* ws = args.ws; F.ws = ws; F.ctl = (gu32*)(ws + WS_CTL);
    for (int u = F.tid; u < (LDS_BYTES - LDSCTL_OFF) / 4; u += NWAVES * 64) ((LAS unsigned*)(F.lds + LDSCTL_OFF))[u] = 0u;
    __syncthreads();
    if (F.tid < 21) *(LAS unsigned long long*)(F.lds + PTR_OFF + 8 * F.tid) = (unsigned long long)args.in[F.tid];
    if (F.tid == 21) *(LAS unsigned long long*)(F.lds + PTR_OFF + 8 * 21) = (unsigned long long)args.out;
    __syncthreads();
    volatile LAS unsigned* MISC = (volatile LAS unsigned*)(F.lds + MISC_OFF);
    XcdBarrier bar; bar.bar = (unsigned*)(F.ctl + CW_BAR); bar.x = 0; bar.st = nullptr;
#if MK_ONE_LAUNCH
    bar = xcd_barrier_post((unsigned*)(F.ctl + CW_BAR), MISC + 8, F.tid == 0);
#endif
    const int lo = args.ph_lo, hi = args.ph_hi;
    const int gw = blockIdx.x * NWAVES + F.wave, NGW = F.G * NWAVES;

    if (IN(0)) for (int rep = 0; rep < NREP(0); ++rep) { refresh(F); p0_prologue(F); if (BOTH(0)) GRID_BAR(); }
    layer_phases<0>(F, bar, lo, hi);
    layer_phases<1>(F, bar, lo, hi);
#undef IN
#undef BOTH
}

extern "C" void kernel_launch(void* const* d_in, const int* in_sizes, int n_in, void* d_out, int out_size, void* d_ws, size_t ws_size, hipStream_t stream) {
    static int grid = 0;
    if (grid == 0) {
        if (n_in != 21 || out_size != T * D || ws_size < WS_END) { fprintf(stderr, "kernel_launch: unexpected sizes (n_in %d, out %d, ws %zu < %zu)\n", n_in, out_size, ws_size, (size_t)WS_END); grid = -1; return; }
        int dev = 0, cus = 0, per_cu = 0;
        if (hipGetDevice(&dev) != hipSuccess || hipDeviceGetAttribute(&cus, hipDeviceAttributeMultiprocessorCount, dev) != hipSuccess) { grid = -1; return; }
        if (hipFuncSetAttribute((const void*)fwd_kernel, hipFuncAttributeMaxDynamicSharedMemorySize, LDS_BYTES) != hipSuccess) { fprintf(stderr, "kernel_launch: hipFuncSetAttribute failed\n"); grid = -1; return; }
        if (hipOccupancyMaxActiveBlocksPerMultiprocessor(&per_cu, (const void*)fwd_kernel, NWAVES * 64, LDS_BYTES) != hipSuccess || per_cu < 1) { fprintf(stderr, "kernel_launch: occupancy query says %d\n", per_cu); }
        (void)hipGetLastError();
        grid = cus;
    }
    if (grid < 0) return;
    (void)in_sizes;
    hipMemsetAsync((char*)d_ws + WS_CTL, 0, CTL_ZERO_BYTES, stream);
    Args a{};
    for (int i = 0; i < 21; ++i) a.in[i] = d_in[i];
    a.out = (float*)d_out; a.ws = (unsigned char*)d_ws;
#if MK_ONE_LAUNCH
    a.ph_lo = 0; a.ph_hi = 17;
    hipLaunchKernelGGL(fwd_kernel, dim3(grid), dim3(NWAVES * 64), LDS_BYTES, stream, a);
#else
    for (int p = 0; p < 17; ++p) { a.ph_lo = p; a.ph_hi = p + 1; hipLaunchKernelGGL(fwd_kernel, dim3(grid), dim3(NWAVES * 64), LDS_BYTES, stream, a); }
#endif
}
```

```cpp
#include <hip/hip_runtime.h>
#include <hip/hip_bf16.h>
#include <cstdio>
#include <cstdint>

#ifndef MK_ONE_LAUNCH
#define MK_ONE_LAUNCH 1
#endif

namespace pg8 {
#define PG8_LAS __attribute__((address_space(3)))
typedef unsigned short bf16_t;
typedef short bf16x8 __attribute__((ext_vector_type(8)));
typedef float f32x4 __attribute__((ext_vector_type(4)));
typedef unsigned u32x4 __attribute__((ext_vector_type(4)));
constexpr int BM = 256, BK = 64, HALF = 128, HTB = HALF * BK * 2, STAGE_BYTES = 8 * HTB, NXCD = 8, WGM = 8;
constexpr int GOFF_REL = 137216;

__host__ __device__ __forceinline__ int lds_byte(int r, int c) { const int st = (r >> 4) * 2 + (c >> 5), rr = r & 15, cc = c & 31, ob = rr * 64 + cc * 2; return st * 1024 + (ob ^ (((ob >> 9) & 1) << 5)); }
__host__ __device__ __forceinline__ void stage_rc(int b, int& R, int& C) { const int st = b / 1024, sb = b % 1024, swz = sb ^ (((sb >> 9) & 1) << 5); R = (st >> 1) * 16 + swz / 64; C = (st & 1) * 32 + (swz % 64) / 2; }
__host__ __device__ __forceinline__ int perm32(int rho) { const int n = rho >> 4, i = rho & 15; return 8 * (i >> 2) + 4 * n + (i & 3); }

struct Unit { int pm, pn; };
struct Gemm { const void* A; const void* Bt; int KB; int sa, sb; };

struct StaticOrder {
    static constexpr bool GATHER = false;
    int nM, nN, nwg, G, c;
    __device__ void init(int M, int N, int G_, int c_) { nM = M / BM; nN = N / BM; nwg = nM * nN; G = G_; c = c_; }
    __device__ bool next(int i, Unit& u) const {
        const long L = (long)i * G + c; if (L >= nwg) return false;
        int wgid = (int)L; { const int q = nwg / NXCD, r = nwg % NXCD, xcd = wgid % NXCD, off = wgid / NXCD; wgid = (xcd < r ? xcd * (q + 1) : r * (q + 1) + (xcd - r) * q) + off; }
        const int nig = WGM * nN, gid = wgid / nig, fm = gid * WGM, gsz = (nM - fm) < WGM ? (nM - fm) : WGM;
        u.pm = fm + ((wgid % nig) % gsz); u.pn = (wgid % nig) / gsz; return true;
    }
    __device__ __forceinline__ unsigned tok_off(const Unit&, int) const { return 0u; }
};

typedef int v8i_t __attribute__((ext_vector_type(8))); typedef int v4i_t __attribute__((ext_vector_type(4)));
__device__ __forceinline__ v8i_t cat8(bf16x8 a, bf16x8 b) { const v4i_t x = __builtin_bit_cast(v4i_t, a), y = __builtin_bit_cast(v4i_t, b); return __builtin_shufflevector(x, y, 0, 1, 2, 3, 4, 5, 6, 7); }
__device__ __forceinline__ unsigned cvt_pk_bf16(float lo, float hi) { unsigned r; asm volatile("v_cvt_pk_bf16_f32 %0, %1, %2" : "=v"(r) : "v"(lo), "v"(hi)); return r; }

template <class Epi, class Sched, bool ALIGN_EPI, bool FP8 = false>
__device__ __forceinline__ void gemm_phase(PG8_LAS unsigned char* lds, const Gemm g, const Sched& S, const Epi& E, const int wid, const int lane) {
    constexpr bool GA = Sched::GATHER;
    const int tid = wid * 64 + lane, wr = wid >> 2, wc = wid & 3, fr = lane & 15, fq = lane >> 4;
    int KB = g.KB; asm volatile("" : "+s"(KB)); const int nt = KB / 128;
    unsigned voffA[2], voffB[2]; int rA[2]; unsigned cA2[2];
#pragma unroll
    for (int i = 0; i < 2; ++i) { int R, C; stage_rc(tid * 16 + i * 8192, R, C); const int Rb = Epi::PERM ? ((R & ~31) + perm32(R & 31)) : R;
        rA[i] = R; cA2[i] = (unsigned)C * 2u; voffA[i] = (unsigned)(R * KB + C * 2); voffB[i] = (unsigned)(Rb * KB + C * 2); }
    const size_t kstep = (size_t)(BK * 2);
    const size_t hstep = (size_t)HALF * KB;
    const size_t hstepA = GA ? (size_t)0 : hstep;
    const size_t tstep = 2 * hstep;
    const unsigned ldsw = (unsigned)wid * 1024u;
    const int aoff = lds_byte(wr * 64 + fr, fq * 8), boff = lds_byte(wc * 32 + fr, fq * 8);
#define PG8_SA(b, h) (((b) * 2 + (h)) * HTB)
#define PG8_SB(b, h) ((4 + (b) * 2 + (h)) * HTB)
    const unsigned ldsb = (unsigned)__builtin_amdgcn_readfirstlane((int)((unsigned)(__UINTPTR_TYPE__)lds + ldsw));
#define PG8_STAGE(bufoff, gbase, voff) do { _Pragma("unroll") for (int _i = 0; _i < 2; ++_i) { unsigned keep_; \
        asm volatile("s_mov_b32 %0, m0\n\ts_mov_b32 m0, %3\n\ts_nop 0\n\tglobal_load_lds_dwordx4 %1, %2\n\ts_mov_b32 m0, %0" : "=&s"(keep_) : "v"((voff)[_i]), "s"((const char*)(gbase)), "s"(ldsb + (unsigned)((bufoff) + _i * 8192)) : "memory"); } } while (0)
#define PG8_LDA(dst, b, h) do { _Pragma("unroll") for (int m = 0; m < 4; ++m) _Pragma("unroll") for (int k = 0; k < 2; ++k) dst[m][k] = *(const PG8_LAS bf16x8*)(lds + PG8_SA(b, h) + aoff + m * 2048 + k * 1024); } while (0)
#define PG8_LDB(dst, b, h) do { _Pragma("unroll") for (int n = 0; n < 2; ++n) _Pragma("unroll") for (int k = 0; k < 2; ++k) dst[n][k] = *(const PG8_LAS bf16x8*)(lds + PG8_SB(b, h) + boff + n * 2048 + k * 1024); } while (0)
#define PG8_MMA(ai, bj, At, Bt) do { __builtin_amdgcn_s_setprio(1); _Pragma("unroll") for (int m = 0; m < 4; ++m) _Pragma("unroll") for (int n = 0; n < 2; ++n) { \
        if constexpr (FP8) { asm volatile("v_mfma_scale_f32_16x16x128_f8f6f4 %0, %1, %2, %0, %3, %4 op_sel_hi:[0,0,0]" : "+v"(acc[ai][bj][m][n]) : "v"(cat8(Bt[n][0], Bt[n][1])), "v"(cat8(At[m][0], At[m][1])), "v"(sa_v), "v"(sb_v)); } \
        else { _Pragma("unroll") for (int k = 0; k < 2; ++k) acc[ai][bj][m][n] = __builtin_amdgcn_mfma_f32_16x16x32_bf16(Bt[n][k], At[m][k], acc[ai][bj][m][n], 0, 0, 0); } } \
        __builtin_amdgcn_s_setprio(0); } while (0)
#define PG8_WAIT_V(n) asm volatile("s_waitcnt vmcnt(" #n ")" ::: "memory")
#define PG8_WAIT_L(n) asm volatile("s_waitcnt lgkmcnt(" #n ")" ::: "memory")
#define PG8_BAR __builtin_amdgcn_s_barrier()
#define PG8_SCHED __builtin_amdgcn_sched_barrier(0)
    const int sa_v = g.sa, sb_v = g.sb;
    Unit cur, nxt; int ui = 0;
    if (!S.next(0, cur)) return;
    f32x4 acc[2][2][4][2];
#pragma unroll
    for (int a = 0; a < 2; ++a)
#pragma unroll
        for (int b = 0; b < 2; ++b)
#pragma unroll
            for (int m = 0; m < 4; ++m)
#pragma unroll
                for (int n = 0; n < 2; ++n) acc[a][b][m][n] = (f32x4){0.f, 0.f, 0.f, 0.f};
    bf16x8 At[4][2], B0[2][2], B1[2][2];
    unsigned vc0[2], vc1[2];
    PG8_LAS u32x4* gslot = (PG8_LAS u32x4*)(lds + GOFF_REL) + tid;
#pragma unroll
    for (int i = 0; i < 2; ++i) {
        if (GA) { vc0[i] = S.tok_off(cur, rA[i]) + cA2[i]; vc1[i] = S.tok_off(cur, HALF + rA[i]) + cA2[i]; }
        else { vc0[i] = voffA[i]; vc1[i] = voffA[i]; } }
    if (GA) asm volatile("" : "+v"(vc0[0]), "+v"(vc0[1]), "+v"(vc1[0]), "+v"(vc1[1]));
    const char* cA = GA ? (const char*)g.A : (const char*)g.A + (size_t)cur.pm * tstep; const char* cB = (const char*)g.Bt + (size_t)cur.pn * tstep;
    PG8_STAGE(PG8_SB(0, 0), cB, voffB); PG8_STAGE(PG8_SB(0, 1), cB + hstep, voffB); PG8_STAGE(PG8_SA(0, 0), cA, vc0); PG8_STAGE(PG8_SA(0, 1), cA + hstepA, vc1);
    if (wr == 1) PG8_BAR;
    PG8_WAIT_V(2); PG8_BAR;
    PG8_STAGE(PG8_SB(1, 0), cB + kstep, voffB); PG8_STAGE(PG8_SA(1, 0), cA + kstep, vc0); PG8_STAGE(PG8_SB(1, 1), cB + hstep + kstep, voffB);
    PG8_WAIT_V(6); PG8_BAR;
    for (;;) {
        const bool has_next = S.next(ui + 1, nxt);
        const char* nA = GA ? (const char*)g.A : (has_next ? (const char*)g.A + (size_t)nxt.pm * tstep : cA); const char* nB = has_next ? (const char*)g.Bt + (size_t)nxt.pn * tstep : cB;
        if (GA && has_next) {
            u32x4 q; q.x = S.tok_off(nxt, rA[0]) + cA2[0]; q.y = S.tok_off(nxt, rA[1]) + cA2[1]; q.z = S.tok_off(nxt, HALF + rA[0]) + cA2[0]; q.w = S.tok_off(nxt, HALF + rA[1]) + cA2[1];
            *gslot = q;
        }
#pragma clang loop unroll(disable)
        for (int t = 0; t < nt; t += 2) {
            const bool last = (t == nt - 2);
            const char* a1 = cA + (size_t)(t + 1) * kstep;
            const char* a2 = last ? nA : cA + (size_t)(t + 2) * kstep; const char* b2 = last ? nB : cB + (size_t)(t + 2) * kstep;
            const char* a3 = a2 + kstep; const char* b3 = b2 + kstep;
            PG8_LDB(B0, 0, 0); PG8_LDB(B1, 0, 1); PG8_SCHED; PG8_LDA(At, 0, 0); PG8_STAGE(PG8_SA(1, 1), a1 + hstepA, vc1);
            if (GA && last && has_next) { const u32x4 q = *gslot; vc0[0] = q.x; vc0[1] = q.y; vc1[0] = q.z; vc1[1] = q.w; }
            PG8_WAIT_V(8); PG8_WAIT_L(0); PG8_BAR; PG8_MMA(0, 0, At, B0); PG8_MMA(0, 1, At, B1); PG8_BAR; PG8_SCHED;
            PG8_LDA(At, 0, 1); PG8_STAGE(PG8_SB(0, 0), b2, voffB); PG8_STAGE(PG8_SB(0, 1), b2 + hstep, voffB); PG8_STAGE(PG8_SA(0, 0), a2, vc0);
            PG8_WAIT_V(8); PG8_WAIT_L(0); PG8_BAR; PG8_MMA(1, 0, At, B0); PG8_MMA(1, 1, At, B1); PG8_BAR; PG8_SCHED;
            PG8_LDB(B0, 1, 0); PG8_LDB(B1, 1, 1); PG8_SCHED; PG8_LDA(At, 1, 0); PG8_STAGE(PG8_SA(0, 1), a2 + hstepA, vc1);
            PG8_WAIT_V(8); PG8_WAIT_L(0); PG8_BAR; PG8_MMA(0, 0, At, B0); PG8_MMA(0, 1, At, B1); PG8_BAR; PG8_SCHED;
            PG8_LDA(At, 1, 1); PG8_STAGE(PG8_SB(1, 0), b3, voffB); PG8_STAGE(PG8_SB(1, 1), b3 + hstep, voffB); PG8_STAGE(PG8_SA(1, 0), a3, vc0);
            PG8_WAIT_V(8); PG8_WAIT_L(0); PG8_BAR; PG8_MMA(1, 0, At, B0); PG8_MMA(1, 1, At, B1); PG8_BAR; PG8_SCHED;
        }
        if constexpr (ALIGN_EPI) { if (wr == 0) PG8_BAR; }
        if constexpr (FP8) {
#pragma unroll
            for (int a = 0; a < 2; ++a)
#pragma unroll
                for (int b = 0; b < 2; ++b) asm volatile("s_nop 15\n\ts_nop 15" : "+v"(acc[a][b][0][0]), "+v"(acc[a][b][0][1]), "+v"(acc[a][b][1][0]), "+v"(acc[a][b][1][1]), "+v"(acc[a][b][2][0]), "+v"(acc[a][b][2][1]), "+v"(acc[a][b][3][0]), "+v"(acc[a][b][3][1]));
        }
        E(acc, cur, wr, wc, fr, fq);
        if (!has_next) break;
#pragma unroll
        for (int a = 0; a < 2; ++a)
#pragma unroll
            for (int b = 0; b < 2; ++b)
#pragma unroll
                for (int m = 0; m < 4; ++m)
#pragma unroll
                    for (int n = 0; n < 2; ++n) acc[a][b][m][n] = (f32x4){0.f, 0.f, 0.f, 0.f};
        cur = nxt; cA = nA; cB = nB; ++ui;
        if constexpr (ALIGN_EPI) { if (wr == 1) PG8_BAR; }
    }
    PG8_WAIT_V(0);
    if constexpr (!ALIGN_EPI) { if (wr == 0) PG8_BAR; }
    PG8_BAR;
#undef PG8_SA
#undef PG8_SB
#undef PG8_STAGE
#undef PG8_LDA
#undef PG8_LDB
#undef PG8_MMA
#undef PG8_WAIT_V
#undef PG8_WAIT_L
#undef PG8_BAR
#undef PG8_SCHED
}
}

constexpr int NWAVES = 8;
constexpr int T = 16384, D = 2048, NB = 8, SEQ = 2048, NPROJ = 6144, INW = 6156, NFOX = 12;
constexpr int NE = 64, TOPK = 6, EH = 512, LISTCAP = 16384;
constexpr int QCOL_SB = 0, KCOL_SB = 512, VCOL_SB = 1024, QCOL_FX = 1536, KCOL_FX = 2304, VCOL_FX = 3072, QCOL_DL = 3840, KCOL_DL = 4608, VCOL_DL = 5376;
constexpr float LN_EPS = 1e-5f, RMS_EPS = 1e-6f, ALPHA = 1.4142135623730951f, ROUTED_SCALE = 2.5f;
constexpr float LOG2E = 1.4426950408889634f;
constexpr int WSHIFT = 6, ASHIFT = 4, YSHIFT = 4;
constexpr float C2 = 0.125f * 1.4426950408889634f;

constexpr size_t MiB = 1u << 20;
constexpr size_t WS_CTL = 0, CTL_ZERO_BYTES = 1 * MiB;
constexpr size_t WS_MOD = 1 * MiB;
constexpr size_t WS_TAB = 2 * MiB;
constexpr size_t WS_FLOG = 6 * MiB;
constexpr size_t WS_CUM = 7 * MiB;
constexpr size_t WS_TINFO = 8 * MiB;
constexpr size_t WS_GATE = 9 * MiB;
constexpr size_t WS_LIST = 10 * MiB;
constexpr size_t WS_WR = 14 * MiB;
constexpr size_t WS_W = 16 * MiB;
constexpr size_t W_IN_OFF = 0, W_OUT_OFF = 24 * MiB, W_1_OFF = 32 * MiB, W_2_OFF = 292 * MiB, W_LAYER = 422 * MiB;
constexpr size_t WS_H = 860 * MiB;
constexpr size_t WS_X1 = 924 * MiB;
constexpr size_t WS_X2B = 988 * MiB;
constexpr size_t WS_H2 = 1052 * MiB;
constexpr size_t WS_R1 = 1116 * MiB;
constexpr size_t WS_PROJ = WS_R1, WS_OBUF = WS_R1 + 192 * MiB, WS_Y1 = WS_R1 + 256 * MiB;
constexpr size_t WS_ACT = WS_R1, WS_YBUF = WS_R1 + 128 * MiB;
constexpr size_t WS_DST_O = WS_R1 + 640 * MiB;
constexpr size_t WS_DST_M = WS_DST_O + 24 * MiB;
constexpr size_t WS_LIST2 = WS_DST_M + 2 * MiB;
constexpr size_t WS_WF = WS_LIST2 + 4 * MiB;
constexpr size_t WS_END = WS_WF + 1 * MiB;
constexpr int MAXTILES = 512;

constexpr int CW_TMO = 0, CW_CODE = 1;
constexpr int CW_BAR = 4096;
constexpr int CW_CURSOR = 8192;
constexpr int CW_AQ = 12288;
constexpr int CW_DA = 20480;

constexpr int RING_OFF = 0, RING_BYTES = 131072;
constexpr int WSF_OFF = 131072;
constexpr int TILEE_OFF = WSF_OFF + 2048;
constexpr int TB_OFF = TILEE_OFF + 2048;
constexpr int CNT_OFF = TB_OFF + 512;
constexpr int PTR_OFF = CNT_OFF + 512;
constexpr int MISC_OFF = PTR_OFF + 256;
constexpr int GOFF_OFF = 137216;
static_assert(GOFF_OFF >= MISC_OFF + 128 && GOFF_OFF + 8192 <= 147456 && GOFF_OFF == RING_OFF + pg8::GOFF_REL, "gather slots");
constexpr int LDSCTL_OFF = WSF_OFF;
constexpr int LDS_BYTES = 147456;
static_assert(MISC_OFF + 128 <= LDS_BYTES, "LDS map");
typedef unsigned v2u_early __attribute__((ext_vector_type(2)));

#define GAS __attribute__((address_space(1)))
#define LAS __attribute__((address_space(3)))
typedef unsigned short bf16;
typedef unsigned v4u __attribute__((ext_vector_type(4)));
typedef unsigned v2u __attribute__((ext_vector_type(2)));
typedef float f32x4 __attribute__((ext_vector_type(4)));
typedef short bf16x8 __attribute__((ext_vector_type(8)));
typedef GAS unsigned gu32;
#define RLX_AGENT __ATOMIC_RELAXED, __HIP_MEMORY_SCOPE_AGENT
#define LDS_WAIT() asm volatile("s_waitcnt lgkmcnt(0)" ::: "memory")
#define VM_WAIT() asm volatile("s_waitcnt vmcnt(0)" ::: "memory")
__device__ __forceinline__ unsigned f2bf(float f) { unsigned u = __builtin_bit_cast(unsigned, f); return (u + 0x7fffu + ((u >> 16) & 1u)) >> 16; }
__device__ __forceinline__ unsigned pk2(float lo, float hi) { return f2bf(lo) | (f2bf(hi) << 16); }
__device__ __forceinline__ unsigned pk4_fp8(float a, float b, float c, float d) { int r = __builtin_amdgcn_cvt_pk_fp8_f32(a, b, 0, false); r = __builtin_amdgcn_cvt_pk_fp8_f32(c, d, r, true); return (unsigned)r; }
__device__ __forceinline__ f32x4 bf4(unsigned a, unsigned b);
__device__ __forceinline__ float bflo(unsigned w) { return __builtin_bit_cast(float, w << 16); }
__device__ __forceinline__ float bfhi(unsigned w) { return __builtin_bit_cast(float, w & 0xffff0000u); }
__device__ __forceinline__ f32x4 bf4(unsigned a, unsigned b) { return (f32x4){bflo(a), bfhi(a), bflo(b), bfhi(b)}; }

#define XB_TMO      128
#define XB_XCNT(j)  (256  + 64 * (j))
#define XB_XSUB(j)  (1280 + 64 * (j))
#define XB_XGEN(j)  (2304 + 64 * (j))
#define XB_TOP      3328
#define XB_TOPGEN   3392
#define XCD_BAR_WORDS 3456
#define XB_SPIN_CAP (1u << 20)

__device__ __forceinline__ unsigned xb_ld(unsigned* p)              { return __hip_atomic_load(p, __ATOMIC_RELAXED, __HIP_MEMORY_SCOPE_AGENT); }
__device__ __forceinline__ unsigned xb_add(unsigned* p, unsigned v) { return __hip_atomic_fetch_add(p, v, __ATOMIC_RELAXED, __HIP_MEMORY_SCOPE_AGENT); }
__device__ __forceinline__ unsigned xb_xcc_id() { return (unsigned)__builtin_amdgcn_s_getreg((3 << 11) | 20) & 0xFu; }
#define XB_SPIN(cond, bar) do { unsigned _sp = 0; while (cond) { __builtin_amdgcn_s_sleep(1); \
    if ((++_sp & 255u) == 0u) { if (xb_ld(&(bar)[XB_TMO])) break; if (_sp > XB_SPIN_CAP) { atomicAdd(&(bar)[XB_TMO], 1u); break; } } } } while (0)

struct XcdBarrier { unsigned* bar; unsigned x; volatile LAS unsigned* st; };

__device__ __forceinline__ XcdBarrier xcd_barrier_post(unsigned* bar, volatile LAS unsigned* st, bool leader) {
    XcdBarrier b; b.bar = bar; b.x = xb_xcc_id(); b.st = st;
    if (leader) (void)xb_add(&bar[XB_XCNT(b.x)], 1u);
    return b;
}
__device__ __forceinline__ void xcd_barrier_complete(unsigned* bar, unsigned x, unsigned& nloc, unsigned& nx) {
    const unsigned G = gridDim.x * gridDim.y * gridDim.z;
    unsigned sum, cnt, mine, sp = 0u;
    for (;;) {
        sum = 0u; cnt = 0u; mine = 0u;
#pragma unroll
        for (unsigned j = 0; j < 16; ++j) { const unsigned c = xb_ld(&bar[XB_XCNT(j)]); sum += c; cnt += (c > 0u) ? 1u : 0u; mine = (j == x) ? c : mine; }
        if (sum == G) break;
        __builtin_amdgcn_s_sleep(1);
        if ((++sp & 255u) == 0u) { if (xb_ld(&bar[XB_TMO])) break; if (sp > XB_SPIN_CAP) { atomicAdd(&bar[XB_TMO], 1u); break; } }
    }
    nloc = mine > 0u ? mine : 1u; nx = cnt > 0u ? cnt : 1u;
}
__device__ __forceinline__ void xcd_barrier(const XcdBarrier& b, bool leader  ) {
    asm volatile("s_waitcnt vmcnt(0)" ::: "memory");
    __syncthreads();
    if (leader) {
        unsigned* bar = b.bar;
        __builtin_amdgcn_s_waitcnt(0);
        unsigned nloc = b.st[0], nx = b.st[1];
        if (nloc == 0u) { xcd_barrier_complete(bar, b.x, nloc, nx); b.st[0] = nloc; b.st[1] = nx; }
        const unsigned old = xb_add(&bar[XB_XSUB(b.x)], 1u);
        const unsigned gen = old / nloc;
        if (old + 1u == (gen + 1u) * nloc) {
            __builtin_amdgcn_fence(__ATOMIC_RELEASE, "agent");
            asm volatile("s_waitcnt vmcnt(0)" ::: "memory");
            const unsigned og = xb_add(&bar[XB_TOP], 1u);
            const unsigned tg = og / nx;
            if (og + 1u == (tg + 1u) * nx) xb_add(&bar[XB_TOPGEN], 1u);
            else XB_SPIN(xb_ld(&bar[XB_TOPGEN]) == tg, bar);
            __builtin_amdgcn_fence(__ATOMIC_ACQUIRE, "agent");
            xb_add(&bar[XB_XGEN(b.x)], 1u);
            asm volatile("s_waitcnt vmcnt(0)" ::: "memory");
        } else {
            XB_SPIN(xb_ld(&bar[XB_XGEN(b.x)]) == gen, bar);
            __builtin_amdgcn_fence(__ATOMIC_ACQUIRE, "agent");
            asm volatile("s_waitcnt vmcnt(0)" ::: "memory");
        }
    }
    __syncthreads();
}

struct Frame {
    LAS unsigned char* lds;
    gu32* ctl;
    int tid, lane, wave, G;
    unsigned char* ws;
};
enum { I_X = 0, I_C, I_POS, I_WADA, I_BADA, I_WIN, I_BFORGET, I_HNG, I_WOUT, I_LN1G, I_LN1B, I_WROUTER, I_RBIAS, I_WEG, I_WEU, I_WED, I_WSG, I_WSU, I_WSD, I_LN2G, I_LN2B, I_OUT, I_NPTR };
template <class TP> __device__ __forceinline__ TP* inptr(const Frame& F, int i) {
    const v2u v = *(const LAS v2u*)(F.lds + PTR_OFF + 8 * i);
    const unsigned long long p = ((unsigned long long)(unsigned)__builtin_amdgcn_readfirstlane((int)v.y) << 32) | (unsigned)__builtin_amdgcn_readfirstlane((int)v.x);
    return (TP*)p;
}
__device__ __forceinline__ void refresh(Frame& F) { int l = (int)__builtin_amdgcn_mbcnt_hi(~0u, __builtin_amdgcn_mbcnt_lo(~0u, 0u)); asm volatile("" : "+v"(l)); F.lane = l; F.tid = F.wave * 64 + l; }
__device__ __forceinline__ float wave_sum(float v) {
#pragma unroll
    for (int o = 1; o < 64; o <<= 1) v += __shfl_xor(v, o);
    return v;
}

__device__ __forceinline__ void p0_transpose_item(const float* W, size_t ldw, int k0, int n0, bf16* WT, size_t drowA, size_t drowB, int Kd, LAS unsigned* S, int lane) {
    const int n4 = lane & 15, ks = lane >> 4;
    const float* src = W + (size_t)(k0 + 2 * ks) * ldw + n0 + 4 * n4;
    f32x4 a[8], b[8];
#pragma unroll
    for (int i = 0; i < 8; ++i) { a[i] = __builtin_nontemporal_load((const GAS f32x4*)(src + (size_t)(8 * i) * ldw)); b[i] = __builtin_nontemporal_load((const GAS f32x4*)(src + (size_t)(8 * i + 1) * ldw)); }
#pragma unroll
    for (int i = 0; i < 8; ++i) { const int kp = 4 * i + ks;
#pragma unroll
        for (int j = 0; j < 4; ++j) { const int n = 4 * n4 + j; S[n * 32 + 4 * ((kp >> 2) ^ (n4 & 7)) + (kp & 3)] = pg8::cvt_pk_bf16(a[i][j], b[i][j]); } }
    LDS_WAIT(); asm volatile("" ::: "memory");
    const int c = lane & 7;
#pragma unroll
    for (int j = 0; j < 8; ++j) { const int n = (lane >> 3) + 8 * j;
        const v4u o = *(const LAS v4u*)(S + n * 32 + 4 * (c ^ ((n >> 2) & 7)));
        const size_t drow = (n < 32 ? drowA + n : drowB + (n - 32));
        *(GAS v4u*)(WT + drow * (size_t)Kd + k0 + 8 * c) = o; }
    LDS_WAIT(); asm volatile("" ::: "memory");
}
template <bool PAIR>
__device__ __forceinline__ void p0_transpose_item8(const float* W, size_t ldw, int k0, int n0, unsigned char* WT, size_t drow0, int KdB, float scale, LAS unsigned* S, int lane) {
    const int n4 = lane & 7, ks = lane >> 3;
    const float* src = W + (size_t)(k0 + 4 * ks) * ldw + n0 + 4 * n4;
    f32x4 a[4][4];
#pragma unroll
    for (int i = 0; i < 4; ++i)
#pragma unroll
        for (int r = 0; r < 4; ++r) a[i][r] = __builtin_nontemporal_load((const GAS f32x4*)(src + (size_t)(32 * i + r) * ldw));
#pragma unroll
    for (int i = 0; i < 4; ++i) { const int kq = ks + 8 * i;
#pragma unroll
        for (int j = 0; j < 4; ++j) { const int n = 4 * n4 + j; S[n * 32 + 4 * ((kq >> 2) ^ n4) + (kq & 3)] = pk4_fp8(a[i][0][j] * scale, a[i][1][j] * scale, a[i][2][j] * scale, a[i][3][j] * scale); } }
    LDS_WAIT(); asm volatile("" ::: "memory");
    const int c = lane & 7;
#pragma unroll
    for (int j = 0; j < 4; ++j) { const int n = (lane >> 3) + 8 * j;
        const v4u o = *(const LAS v4u*)(S + n * 32 + 4 * (c ^ ((n >> 2) & 7)));
        const int dn = PAIR ? ((n & 7) + 8 * ((n >> 4) & 1) + 128 * ((n >> 3) & 1)) : n;
        *(GAS v4u*)(WT + (drow0 + dn) * (size_t)KdB + k0 + 16 * c) = o; }
    LDS_WAIT(); asm volatile("" ::: "memory");
}
__device__ __forceinline__ int in_dest_row(int n0) {
    if (n0 < KCOL_DL + 768 && n0 >= QCOL_DL) { const int reg = (n0 - QCOL_DL) / 768, c = (n0 - QCOL_DL) % 768, tile = c >> 8, hd = (c & 255) >> 6, dh = (c & 63) >> 5;
        return QCOL_DL + reg * 768 + tile * 256 + dh * 128 + hd * 32; }
    return n0;
}
constexpr int ITEMS_IN = 32 * 96, ITEMS_OUT = 32 * 32, ITEMS_E = 768, ITEMS_LAYER = ITEMS_IN + ITEMS_OUT + 65 * ITEMS_E;

__device__ __forceinline__ void p0_prologue(Frame& F) {
    float* mod = (float*)(F.ws + WS_MOD);
    const float* Fc = inptr<const float>(F, I_C); const float* Fw_ada = inptr<const float>(F, I_WADA); const float* Fb_ada = inptr<const float>(F, I_BADA);
    {
        LAS float* cact = (LAS float*)(F.lds);
        LAS float* part = (LAS float*)(F.lds + 65536);
        for (int i = F.tid; i < NB * D; i += NWAVES * 64) { const float v = Fc[i]; cact[i] = v / (1.f + __expf(-v)); }
        __syncthreads();
        const int cg = F.tid & 7, kq = F.tid >> 3;
        for (int item = blockIdx.x; item < 768; item += F.G) {
            const int l = item / 384, col0 = (item % 384) * 32;
            f32x4 acc[8];
#pragma unroll
            for (int b = 0; b < 8; ++b) acc[b] = (f32x4){0.f, 0.f, 0.f, 0.f};
            const float* wp = Fw_ada + ((size_t)l * D) * 12288 + col0 + 4 * cg;
#pragma unroll 4
            for (int i = 0; i < 32; ++i) { const int k = kq + 64 * i; const f32x4 w4 = *(const GAS f32x4*)(wp + (size_t)k * 12288);
#pragma unroll
                for (int b = 0; b < 8; ++b) { const float cv = cact[b * D + k]; acc[b] += w4 * cv; } }
#pragma unroll
            for (int b = 0; b < 8; ++b) *(LAS f32x4*)(part + (kq * 8 + b) * 32 + 4 * cg) = acc[b];
            __syncthreads();
            if (F.tid < 256) { const int b = F.tid >> 5, col = F.tid & 31; float s = 0.f;
                for (int q = 0; q < 64; ++q) s += part[(q * 8 + b) * 32 + col];
                mod[((size_t)l * 8 + b) * 12288 + col0 + col] = s + Fb_ada[(size_t)l * 12288 + col0 + col]; }
            __syncthreads();
        }
    }
    {
        float* tab = (float*)(F.ws + WS_TAB); const int* Fpos = inptr<const int>(F, I_POS);
        for (int idx = blockIdx.x * (NWAVES * 64) + F.tid; idx < T * 32; idx += F.G * NWAVES * 64) {
            const int t = idx >> 5, i = idx & 31;
            const float inv = exp2f(-(float)i * (13.287712379549449f / 32.f));
            const float ang = (float)Fpos[t] * inv;
            double rev = (double)ang * 0.15915494309189535; rev -= __builtin_rint(rev);
            tab[(size_t)t * 64 + i] = __builtin_amdgcn_cosf((float)rev); tab[(size_t)t * 64 + 32 + i] = __builtin_amdgcn_sinf((float)rev);
        }
    }
    {
        const float* Fwr = inptr<const float>(F, I_WROUTER);
        for (int idx = blockIdx.x * (NWAVES * 64) + F.tid; idx < 2 * 128 * 2 * 64; idx += F.G * NWAVES * 64) {
            const int ln = idx & 63, nt = (idx >> 6) & 1, ks = (idx >> 7) & 127, l = idx >> 14;
            const int e = 32 * nt + (ln & 31), k0 = 16 * ks + 8 * (ln >> 5);
            float w[8]; unsigned hb[8], lb[8];
#pragma unroll
            for (int j = 0; j < 8; ++j) { w[j] = Fwr[((size_t)l * D + k0 + j) * NE + e]; hb[j] = f2bf(w[j]); lb[j] = f2bf(w[j] - __builtin_bit_cast(float, hb[j] << 16)); }
            v4u oh, ol; oh.x = hb[0] | (hb[1] << 16); oh.y = hb[2] | (hb[3] << 16); oh.z = hb[4] | (hb[5] << 16); oh.w = hb[6] | (hb[7] << 16);
            ol.x = lb[0] | (lb[1] << 16); ol.y = lb[2] | (lb[3] << 16); ol.z = lb[4] | (lb[5] << 16); ol.w = lb[6] | (lb[7] << 16);
            unsigned char* dst = F.ws + WS_WR + (size_t)l * 524288 + (size_t)((ks * 2 + nt) * 2) * 1024 + ln * 16;
            *(GAS v4u*)dst = oh; *(GAS v4u*)(dst + 1024) = ol;
        }
    }
    {
        const float* Fwi = inptr<const float>(F, I_WIN);
        for (int idx = blockIdx.x * (NWAVES * 64) + F.tid; idx < 2 * 128 * 64; idx += F.G * NWAVES * 64) {
            const int ln = idx & 63, ks = (idx >> 6) & 127, l = idx >> 13;
            const int n = ln & 31, k0 = 16 * ks + 8 * (ln >> 5);
            unsigned hb[8], lb[8];
#pragma unroll
            for (int j = 0; j < 8; ++j) { const float w = (n < NFOX) ? Fwi[((size_t)l * D + k0 + j) * INW + NPROJ + n] : 0.f; hb[j] = f2bf(w); lb[j] = f2bf(w - __builtin_bit_cast(float, hb[j] << 16)); }
            v4u oh, ol; oh.x = hb[0] | (hb[1] << 16); oh.y = hb[2] | (hb[3] << 16); oh.z = hb[4] | (hb[5] << 16); oh.w = hb[6] | (hb[7] << 16);
            ol.x = lb[0] | (lb[1] << 16); ol.y = lb[2] | (lb[3] << 16); ol.z = lb[4] | (lb[5] << 16); ol.w = lb[6] | (lb[7] << 16);
            unsigned char* dst = F.ws + WS_WF + (size_t)l * 262144 + (size_t)(ks * 2) * 1024 + ln * 16;
            *(GAS v4u*)dst = oh; *(GAS v4u*)(dst + 1024) = ol;
        }
    }
    {
        LAS unsigned* scr = (LAS unsigned*)(F.lds + RING_OFF + F.wave * 16384);
        const int gw = blockIdx.x * NWAVES + F.wave, NGW = F.G * NWAVES;
        for (int it = gw; it < 2 * ITEMS_LAYER; it += NGW) {
            const int l = 1 - it / ITEMS_LAYER; int r = ITEMS_LAYER - 1 - it % ITEMS_LAYER;
            bf16* WL = (bf16*)(F.ws + WS_W + (size_t)l * W_LAYER);
            if (r < ITEMS_IN) { const float* Fw_in = inptr<const float>(F, I_WIN); const int kb = r / 96, nb = r % 96;
                p0_transpose_item(Fw_in + (size_t)l * D * INW, INW, 64 * kb, 64 * nb, WL + W_IN_OFF / 2, in_dest_row(64 * nb), in_dest_row(64 * nb + 32), D, scr, F.lane); continue; }
            r -= ITEMS_IN;
            if (r < ITEMS_OUT) { const int kb = r / 64, nb = r % 64; const float* Fw_out = inptr<const float>(F, I_WOUT);
                p0_transpose_item8<false>(Fw_out + (size_t)l * D * D, D, 128 * kb, 32 * nb, F.ws + WS_W + (size_t)l * W_LAYER + W_OUT_OFF, (size_t)(32 * nb), D, (float)(1 << WSHIFT), scr, F.lane); continue; }
            r -= ITEMS_OUT;
            const int e = r / ITEMS_E, q = r % ITEMS_E;
            unsigned char* WLb = F.ws + WS_W + (size_t)l * W_LAYER;
            if (q < 512) { const int up = q >> 8, qq = q & 255, kb = qq / 16, nb = qq % 16, n0 = 32 * nb;
                const float* src = (e < NE) ? (inptr<const float>(F, up ? I_WEU : I_WEG) + ((size_t)l * NE + e) * D * EH) : (inptr<const float>(F, up ? I_WSU : I_WSG) + (size_t)l * D * EH);
                const size_t dr = (size_t)e * 1024 + (n0 >> 7) * 256 + up * 128 + (n0 & 127);
                p0_transpose_item8<false>(src, EH, 128 * kb, n0, WLb + W_1_OFF, dr, D, (float)(1 << WSHIFT), scr, F.lane);
            } else { const int qq = q - 512, kb = qq / 64, nb = qq % 64;
                const float* src = (e < NE) ? (inptr<const float>(F, I_WED) + ((size_t)l * NE + e) * EH * D) : (inptr<const float>(F, I_WSD) + (size_t)l * EH * D);
                { const int n0 = 32 * nb, o = n0 & 255; p0_transpose_item8<true>(src, D, 128 * kb, n0, WLb + W_2_OFF, (size_t)e * 2048 + (n0 & ~255) + 32 * (o >> 6) + 16 * ((o >> 5) & 1), EH, (float)(1 << WSHIFT), scr, F.lane); } }
        }
    }
}

__device__ __forceinline__ void prep_row_from_regs(Frame& F, const f32x4 (&xv)[8], int m, int l, const LAS float* wf) {
    const float* mod = (const float*)(F.ws + WS_MOD) + ((size_t)l * 8 + (m >> 11)) * 12288;
    bf16* hrow = (bf16*)(F.ws + WS_H) + (size_t)m * D;
    float fl[12];
#pragma unroll
    for (int j = 0; j < 12; ++j) fl[j] = 0.f;
#pragma unroll
    for (int j = 0; j < 8; ++j) { int k = 4 * F.lane + 256 * j; asm volatile("" : "+v"(k));
        const f32x4 sh = *(const GAS f32x4*)(mod + k), sc = *(const GAS f32x4*)(mod + 2048 + k);
        const f32x4 h = xv[j] * (sc + 1.0f) + sh;
        v2u o; o.x = pk2(h.x, h.y); o.y = pk2(h.z, h.w); *(GAS v2u*)(hrow + k) = o;
#pragma unroll
        for (int e = 0; e < 4; ++e) { const LAS f32x4* wr = (const LAS f32x4*)(wf + (k + e) * 12); const f32x4 a = wr[0], b = wr[1], c = wr[2]; const float hv = h[e];
            fl[0] += hv * a.x; fl[1] += hv * a.y; fl[2] += hv * a.z; fl[3] += hv * a.w; fl[4] += hv * b.x; fl[5] += hv * b.y; fl[6] += hv * b.z; fl[7] += hv * b.w;
            fl[8] += hv * c.x; fl[9] += hv * c.y; fl[10] += hv * c.z; fl[11] += hv * c.w; }
        asm volatile("" ::: "memory"); }
    float mine = 0.f;
#pragma unroll
    for (int j = 0; j < 12; ++j) { const float s = wave_sum(fl[j]); if (F.lane == j) mine = s; }
    if (F.lane < 12) ((float*)(F.ws + WS_FLOG))[(size_t)m * 16 + F.lane] = mine;
}
__device__ __forceinline__ void load_wf(Frame& F, int l, LAS float* wf) {
    const float* src = inptr<const float>(F, I_WIN) + (size_t)l * D * INW + NPROJ;
    for (int i = F.tid; i < D * 12; i += NWAVES * 64) { const int k = i / 12, j = i % 12; wf[i] = src[(size_t)k * INW + j]; }
    __syncthreads();
}

constexpr int APITCH = 64;
__device__ __forceinline__ size_t hm_off(int cs, int Hg, int b, int h) { return (size_t)NB * SEQ * cs + ((size_t)(b * Hg + h) * SEQ) * 64; }
namespace att {
typedef float f32x16 __attribute__((ext_vector_type(16)));
typedef short s16x4 __attribute__((ext_vector_type(4)));
typedef LAS unsigned char* lptr;
typedef float f32x2_t __attribute__((ext_vector_type(2))); typedef __bf16 bf16x2_t __attribute__((ext_vector_type(2)));
__device__ __forceinline__ unsigned cvtpk(float lo, float hi) { f32x2_t v = {lo, hi}; bf16x2_t b = __builtin_convertvector(v, bf16x2_t); return __builtin_bit_cast(unsigned, b); }
typedef short v4i16_t __attribute__((ext_vector_type(4)));
__device__ __forceinline__ s16x4 vtr(const LAS unsigned char* p) { return __builtin_bit_cast(s16x4, __builtin_amdgcn_ds_read_tr16_b64_v4i16((LAS v4i16_t*)p)); }
__device__ __forceinline__ int crow(int r, int hi) { return (r & 3) + 8 * (r >> 2) + 4 * hi; }
__device__ __forceinline__ float max3f(float a, float b, float c) { float r; asm("v_max3_f32 %0, %1, %2, %3" : "=v"(r) : "v"(a), "v"(b), "v"(c)); return r; }
__device__ __forceinline__ float max2f(float a, float b) { float r; asm("v_max_f32_e32 %0, %1, %2" : "=v"(r) : "v"(a), "v"(b)); return r; }
__device__ __forceinline__ float rowmax32(const f32x16& p0, const f32x16& p1) {
    float a = max3f(p0[0], p0[1], p1[0]), b = max3f(p0[2], p0[3], p1[1]); a = max3f(a, p1[2], p1[3]);
#pragma unroll
    for (int r = 4; r < 16; r += 4) { a = max3f(a, p0[r], p0[r + 1]); b = max3f(b, p0[r + 2], p0[r + 3]); a = max3f(a, p1[r], p1[r + 1]); b = max3f(b, p1[r + 2], p1[r + 3]); }
    return max2f(a, b);
}
__device__ __forceinline__ float rowmax16(const f32x16& p0) {
    float a = max3f(p0[0], p0[1], p0[2]), b = max3f(p0[3], p0[4], p0[5]);
    a = max3f(a, p0[6], p0[7]); b = max3f(b, p0[8], p0[9]); a = max3f(a, p0[10], p0[11]); b = max3f(b, p0[12], p0[13]); a = max3f(a, p0[14], p0[15]);
    return max2f(a, b);
}
__device__ __forceinline__ float pswap_max(float m) { auto rr = __builtin_amdgcn_permlane32_swap(__float_as_uint(m), __float_as_uint(m), false, false); return max2f(__uint_as_float(rr[0]), __uint_as_float(rr[1])); }

#define ATT_PACK8(P, B) __builtin_bit_cast(bf16x8, (v4u){cvtpk(P[B], P[B + 1]), cvtpk(P[B + 2], P[B + 3]), cvtpk(P[B + 4], P[B + 5]), cvtpk(P[B + 6], P[B + 7])})

template <int DHS>
__device__ __forceinline__ void pv_step(f32x16 (&o)[2], const LAS unsigned char* vb, int vsw, int s, bf16x8 pa) {
#pragma unroll
    for (int d0 = 0; d0 < 2; ++d0) {
        const s16x4 lo = vtr(vb + d0 * (DHS + vsw) + s * 1024), hi = vtr(vb + d0 * (DHS + vsw) + s * 1024 + 512);
        const bf16x8 vf = (bf16x8){lo[0], lo[1], lo[2], lo[3], hi[0], hi[1], hi[2], hi[3]};
        o[d0] = __builtin_amdgcn_mfma_f32_32x32x16_bf16(pa, vf, o[d0], 0, 0, 0);
    }
}
__device__ __forceinline__ void epilogue(const f32x16 (&o)[2], float linv_lane  , lptr wl, LAS float* wsf, const float* gn, unsigned char* orow0  ,
                                         int tok0, int tstride, int lane) {
    const int r32 = lane & 31, hi = lane >> 5;
    LAS float* stg = (LAS float*)wl;
#pragma unroll
    for (int r = 0; r < 16; ++r) { const int q = crow(r, hi); stg[q * 68 + r32] = o[0][r]; stg[q * 68 + 32 + r32] = o[1][r]; }
    if (hi == 0) wsf[r32] = linv_lane;
    LDS_WAIT(); asm volatile("" ::: "memory");
    const int row = lane >> 1, hf = lane & 1;
    const float li = wsf[row];
    f32x4 v[8]; float ss = 0.f;
#pragma unroll
    for (int i = 0; i < 8; ++i) { v[i] = *(const LAS f32x4*)(stg + row * 68 + hf * 32 + 4 * i) * li; ss += (v[i].x * v[i].x + v[i].y * v[i].y) + (v[i].z * v[i].z + v[i].w * v[i].w); }
    ss += __shfl_xor(ss, 1);
    const float rn = 1.0f / sqrtf(ss * (1.0f / 64.0f) + RMS_EPS);
    unsigned char* op = orow0 + (size_t)(tok0 + tstride * row) * D + hf * 32;
    const float rq = rn * 16.0f;
    unsigned wq[8];
#pragma unroll
    for (int i = 0; i < 4; ++i) { const f32x4 g0 = *(const GAS f32x4*)(gn + hf * 32 + 8 * i), g1 = *(const GAS f32x4*)(gn + hf * 32 + 8 * i + 4); const f32x4 a = v[2 * i] * rq * g0, b = v[2 * i + 1] * rq * g1;
        wq[2 * i] = pk4_fp8(a.x, a.y, a.z, a.w); wq[2 * i + 1] = pk4_fp8(b.x, b.y, b.z, b.w); }
    { v4u w0, w1; w0.x = wq[0]; w0.y = wq[1]; w0.z = wq[2]; w0.w = wq[3]; w1.x = wq[4]; w1.y = wq[5]; w1.z = wq[6]; w1.w = wq[7]; *(GAS v4u*)(op) = w0; *(GAS v4u*)(op + 16) = w1; }
    LDS_WAIT(); asm volatile("" ::: "memory");
}

__device__ __forceinline__ void qk64(f32x16& p0, f32x16& p1, const bf16x8 (&qr)[4], const LAS unsigned char* kf, const f32x16& c0, const f32x16& c1) {
    p0 = c0; p1 = c1;
#pragma unroll
    for (int d0 = 0; d0 < 4; ++d0) { const bf16x8 k0 = *(const LAS bf16x8*)(kf + d0 * 2048), k1 = *(const LAS bf16x8*)(kf + d0 * 2048 + 512);
        p0 = __builtin_amdgcn_mfma_f32_32x32x16_bf16(k0, qr[d0], p0, 0, 0, 0); p1 = __builtin_amdgcn_mfma_f32_32x32x16_bf16(k1, qr[d0], p1, 0, 0, 0); }
}
__device__ __forceinline__ void load_kf64(bf16x8 (&kf)[8], const LAS unsigned char* kt, int r32, int hi) {
#pragma unroll
    for (int d0 = 0; d0 < 4; ++d0) { const int ch = 2 * d0 + hi; const LAS unsigned char* p = kt + ch * 1024 + ((r32 ^ ch) << 4); kf[2 * d0] = *(const LAS bf16x8*)p; kf[2 * d0 + 1] = *(const LAS bf16x8*)(p + 512); }
}
template <bool ZC>
__device__ __forceinline__ void qk64_regs(f32x16& p0, f32x16& p1, const bf16x8 (&qr)[4], const bf16x8 (&kf)[8], const f32x16& c0, const f32x16& c1) {
    if (ZC) { p0 = f32x16{}; p1 = f32x16{}; } else { p0 = c0; p1 = c1; }
#pragma unroll
    for (int d0 = 0; d0 < 4; ++d0) { p0 = __builtin_amdgcn_mfma_f32_32x32x16_bf16(kf[2 * d0], qr[d0], p0, 0, 0, 0); p1 = __builtin_amdgcn_mfma_f32_32x32x16_bf16(kf[2 * d0 + 1], qr[d0], p1, 0, 0, 0); }
}
__device__ __forceinline__ void load_vf64(bf16x8 (&vf)[8], const LAS unsigned char* vb) {
#pragma unroll
    for (int s = 0; s < 4; ++s)
#pragma unroll
        for (int d0 = 0; d0 < 2; ++d0) { const s16x4 lo = vtr(vb + d0 * 4096 + s * 1024), hi = vtr(vb + d0 * 4096 + s * 1024 + 512);
            vf[2 * s + d0] = (bf16x8){lo[0], lo[1], lo[2], lo[3], hi[0], hi[1], hi[2], hi[3]}; }
}
__device__ __forceinline__ void rescale_o(f32x16 (&o)[2], float alpha, LAS float* wsf, int r32, int hi) {
    if (hi == 0) wsf[r32] = alpha;
    LDS_WAIT(); asm volatile("" ::: "memory");
#pragma unroll
    for (int j = 0; j < 4; ++j) { const f32x4 a = *(const LAS f32x4*)(wsf + 8 * j + 4 * hi);
#pragma unroll
        for (int e = 0; e < 4; ++e) { o[0][4 * j + e] *= a[e]; o[1][4 * j + e] *= a[e]; } }
    LDS_WAIT(); asm volatile("" ::: "memory");
}
constexpr float RESC_THR = 8.0f;

__device__ __forceinline__ void fox_softmax(f32x16& p0, f32x16& p1, f32x16 (&o)[2], float& mrun, float& lrun, int kv0, int qtok, bool diag, LAS float* wsf, int r32, int hi) {
    if (__builtin_amdgcn_readfirstlane((int)diag)) {
#pragma unroll
        for (int r = 0; r < 16; ++r) { const int kv = kv0 + (r & 3) + 8 * (r >> 2); if (kv > qtok) p0[r] = -INFINITY; if (kv + 32 > qtok) p1[r] = -INFINITY; } }
    float mt = pswap_max(rowmax32(p0, p1));
    if (__any(mt > mrun + RESC_THR)) { const float mnew = max2f(mrun, mt), alpha = __builtin_amdgcn_exp2f(mrun - mnew); mrun = mnew; lrun *= alpha; rescale_o(o, alpha, wsf, r32, hi); }
    float rs = 0.f;
#pragma unroll
    for (int r = 0; r < 16; ++r) { p0[r] = __builtin_amdgcn_exp2f(p0[r] - mrun); p1[r] = __builtin_amdgcn_exp2f(p1[r] - mrun); rs += p0[r] + p1[r]; }
    lrun += rs;
}
__device__ __forceinline__ void sb_weights(f32x16& p0, f32x16& p1, float& R, int kv0, int qtok, bool diag, int hi) {
    float run = 1.f;
#pragma unroll
    for (int hh = 1; hh >= 0; --hh)
#pragma unroll
        for (int j = 3; j >= 0; --j) {
            float kk[4], bb[4];
#pragma unroll
            for (int e = 0; e < 4; ++e) { const float y = hh ? p1[4 * j + e] : p0[4 * j + e]; float yc; asm("v_min_f32_e32 %0, 0x42a00000, %1" : "=v"(yc) : "v"(y)); const float ex = __builtin_amdgcn_exp2f(yc); kk[e] = __builtin_amdgcn_rcpf(1.0f + ex); bb[e] = ex * kk[e];
                if (diag) { const int kv = kv0 + 32 * hh + 8 * j + e; if (kv >= qtok) { kk[e] = 1.f; bb[e] = 0.f; } } }
            const float s2 = kk[3], s1 = kk[3] * kk[2], s0 = s1 * kk[1], Gp = s0 * kk[0];
            auto rr = __builtin_amdgcn_permlane32_swap(__float_as_uint(Gp), __float_as_uint(Gp), false, false);
            const float ga = __uint_as_float(rr[0]), gb = __uint_as_float(rr[1]);
            const float after = R * run * (hi ? 1.0f : gb);
            if (hh) { p1[4 * j] = bb[0] * after * s0; p1[4 * j + 1] = bb[1] * after * s1; p1[4 * j + 2] = bb[2] * after * s2; p1[4 * j + 3] = bb[3] * after; }
            else { p0[4 * j] = bb[0] * after * s0; p0[4 * j + 1] = bb[1] * after * s1; p0[4 * j + 2] = bb[2] * after * s2; p0[4 * j + 3] = bb[3] * after; }
            run *= ga * gb;
        }
    R *= run;
}

template <int TYPE>
__device__ __forceinline__ void causal_wg_unit(const bf16* proj, const float* cum2, const float* gn, unsigned char* obuf, int b, int h, int qb, LAS unsigned char* kvbuf, LAS float* ncum, lptr wl, LAS float* wsf, int tid, int wave) {
    const int lane = tid & 63, r32 = lane & 31, hi = lane >> 5;
    constexpr int QC = TYPE == 0 ? QCOL_SB : QCOL_FX, KC = TYPE == 0 ? KCOL_SB : KCOL_FX, VC = TYPE == 0 ? VCOL_SB : VCOL_FX;
    constexpr int HG = TYPE == 0 ? 8 : 12;
    const bf16* Qp = proj + hm_off(QC, HG, b, h); const bf16* Kp = proj + hm_off(KC, HG, b, h); const bf16* Vp = proj + hm_off(VC, HG, b, h);
    const int qt = 8 * qb + wave, qtok = 32 * qt + r32;
    bf16x8 qr[4];
#pragma unroll
    for (int d0 = 0; d0 < 4; ++d0) qr[d0] = *(const GAS bf16x8*)(Qp + (size_t)qtok * APITCH + d0 * 16 + hi * 8);
    const int NT = 4 * qb + 4, my_tlast = qt >> 1;
    const unsigned lvoff = (unsigned)(((tid >> 3) * APITCH + (tid & 7) * 8) * 2);
    const int skey = tid >> 3, sch = tid & 7;
    const int kst = sch * 1024 + ((skey ^ sch) << 4), vst = 8192 + (sch >> 2) * 4096 + ((skey ^ (sch >> 2)) << 6) + (sch & 3) * 16;
    v4u kreg, vreg;
#define ATT_TILE(s_) (TYPE == 0 ? NT - 1 - (s_) : (s_))
#define ATT_LOAD(t) do { kreg = *(const GAS v4u*)((const char*)(Kp + (size_t)(64 * (t)) * APITCH) + lvoff); vreg = *(const GAS v4u*)((const char*)(Vp + (size_t)(64 * (t)) * APITCH) + lvoff); } while (0)
#define ATT_STORE(slot) do { *(LAS v4u*)(kvbuf + (slot) * 16384 + kst) = kreg; *(LAS v4u*)(kvbuf + (slot) * 16384 + vst) = vreg; } while (0)
    if (TYPE == 1) { const int n = 256 * (qb + 1); if (4 * tid < n) { const f32x4 c = *(const GAS f32x4*)(cum2 + 4 * tid); v4u w;
#pragma unroll
        for (int e = 0; e < 4; ++e) { const float v = -c[e]; const unsigned hb = f2bf(v); const unsigned lb = f2bf(v - __builtin_bit_cast(float, hb << 16)); w[e] = hb | (lb << 16); }
        *(LAS v4u*)(ncum + 4 * tid) = w; } }
    const bf16x8 qone = hi ? (bf16x8){0, 0, 0, 0, 0, 0, 0, 0} : (bf16x8){(short)0x3f80, (short)0x3f80, 0, 0, 0, 0, 0, 0};
    f32x16 o[2]; o[0] = f32x16{}; o[1] = f32x16{};
    float mrun = -1e30f, lrun = 0.f, R = 1.f;
    const int vbo = 8192 + ((lane >> 4) & 1) * 32 + (lane & 3) * 8 + (4 * hi + ((lane & 15) >> 2)) * 64, vsw = ((lane >> 2) & 1) ? -64 : 64;
    ATT_LOAD(ATT_TILE(0)); ATT_STORE(0);
    ATT_LOAD(ATT_TILE(1)); ATT_STORE(1);
    __syncthreads();
    f32x16 pc0 = f32x16{}, pc1 = f32x16{}, pn0 = f32x16{}, pn1 = f32x16{};
#define ATT_QK(P0, P1, s_) do { const int t_ = ATT_TILE(s_); const LAS unsigned char* kb_ = kvbuf + ((s_) % 3) * 16384; \
        if (TYPE == 1) { const LAS unsigned* cw_ = (const LAS unsigned*)ncum + 64 * t_ + r32; const unsigned w0_ = hi ? 0u : cw_[0], w1_ = hi ? 0u : cw_[32]; \
            const bf16x8 ka_ = __builtin_bit_cast(bf16x8, (v4u){w0_, 0u, 0u, 0u}), kb2_ = __builtin_bit_cast(bf16x8, (v4u){w1_, 0u, 0u, 0u}); \
            bf16x8 kf_[8]; load_kf64(kf_, kb_, r32, hi); \
            f32x16 c0_ = __builtin_amdgcn_mfma_f32_32x32x16_bf16(ka_, qone, f32x16{}, 0, 0, 0), c1_ = __builtin_amdgcn_mfma_f32_32x32x16_bf16(kb2_, qone, f32x16{}, 0, 0, 0); \
            qk64_regs<false>(P0, P1, qr, kf_, c0_, c1_); } \
        else { bf16x8 kf_[8]; load_kf64(kf_, kb_, r32, hi); qk64_regs<true>(P0, P1, qr, kf_, P0, P1); } } while (0)
    if (ATT_TILE(0) <= my_tlast) ATT_QK(pc0, pc1, 0);
    constexpr float SB_DEAD = 1e-30f;
    bool dead = false;
    LAS int* aflag = (LAS int*)ncum;
    for (int s = 0; s < NT; ++s) {
        const int t = ATT_TILE(s);
        if (s + 2 < NT) ATT_LOAD(ATT_TILE(s + 2));
        const bool act = !dead && t <= my_tlast, actn = !dead && (s + 1 < NT) && (ATT_TILE(s + 1) <= my_tlast);
        if (actn) ATT_QK(pn0, pn1, s + 1);
        if (act) {
            const int kv0 = 64 * t + 4 * hi; const bool diag = (t == my_tlast);
            if (TYPE == 1) fox_softmax(pc0, pc1, o, mrun, lrun, kv0, qtok, diag, wsf, r32, hi);
            else sb_weights(pc0, pc1, R, kv0, qtok, diag, hi);
            const bf16x8 pa0 = ATT_PACK8(pc0, 0), pa1 = ATT_PACK8(pc0, 8), pa2 = ATT_PACK8(pc1, 0), pa3 = ATT_PACK8(pc1, 8);
            const LAS unsigned char* vb = kvbuf + (s % 3) * 16384 + vbo;
            pv_step<4096>(o, vb, vsw, 0, pa0); pv_step<4096>(o, vb, vsw, 1, pa1); pv_step<4096>(o, vb, vsw, 2, pa2); pv_step<4096>(o, vb, vsw, 3, pa3);
        }
        if (s + 2 < NT) ATT_STORE((s + 2) % 3);
        if (TYPE == 0) { if (act && !__any(R >= SB_DEAD)) dead = true; if (lane == 0) aflag[(s & 1) * 8 + wave] = dead ? 0 : 1; }
        __syncthreads();
        if (TYPE == 0) { const v4u f0 = *(const LAS v4u*)(aflag + (s & 1) * 8), f1 = *(const LAS v4u*)(aflag + (s & 1) * 8 + 4);
            if (((f0.x | f0.y) | (f0.z | f0.w) | (f1.x | f1.y) | (f1.z | f1.w)) == 0u) break; }
        pc0 = pn0; pc1 = pn1;
    }
#undef ATT_QK
#undef ATT_TILE
#undef ATT_LOAD
#undef ATT_STORE
    float linv = 1.0f;
    if (TYPE == 1) { auto rr = __builtin_amdgcn_permlane32_swap(__float_as_uint(lrun), __float_as_uint(lrun), false, false); linv = 1.0f / (__uint_as_float(rr[0]) + __uint_as_float(rr[1])); }
    const int headcol = TYPE == 0 ? h : 8 + h;
    epilogue(o, linv, wl, wsf, gn + headcol * 64, obuf + (size_t)b * SEQ * D + headcol * 64, 32 * qt, 1, lane);
}

__device__ __forceinline__ void qk32(f32x16& p0, const bf16x8 (&qr)[4], const LAS unsigned char* kt, int r32, int hi) {
    p0 = f32x16{};
#pragma unroll
    for (int d0 = 0; d0 < 4; ++d0) { const int ch = 2 * d0 + hi; const bf16x8 k0 = *(const LAS bf16x8*)(kt + ch * 512 + ((r32 ^ ch) << 4)); p0 = __builtin_amdgcn_mfma_f32_32x32x16_bf16(k0, qr[d0], p0, 0, 0, 0); }
}
__device__ __forceinline__ void dil_softmax_pv(f32x16& p0, f32x16 (&o)[2], float& mrun, float& lrun, const LAS unsigned char* vb, int vsw, int jq, int jb, LAS float* wsf, int r32, int hi) {
#pragma unroll
    for (int r = 0; r < 16; ++r) { const int dist = jq - (jb + (r & 3) + 8 * (r >> 2)); if ((unsigned)dist > 128u) p0[r] = -INFINITY; }
    float mt = pswap_max(rowmax16(p0));
    if (__any(mt > mrun + RESC_THR)) { const float mnew = max2f(mrun, mt), alpha = __builtin_amdgcn_exp2f(mrun - mnew); mrun = mnew; lrun *= alpha; rescale_o(o, alpha, wsf, r32, hi); }
    float rs = 0.f;
#pragma unroll
    for (int r = 0; r < 16; ++r) { p0[r] = __builtin_amdgcn_exp2f(p0[r] - mrun); rs += p0[r]; }
    lrun += rs;
    const bf16x8 pa0 = ATT_PACK8(p0, 0), pa1 = ATT_PACK8(p0, 8);
    pv_step<2048>(o, vb, vsw, 0, pa0); pv_step<2048>(o, vb, vsw, 1, pa1);
}
#define DILP_LOAD(sh_, rst_, tt_) do { const unsigned lvo_ = (unsigned)((((lane >> 3) << (sh_)) * APITCH + (lane & 7) * 8) * 2); const size_t tok0_ = (size_t)((rst_) + ((32 * (tt_)) << (sh_))); \
        const char* kb_ = (const char*)(Kp + tok0_ * APITCH); const char* vb_ = (const char*)(Vp + tok0_ * APITCH); const size_t is_ = (size_t)(8 << (sh_)) * APITCH * 2; \
        _Pragma("unroll") for (int i = 0; i < 4; ++i) { kreg[i] = *(const GAS v4u*)(kb_ + i * is_ + lvo_); vreg[i] = *(const GAS v4u*)(vb_ + i * is_ + lvo_); } } while (0)
#define DILP_STORE() do { _Pragma("unroll") for (int i = 0; i < 4; ++i) { const int id = lane + 64 * i, key = id >> 3, ch = id & 7; \
        *(LAS v4u*)(wl + ch * 512 + ((key ^ ch) << 4)) = kreg[i]; *(LAS v4u*)(wl + 4096 + (ch >> 2) * 2048 + ((key ^ (ch >> 2)) << 6) + (ch & 3) * 16) = vreg[i]; } } while (0)
__device__ __forceinline__ void dil_a_unit(const bf16* proj, bf16* SO, float* SM, gu32* done, int b, int h, int qb, lptr wl, LAS float* wsf, int tid, int wave) {
    const int lane = tid & 63, r32 = lane & 31, hi = lane >> 5;
    const bf16* Qp = proj + hm_off(QCOL_DL, 12, b, h); const bf16* Kp = proj + hm_off(KCOL_DL, 12, b, h); const bf16* Vp = proj + hm_off(VCOL_DL, 12, b, h);
    const int qt = 8 * qb + wave, qtok = 32 * qt + r32;
    bf16x8 qr[4];
#pragma unroll
    for (int d0 = 0; d0 < 4; ++d0) qr[d0] = *(const GAS bf16x8*)(Qp + (size_t)qtok * APITCH + d0 * 16 + hi * 8);
    f32x16 o[2]; o[0] = f32x16{}; o[1] = f32x16{};
    float mrun = -1e30f, lrun = 0.f;
    const int vbo = 4096 + ((lane >> 4) & 1) * 32 + (lane & 3) * 8 + (4 * hi + ((lane & 15) >> 2)) * 64, vsw = ((lane >> 2) & 1) ? -64 : 64;
    v4u kreg[4], vreg[4];
    int tt = qt > 4 ? qt - 4 : 0;
    DILP_LOAD(0, 0, tt);
    for (;;) {
        DILP_STORE();
        const int jb = 32 * tt + 4 * hi; const bool more = tt < qt;
        if (more) { ++tt; DILP_LOAD(0, 0, tt); }
        f32x16 p0; qk32(p0, qr, wl, r32, hi);
        dil_softmax_pv(p0, o, mrun, lrun, wl + vbo, vsw, qtok, jb, wsf, r32, hi);
        if (!more) break;
    }
    { auto rr = __builtin_amdgcn_permlane32_swap(__float_as_uint(lrun), __float_as_uint(lrun), false, false); lrun = __uint_as_float(rr[0]) + __uint_as_float(rr[1]); }
    const size_t srow0 = ((size_t)(b * 12 + h) * SEQ + 32 * qt);
    if (hi == 0) __hip_atomic_store((unsigned long long*)(SM + (srow0 + r32) * 2), ((unsigned long long)__float_as_uint(lrun) << 32) | __float_as_uint(mrun), RLX_AGENT);
    LAS float* stg = (LAS float*)wl;
#pragma unroll
    for (int r = 0; r < 16; ++r) { const int q = crow(r, hi); stg[q * 68 + r32] = o[0][r]; stg[q * 68 + 32 + r32] = o[1][r]; }
    LDS_WAIT(); asm volatile("" ::: "memory");
    { const int row = lane >> 1, hf = lane & 1; bf16* op = SO + (srow0 + row) * 64 + hf * 32;
#pragma unroll
      for (int i = 0; i < 4; ++i) { const f32x4 a = *(const LAS f32x4*)(stg + row * 68 + hf * 32 + 8 * i), c = *(const LAS f32x4*)(stg + row * 68 + hf * 32 + 8 * i + 4);
          v4u w; w.x = pk2(a.x, a.y); w.y = pk2(a.z, a.w); w.z = pk2(c.x, c.y); w.w = pk2(c.z, c.w);
          asm volatile("global_store_dwordx4 %0, %1, off sc1" :: "v"(op + 8 * i), "v"(w) : "memory"); } }
    LDS_WAIT();
    asm volatile("s_waitcnt vmcnt(0)" ::: "memory");
    __syncthreads();
    if (tid == 0) __hip_atomic_fetch_add(done, 1u, RLX_AGENT);
}
__device__ __forceinline__ void dil_b_unit(const bf16* proj, const bf16* SO, const float* SM, gu32* done, gu32* tmo, const float* gn, unsigned char* obuf, int b, int h, int blk, int half, lptr wl, LAS float* wsf, int tid, int wave) {
    const int lane = tid & 63, r32 = lane & 31, hi = lane >> 5, r16 = 8 * half + wave;
    if (tid == 0) { unsigned sp = 0; while (__hip_atomic_load(done, RLX_AGENT) < 2u) { __builtin_amdgcn_s_sleep(2); if (++sp > (1u << 22)) { __hip_atomic_store(tmo, 1u, RLX_AGENT); break; } }
        __builtin_amdgcn_fence(__ATOMIC_ACQUIRE, "agent"); asm volatile("s_waitcnt vmcnt(0)" ::: "memory"); }
    __syncthreads();
    const bf16* Qp = proj + hm_off(QCOL_DL, 12, b, h); const bf16* Kp = proj + hm_off(KCOL_DL, 12, b, h); const bf16* Vp = proj + hm_off(VCOL_DL, 12, b, h);
    const int p0tok = 512 * blk + r16;
    bf16x8 qr[4];
#pragma unroll
    for (int d0 = 0; d0 < 4; ++d0) qr[d0] = *(const GAS bf16x8*)(Qp + (size_t)(p0tok + 16 * r32) * APITCH + d0 * 16 + hi * 8);
    const size_t srow0 = (size_t)(b * 12 + h) * SEQ + p0tok;
    const f32x2_t ml = *(const GAS f32x2_t*)(SM + (srow0 + 16 * r32) * 2);
    float mrun = ml.x, lrun = hi ? 0.f : ml.y;
    f32x16 o[2];
    { LAS float* stg = (LAS float*)wl; const int row = lane >> 1, hf = lane & 1; const bf16* ip = SO + (srow0 + 16 * row) * 64 + hf * 32;
#pragma unroll
      for (int i = 0; i < 4; ++i) { const v4u w = *(const GAS v4u*)(ip + 8 * i);
          *(LAS f32x4*)(stg + row * 68 + hf * 32 + 8 * i) = (f32x4){bflo(w.x), bfhi(w.x), bflo(w.y), bfhi(w.y)}; *(LAS f32x4*)(stg + row * 68 + hf * 32 + 8 * i + 4) = (f32x4){bflo(w.z), bfhi(w.z), bflo(w.w), bfhi(w.w)}; }
      LDS_WAIT(); asm volatile("" ::: "memory");
#pragma unroll
      for (int r = 0; r < 16; ++r) { const int q = crow(r, hi); o[0][r] = stg[q * 68 + r32]; o[1][r] = stg[q * 68 + 32 + r32]; }
      LDS_WAIT(); asm volatile("" ::: "memory"); }
    const int vbo = 4096 + ((lane >> 4) & 1) * 32 + (lane & 3) * 8 + (4 * hi + ((lane & 15) >> 2)) * 64, vsw = ((lane >> 2) & 1) ? -64 : 64;
    {
        int sh = 2, rst = r16 & 3, jq0 = (p0tok - rst) >> 2, dj = 4;
        int tt = (jq0 > 128 ? jq0 - 128 : 0) >> 5, thi = (jq0 + dj * 31) >> 5;
        v4u kreg[4], vreg[4];
        DILP_LOAD(sh, rst, tt);
        for (;;) {
            DILP_STORE();
            const int jq = jq0 + dj * r32, jb = 32 * tt + 4 * hi;
            bool more = true;
            if (tt < thi) ++tt;
            else if (sh == 2) { sh = 4; rst = r16; jq0 = (p0tok - rst) >> 4; dj = 1; tt = (jq0 > 128 ? jq0 - 128 : 0) >> 5; thi = (jq0 + 31) >> 5; }
            else more = false;
            if (more) DILP_LOAD(sh, rst, tt);
            f32x16 p0; qk32(p0, qr, wl, r32, hi);
            dil_softmax_pv(p0, o, mrun, lrun, wl + vbo, vsw, jq, jb, wsf, r32, hi);
            if (!more) break;
        }
    }
    auto rr = __builtin_amdgcn_permlane32_swap(__float_as_uint(lrun), __float_as_uint(lrun), false, false);
    const float linv = 1.0f / (__uint_as_float(rr[0]) + __uint_as_float(rr[1]));
    epilogue(o, linv, wl, wsf, gn + (20 + h) * 64, obuf + (size_t)b * SEQ * D + (20 + h) * 64, p0tok, 16, lane);
}
__device__ __forceinline__ void sb_wave_unit(const bf16* proj, const float* gn, unsigned char* obuf, int b, int h, int qt, lptr wl, LAS float* wsf, int lane) {
    const int r32 = lane & 31, hi = lane >> 5;
    const bf16* Qp = proj + hm_off(QCOL_SB, 8, b, h); const bf16* Kp = proj + hm_off(KCOL_SB, 8, b, h); const bf16* Vp = proj + hm_off(VCOL_SB, 8, b, h);
    const int qtok = 32 * qt + r32;
    bf16x8 qr[4];
#pragma unroll
    for (int d0 = 0; d0 < 4; ++d0) qr[d0] = *(const GAS bf16x8*)(Qp + (size_t)qtok * APITCH + d0 * 16 + hi * 8);
    f32x16 o[2]; o[0] = f32x16{}; o[1] = f32x16{};
    float R = 1.f;
    const int vbo = 4096 + ((lane >> 4) & 1) * 32 + (lane & 3) * 8 + (4 * hi + ((lane & 15) >> 2)) * 64, vsw = ((lane >> 2) & 1) ? -64 : 64;
    v4u kreg[4], vreg[4];
    int tt = qt;
    DILP_LOAD(0, 0, tt);
    for (;;) {
        DILP_STORE();
        const int kv0 = 32 * tt + 4 * hi; const bool diag = (tt == qt), more = tt > 0;
        if (more) { DILP_LOAD(0, 0, tt - 1); }
        f32x16 p0; qk32(p0, qr, wl, r32, hi);
        asm volatile("s_nop 15\n\ts_nop 7" : "+v"(p0));
        float run = 1.f;
#pragma unroll
        for (int j = 3; j >= 0; --j) {
            float kk[4], bb[4];
#pragma unroll
            for (int e = 0; e < 4; ++e) { float yc; asm("v_min_f32_e32 %0, 0x42a00000, %1" : "=v"(yc) : "v"(p0[4 * j + e])); const float ex = __builtin_amdgcn_exp2f(yc); kk[e] = __builtin_amdgcn_rcpf(1.0f + ex); bb[e] = ex * kk[e];
                if (diag) { const int kv = kv0 + 8 * j + e; if (kv >= qtok) { kk[e] = 1.f; bb[e] = 0.f; } } }
            const float s2 = kk[3], s1 = kk[3] * kk[2], s0 = s1 * kk[1], Gp = s0 * kk[0];
            auto rr = __builtin_amdgcn_permlane32_swap(__float_as_uint(Gp), __float_as_uint(Gp), false, false);
            const float ga = __uint_as_float(rr[0]), gb = __uint_as_float(rr[1]);
            const float after = R * run * (hi ? 1.0f : gb);
            p0[4 * j] = bb[0] * after * s0; p0[4 * j + 1] = bb[1] * after * s1; p0[4 * j + 2] = bb[2] * after * s2; p0[4 * j + 3] = bb[3] * after;
            run *= ga * gb;
        }
        R *= run;
        const bf16x8 pa0 = ATT_PACK8(p0, 0), pa1 = ATT_PACK8(p0, 8);
        pv_step<2048>(o, wl + vbo, vsw, 0, pa0); pv_step<2048>(o, wl + vbo, vsw, 1, pa1);
        if (!more || !__any(R >= 1e-30f)) break;
        --tt;
    }
    epilogue(o, 1.0f, wl, wsf, gn + h * 64, obuf + (size_t)b * SEQ * D + h * 64, 32 * qt, 1, lane);
}
#undef DILP_LOAD
#undef DILP_STORE
#undef ATT_PACK8
}

using pg8::Unit; using pg8::HALF; using pg8::BM; using pg8::cvt_pk_bf16;
struct EpiProj {
    static constexpr bool PERM = true;
    bf16* O; const float* tab;
    __device__ __forceinline__ bf16* dst(int row, int c) const {
        const int cs = c < 1536 ? (c >> 9) << 9 : 1536 + ((c - 1536) / 768) * 768, Hg = c < 1536 ? 8 : 12;
        const int hl = (c - cs) >> 6, d = c & 63, b = row >> 11, sq = row & 2047;
        return O + (size_t)NB * SEQ * cs + ((size_t)(b * Hg + hl) * SEQ + sq) * 64 + d;
    }
    __device__ __forceinline__ void operator()(const f32x4 (&acc)[2][2][4][2], const Unit& u, int wr, int wc, int fr, int fq) const {
        const int row0 = u.pm * BM + wr * 64 + fr, pn = u.pn;
        const bool isq = (pn < 2) || (pn >= 6 && pn < 9) || (pn >= 15 && pn < 18);
        const float sc = isq ? C2 : 1.0f;
        if (pn >= 15 && pn < 21) {
            const int col = pn * 256 + wc * 64 + 8 * fq;
            f32x4 tn[4];
            { const float* tr = tab + (size_t)row0 * 64 + 8 * fq; tn[0] = *(const GAS f32x4*)(tr); tn[1] = *(const GAS f32x4*)(tr + 4); tn[2] = *(const GAS f32x4*)(tr + 32); tn[3] = *(const GAS f32x4*)(tr + 36); }
#pragma unroll
            for (int ai = 0; ai < 2; ++ai)
#pragma unroll
                for (int m = 0; m < 4; ++m) { const int row = row0 + ai * HALF + m * 16;
                    const f32x4 c0 = tn[0], c1 = tn[1], s0 = tn[2], s1 = tn[3];
                    if (ai * 4 + m < 7) { const int rown = row0 + ((ai * 4 + m + 1) >> 2) * HALF + ((ai * 4 + m + 1) & 3) * 16; const float* tr = tab + (size_t)rown * 64 + 8 * fq;
                        tn[0] = *(const GAS f32x4*)(tr); tn[1] = *(const GAS f32x4*)(tr + 4); tn[2] = *(const GAS f32x4*)(tr + 32); tn[3] = *(const GAS f32x4*)(tr + 36); }
                    const f32x4 a0 = acc[ai][0][m][0] * sc, a1 = acc[ai][0][m][1] * sc, b0 = acc[ai][1][m][0] * sc, b1 = acc[ai][1][m][1] * sc;
                    const f32x4 l0 = a0 * c0 - b0 * s0, l1 = a1 * c1 - b1 * s1, h0 = a0 * s0 + b0 * c0, h1 = a1 * s1 + b1 * c1;
                    pg8::u32x4 wl, wh; wl.x = cvt_pk_bf16(l0[0], l0[1]); wl.y = cvt_pk_bf16(l0[2], l0[3]); wl.z = cvt_pk_bf16(l1[0], l1[1]); wl.w = cvt_pk_bf16(l1[2], l1[3]);
                    wh.x = cvt_pk_bf16(h0[0], h0[1]); wh.y = cvt_pk_bf16(h0[2], h0[3]); wh.z = cvt_pk_bf16(h1[0], h1[1]); wh.w = cvt_pk_bf16(h1[2], h1[3]);
                    bf16* rp = dst(row, col); *(pg8::u32x4*)rp = wl; *(pg8::u32x4*)(rp + 32) = wh;
                    asm volatile("" ::: "memory"); }
        } else {
            const int col0 = pn * 256 + wc * 32 + 8 * fq;
#pragma unroll
            for (int ai = 0; ai < 2; ++ai)
#pragma unroll
                for (int m = 0; m < 4; ++m) { const int row = row0 + ai * HALF + m * 16;
#pragma unroll
                    for (int bj = 0; bj < 2; ++bj) { const f32x4 v0 = acc[ai][bj][m][0] * sc, v1 = acc[ai][bj][m][1] * sc;
                        pg8::u32x4 w; w.x = cvt_pk_bf16(v0[0], v0[1]); w.y = cvt_pk_bf16(v0[2], v0[3]); w.z = cvt_pk_bf16(v1[0], v1[1]); w.w = cvt_pk_bf16(v1[2], v1[3]);
                        *(pg8::u32x4*)dst(row, col0 + bj * HALF) = w; } }
        }
    }
};
struct EpiMix {
    static constexpr bool PERM = true;
    bf16* O;
    __device__ __forceinline__ void operator()(const f32x4 (&acc)[2][2][4][2], const Unit& u, int wr, int wc, int fr, int fq) const {
        const int row0 = u.pm * BM + wr * 64 + fr, col0 = u.pn * BM + wc * 32 + 8 * fq;
#pragma unroll
        for (int ai = 0; ai < 2; ++ai)
#pragma unroll
            for (int m = 0; m < 4; ++m) { bf16* rowp = O + (size_t)(row0 + ai * HALF + m * 16) * D + col0;
#pragma unroll
                for (int bj = 0; bj < 2; ++bj) { const f32x4 v0 = acc[ai][bj][m][0], v1 = acc[ai][bj][m][1];
                    pg8::u32x4 w; w.x = cvt_pk_bf16(v0[0], v0[1]); w.y = cvt_pk_bf16(v0[2], v0[3]); w.z = cvt_pk_bf16(v1[0], v1[1]); w.w = cvt_pk_bf16(v1[2], v1[3]);
                    *(pg8::u32x4*)(rowp + bj * HALF) = w; } }
    }
};
struct EpiSwiglu {
    static constexpr bool PERM = true;
    unsigned char* O;
    __device__ __forceinline__ void operator()(const f32x4 (&acc)[2][2][4][2], const Unit& u, int wr, int wc, int fr, int fq) const {
        const int row0 = u.pm * BM + wr * 64 + fr, col0 = (u.pn & 3) * 128 + wc * 32 + 8 * fq;
#pragma unroll
        for (int ai = 0; ai < 2; ++ai)
#pragma unroll
            for (int m = 0; m < 4; ++m) { float r[8];
#pragma unroll
                for (int n = 0; n < 2; ++n)
#pragma unroll
                    for (int e = 0; e < 4; ++e) { const float g = acc[ai][0][m][n][e], up = acc[ai][1][m][n][e]; r[4 * n + e] = g * __builtin_amdgcn_rcpf(1.0f + __builtin_amdgcn_exp2f(-g * LOG2E)) * up * (float)(1 << ASHIFT); }
                v2u w; w.x = pk4_fp8(r[0], r[1], r[2], r[3]); w.y = pk4_fp8(r[4], r[5], r[6], r[7]);
                *(v2u*)(O + (size_t)(row0 + ai * HALF + m * 16) * EH + col0) = w; }
    }
};
struct EpiDown {
    static constexpr bool PERM = true;
    unsigned char* O;
    const LAS int* tileE; const LAS int* tb; const LAS int* cnt; const int* list2;
    __device__ __forceinline__ void operator()(const f32x4 (&acc)[2][2][4][2], const Unit& u, int wr, int wc, int fr, int fq) const {
        const int col0 = (u.pn & 7) * 256 + wc * 64 + 16 * fq;
        const int e = tileE[u.pm], lbase = (u.pm - tb[e]) * 256 + wr * 64 + fr, ce = cnt[e];
        const float ysc = (float)(1 << YSHIFT);
        int drow[2][4];
#pragma unroll
        for (int ai = 0; ai < 2; ++ai)
#pragma unroll
            for (int m = 0; m < 4; ++m) { const int local = lbase + ai * HALF + m * 16; drow[ai][m] = (e >= NE) ? (local * 7 + 6) : ((local < ce) ? list2[(size_t)e * LISTCAP + local] : 7 * T); }
#pragma unroll
        for (int ai = 0; ai < 2; ++ai)
#pragma unroll
            for (int m = 0; m < 4; ++m) { unsigned char* rowp = O + (size_t)drow[ai][m] * D + col0;
                const f32x4 a0 = acc[ai][0][m][0] * ysc, a1 = acc[ai][0][m][1] * ysc, b0 = acc[ai][1][m][0] * ysc, b1 = acc[ai][1][m][1] * ysc;
                v4u w; w.x = pk4_fp8(a0[0], a0[1], a0[2], a0[3]); w.y = pk4_fp8(a1[0], a1[1], a1[2], a1[3]); w.z = pk4_fp8(b0[0], b0[1], b0[2], b0[3]); w.w = pk4_fp8(b1[0], b1[1], b1[2], b1[3]);
                *(v4u*)rowp = w; }
    }
};
template <bool GATHER_, int NT>
struct MoeOrder {
    static constexpr bool GATHER = GATHER_;
    int G, c, nunits; const LAS int* tileE; const LAS int* tb; const LAS int* cnt; const int* list; unsigned K2;
    __device__ __forceinline__ bool next(int i, Unit& u) const {
        const int v = ((G & 7) == 0) ? (c & 7) * (G >> 3) + (c >> 3) : c;
        const int L = i * G + v; if (L >= nunits) return false;
        const int pm = L / NT, pl = L % NT; u.pm = pm; u.pn = tileE[pm] * NT + pl; return true;
    }
    __device__ __forceinline__ unsigned tok_off(const Unit& u, int r) const {
        const int e = tileE[u.pm], local = (u.pm - tb[e]) * 256 + r;
        int tok = local;
        if (e < NE) tok = (local < cnt[e]) ? list[(size_t)e * LISTCAP + local] : 0;
        return (unsigned)tok * K2;
    }
};
__device__ __forceinline__ void build_tables(Frame& F, int l) {
    LAS int* tileE = (LAS int*)(F.lds + TILEE_OFF); LAS int* tb = (LAS int*)(F.lds + TB_OFF); LAS int* cnt = (LAS int*)(F.lds + CNT_OFF);
    if (F.wave == 0) {
        int c = (int)__hip_atomic_load(F.ctl + CW_CURSOR + (l * 64 + F.lane) * 16, RLX_AGENT); if (c > LISTCAP) c = LISTCAP;
        const int tiles = (c + 255) >> 8; int inc = tiles;
#pragma unroll
        for (int o = 1; o < 64; o <<= 1) { const int t = __shfl_up(inc, o); if (F.lane >= o) inc += t; }
        cnt[F.lane] = c; tb[F.lane] = inc - tiles;
        if (F.lane == 63) { cnt[64] = T; tb[64] = inc; tb[65] = inc + 64; }
    }
    __syncthreads();
    const int nt = tb[65];
    for (int pm = F.tid; pm < nt; pm += NWAVES * 64) { int e = 0;
#pragma unroll 1
        for (int step = 64; step >= 1; step >>= 1) { const int q = e + step; if (q <= 64 && tb[q] <= pm) e = q; }
        tileE[pm] = e; }
    __syncthreads();
}

#if MK_ONE_LAUNCH
#define GRID_BAR() xcd_barrier(bar, F.tid == 0)
#else
#define GRID_BAR() do { } while (0)
#endif
#ifndef ONLY_PHASE
#define ONLY_PHASE -1
#endif
#define IN(k) ((ONLY_PHASE < 0 || ONLY_PHASE == ((k) < 1 ? (k) : 1 + ((k) - 1) % 8)) && lo <= (k) && (k) < hi)
#define BOTH(k) (IN(k) && IN((k) + 1))
#ifndef REPEAT_MASK
#define REPEAT_MASK 0
#endif
#define NREP(k) (1 + ((REPEAT_MASK >> (k)) & 1))
__device__ __forceinline__ int affine_item(int item_, int G) { if (G != 256) return item_; const int c = item_ & 255, i = item_ >> 8; return 64 * (c & 7) + (c >> 3) + 32 * i; }
template <int l>
__device__ __forceinline__ void layer_phases(Frame& F, const XcdBarrier& bar, const int lo, const int hi) {
    unsigned char* ws = F.ws;
    const int gw = blockIdx.x * NWAVES + F.wave, NGW = F.G * NWAVES;
    constexpr int pb = 2 + 8 * l;

        if (IN(pb - 1)) for (int rep = 0; rep < NREP(1); ++rep) {
            refresh(F);
            LAS unsigned char* hs = F.lds + RING_OFF;
            LAS float* part = (LAS float*)(F.lds + RING_OFF);
            const unsigned char* wff = ws + WS_WF + (size_t)l * 262144;
            const float* Fx = inptr<const float>(F, I_X); const bf16* Xb = (const bf16*)(ws + WS_X2B);
            bf16* hbuf = (bf16*)(ws + WS_H); float* flog = (float*)(ws + WS_FLOG);
            for (int item_ = blockIdx.x; item_ < T / 32; item_ += F.G) {
                const int ia_ = affine_item(item_, F.G);
                const int item = (l == 1) ? ((F.G == 256) ? ((ia_ & ~63) + 63 - (ia_ & 63)) : (T / 32 - 1 - item_)) : ia_;
                const int m0 = item * 32 + 4 * F.wave;
                int lq = F.lane; asm volatile("" : "+v"(lq));
                const int r32 = lq & 31, hi5 = lq >> 5;
                const float* mrow = (const float*)(ws + WS_MOD) + ((size_t)l * 8 + (m0 >> 11)) * 12288;
                f32x4 xv[4][8];
#pragma unroll
                for (int rr = 0; rr < 4; ++rr)
#pragma unroll
                    for (int j = 0; j < 8; ++j) { const size_t o0 = (size_t)(m0 + rr) * D + 4 * lq + 256 * j;
                        if (l == 0) xv[rr][j] = __builtin_nontemporal_load((const GAS f32x4*)(Fx + o0)); else { const v2u a = __builtin_nontemporal_load((const GAS v2u*)(Xb + o0)); xv[rr][j] = bf4(a.x, a.y); } }
#pragma unroll
                for (int j = 0; j < 8; ++j) { const int k = 4 * lq + 256 * j;
                    const f32x4 sh = *(const GAS f32x4*)(mrow + k), sc = *(const GAS f32x4*)(mrow + 2048 + k) + 1.0f;
#pragma unroll
                    for (int rr = 0; rr < 4; ++rr) { const int rloc = 4 * F.wave + rr; const f32x4 h = xv[rr][j] * sc + sh;
                        v2u o; o.x = pk2(h.x, h.y); o.y = pk2(h.z, h.w);
                        *(GAS v2u*)(hbuf + (size_t)(m0 + rr) * D + k) = o;
                        const int chunk = (lq >> 1) + 32 * j;
                        *(LAS v2u*)(hs + rloc * 4096 + ((chunk ^ (rloc & 15)) << 4) + (lq & 1) * 8) = o; } }
                asm volatile("" ::: "memory");
                bf16x8 bw[16][2];
                { const unsigned char* wb = wff + (size_t)(16 * F.wave) * 2048 + lq * 16;
#pragma unroll
                  for (int q = 0; q < 16; ++q) { bw[q][0] = *(const GAS bf16x8*)(wb + q * 2048); bw[q][1] = *(const GAS bf16x8*)(wb + q * 2048 + 1024); } }
                __syncthreads();
                att::f32x16 acc0 = att::f32x16{};
#pragma unroll
                for (int q = 0; q < 16; ++q) { const int ks = 16 * F.wave + q;
                    const bf16x8 af = *(const LAS bf16x8*)(hs + r32 * 4096 + (((2 * ks + hi5) ^ (r32 & 15)) << 4));
                    acc0 = __builtin_amdgcn_mfma_f32_32x32x16_bf16(af, bw[q][0], acc0, 0, 0, 0); acc0 = __builtin_amdgcn_mfma_f32_32x32x16_bf16(af, bw[q][1], acc0, 0, 0, 0); }
                __syncthreads();
#pragma unroll
                for (int r = 0; r < 16; ++r) part[(F.wave * 32 + att::crow(r, hi5)) * 32 + r32] = acc0[r];
                __syncthreads();
                if (F.tid < 32 * NFOX) { const int row = F.tid / NFOX, j = F.tid % NFOX; float sacc = 0.f;
#pragma unroll
                    for (int w = 0; w < 8; ++w) sacc += part[(w * 32 + row) * 32 + j];
                    flog[(size_t)(item * 32 + row) * 16 + j] = sacc; }
                __syncthreads();
            }
            __syncthreads();
            if (BOTH(pb - 1)) GRID_BAR();
        }
        if (IN(pb + 0)) for (int rep = 0; rep < NREP(2); ++rep) {
            refresh(F);
            if ((int)blockIdx.x < NB * NFOX) {
                const int b = blockIdx.x / NFOX, hh = blockIdx.x % NFOX;
                const float* fl = (const float*)(ws + WS_FLOG) + (size_t)b * SEQ * 16 + hh; const float bf = inptr<const float>(F, I_BFORGET)[l * NFOX + hh];
                LAS float* wtot = (LAS float*)(F.lds + RING_OFF);
                float v[4], run = 0.f;
#pragma unroll
                for (int i = 0; i < 4; ++i) { const float z = fl[(size_t)(4 * F.tid + i) * 16] + bf; const float ls = fminf(z, 0.f) - log1pf(__expf(-fabsf(z))); run += ls * LOG2E; v[i] = run; }
                float inc = run;
#pragma unroll
                for (int o = 1; o < 64; o <<= 1) { const float t = __shfl_up(inc, o); if (F.lane >= o) inc += t; }
                if (F.lane == 63) wtot[F.wave] = inc;
                __syncthreads();
                float basev = inc - run;
                for (int w = 0; w < F.wave; ++w) basev += wtot[w];
                float* co = (float*)(ws + WS_CUM) + (size_t)blockIdx.x * SEQ + 4 * F.tid;
#pragma unroll
                for (int i = 0; i < 4; ++i) co[i] = basev + v[i];
                __syncthreads();
            }
            const bf16* WL = (const bf16*)(ws + WS_W + (size_t)l * W_LAYER);
            pg8::Gemm g{(const void*)(ws + WS_H), (const void*)(WL + W_IN_OFF / 2), D * 2, 127, 127}; pg8::StaticOrder S; S.init(T, NPROJ, F.G, (int)blockIdx.x);
            EpiProj E{(bf16*)(ws + WS_PROJ), (const float*)(ws + WS_TAB)};
            pg8::gemm_phase<EpiProj, pg8::StaticOrder, true>(F.lds + RING_OFF, g, S, E, F.wave, F.lane);
            if (BOTH(pb + 0)) GRID_BAR();
        }
        if (IN(pb + 1)) for (int rep = 0; rep < NREP(3); ++rep) {
            refresh(F);
            const bf16* proj = (const bf16*)(ws + WS_PROJ); unsigned char* obuf = ws + WS_OBUF;
            const float* gn = inptr<const float>(F, I_HNG) + (size_t)l * D;
            LAS unsigned char* kvbuf = F.lds + RING_OFF; LAS float* ncum = (LAS float*)(F.lds + RING_OFF + 49152); att::lptr wl = F.lds + RING_OFF + 57344 + F.wave * 9216; LAS float* wsf = (LAS float*)(F.lds + WSF_OFF + F.wave * 256);
            volatile LAS unsigned* uslot = (volatile LAS unsigned*)(F.lds + MISC_OFF + 64);
            const int qid = blockIdx.x & 7;
#ifndef ATT_ONLY
#define ATT_ONLY -1
#endif
#define ATT_DEQ(ctrp, out) do { __syncthreads(); if (F.tid == 0) uslot[0] = __hip_atomic_fetch_add((ctrp), 1u, RLX_AGENT); __syncthreads(); (out) = (int)uslot[0] * 8 + qid; } while (0)
            bf16* dstO = (bf16*)(ws + WS_DST_O); float* dstM = (float*)(ws + WS_DST_M);
            if (rep == 0) { gu32* ctr = F.ctl + CW_AQ + ((l * 4 + 3) * 8 + qid) * 64;
              for (;;) { int gi; ATT_DEQ(ctr, gi); if (gi >= 768) break;
                  const int sl_ = gi >> 3, qb = sl_ / 12, bh = 12 * (gi & 7) + sl_ % 12;
                  att::dil_a_unit(proj, dstO, dstM, F.ctl + CW_DA + ((l * 96 + bh) * 4 + (qb >> 1)) * 16, bh / 12, bh % 12, qb, wl, wsf, F.tid, F.wave); } }
            if (ATT_ONLY < 0 || ATT_ONLY == 0) { gu32* ctr = F.ctl + CW_AQ + ((l * 4 + 0) * 8 + qid) * 64 + rep * 32;
              for (;;) { int gi; ATT_DEQ(ctr, gi); if (gi >= 512) break;
                  const int sl_ = gi >> 3, qb = 7 - sl_ / 8, bh = 8 * (gi & 7) + (sl_ & 7);
                  att::sb_wave_unit(proj, gn, obuf, bh >> 3, bh & 7, 8 * qb + F.wave, wl, wsf, F.lane); } }
            if (ATT_ONLY < 0 || ATT_ONLY == 1) { gu32* ctr = F.ctl + CW_AQ + ((l * 4 + 1) * 8 + qid) * 64 + rep * 32;
              for (;;) { int gi; ATT_DEQ(ctr, gi); if (gi >= 768) break;
                  const int sl_ = gi >> 3, qb = 7 - sl_ / 12, bh = 12 * (gi & 7) + sl_ % 12;
                  att::causal_wg_unit<1>(proj, (const float*)(ws + WS_CUM) + (size_t)bh * SEQ, gn, obuf, bh / 12, bh % 12, qb, kvbuf, ncum, wl, wsf, F.tid, F.wave); } }
            if (ATT_ONLY < 0 || ATT_ONLY == 2) { gu32* ctr = F.ctl + CW_AQ + ((l * 4 + 2) * 8 + qid) * 64 + rep * 32;
              for (;;) { int gi; ATT_DEQ(ctr, gi); if (gi >= 768) break;
                  const int sl_ = gi >> 3, blk = 3 - sl_ / 24, r_ = sl_ % 24, bh = 12 * (gi & 7) + (r_ >> 1), half = r_ & 1;
                  att::dil_b_unit(proj, dstO, dstM, F.ctl + CW_DA + ((l * 96 + bh) * 4 + blk) * 16, F.ctl + CW_TMO, gn, obuf, bh / 12, bh % 12, blk, half, wl, wsf, F.tid, F.wave); } }
#undef ATT_DEQ
            __syncthreads();
            if (BOTH(pb + 1)) GRID_BAR();
        }
        if (IN(pb + 2)) for (int rep = 0; rep < NREP(4); ++rep) {
            refresh(F);
            const bf16* WL = (const bf16*)(ws + WS_W + (size_t)l * W_LAYER);
            pg8::Gemm g{(const void*)(ws + WS_OBUF), (const void*)(WL + W_OUT_OFF / 2), D, 127 - WSHIFT, 127 - ASHIFT}; pg8::StaticOrder S; S.init(T, D, F.G, (int)blockIdx.x);
            EpiMix E{(bf16*)(ws + WS_Y1)};
            pg8::gemm_phase<EpiMix, pg8::StaticOrder, true, true>(F.lds + RING_OFF, g, S, E, F.wave, F.lane);
            if (BOTH(pb + 2)) GRID_BAR();
        }
        if (IN(pb + 3)) for (int rep = 0; rep < NREP(5); ++rep) {
            refresh(F);
            const bf16* mixb = (const bf16*)(ws + WS_Y1); const float* xin = inptr<const float>(F, I_X); const bf16* xinb = (const bf16*)(ws + WS_X2B); bf16* x1 = (bf16*)(ws + WS_X1); unsigned char* h2q = ws + WS_H2;
            const float* g1 = inptr<const float>(F, I_LN1G) + (size_t)l * D; const float* b1 = inptr<const float>(F, I_LN1B) + (size_t)l * D;
            int* tinfo = (int*)(ws + WS_TINFO); float* gates = (float*)(ws + WS_GATE); int* list = (int*)(ws + WS_LIST); int* list2 = (int*)(ws + WS_LIST2);
            LAS unsigned char* h2s = F.lds + RING_OFF;
            LAS float* part = (LAS float*)(F.lds + RING_OFF);
            const unsigned char* wrf = ws + WS_WR + (size_t)l * 524288;
            const float rb = inptr<const float>(F, I_RBIAS)[l * NE + F.lane];
            for (int item_ = blockIdx.x; item_ < T / 32; item_ += F.G) {
                const int item = affine_item(item_, F.G);
                const int m0 = item * 32 + 4 * F.wave;
                int lq = F.lane; asm volatile("" : "+v"(lq));
                const int r32 = lq & 31, hi5 = lq >> 5;
                const float* mrow = (const float*)(ws + WS_MOD) + ((size_t)l * 8 + (m0 >> 11)) * 12288;
#pragma unroll
                for (int rp = 0; rp < 2; ++rp) {
                f32x4 vv[2][8];
#pragma unroll
                for (int rr = 0; rr < 2; ++rr)
#pragma unroll
                    for (int j = 0; j < 8; ++j) { const size_t off = (size_t)(m0 + 2 * rp + rr) * D + 4 * lq + 256 * j;
                        f32x4 xv; if (l == 0) xv = __builtin_nontemporal_load((const GAS f32x4*)(xin + off)); else { const v2u xw_ = __builtin_nontemporal_load((const GAS v2u*)(xinb + off)); xv = bf4(xw_.x, xw_.y); } const v2u mw = __builtin_nontemporal_load((const GAS v2u*)(mixb + off)); const f32x4 gv = *(const GAS f32x4*)(mrow + 4096 + 4 * lq + 256 * j);
                        vv[rr][j] = xv * ALPHA + gv * (f32x4){bflo(mw.x), bfhi(mw.x), bflo(mw.y), bfhi(mw.y)}; }
#pragma unroll
                for (int rq = 0; rq < 2; ++rq) { const int rr = 2 * rp + rq, m = m0 + rr, rloc = 4 * F.wave + rr;
                    f32x4 (&v)[8] = vv[rq]; float s = 0.f;
#pragma unroll
                    for (int j = 0; j < 8; ++j) s += (v[j].x + v[j].y) + (v[j].z + v[j].w);
                    const float mean = wave_sum(s) * (1.f / D); float s2 = 0.f;
#pragma unroll
                    for (int j = 0; j < 8; ++j) { v[j] = v[j] - mean; s2 += (v[j].x * v[j].x + v[j].y * v[j].y) + (v[j].z * v[j].z + v[j].w * v[j].w); }
                    const float rstd = 1.f / sqrtf(wave_sum(s2) * (1.f / D) + LN_EPS);
#pragma unroll
                    for (int j = 0; j < 8; ++j) { const int k = 4 * lq + 256 * j;
                        const f32x4 xv = v[j] * rstd * *(const GAS f32x4*)(g1 + k) + *(const GAS f32x4*)(b1 + k);
                        { v2u xo; xo.x = pk2(xv.x, xv.y); xo.y = pk2(xv.z, xv.w); *(GAS v2u*)(x1 + (size_t)m * D + k) = xo; }
                        const f32x4 hv = xv * (*(const GAS f32x4*)(mrow + 8192 + k) + 1.0f) + *(const GAS f32x4*)(mrow + 6144 + k);
                        v2u o; o.x = pk2(hv.x, hv.y); o.y = pk2(hv.z, hv.w);
                        *(GAS unsigned*)(h2q + (size_t)m * D + k) = pk4_fp8(hv.x, hv.y, hv.z, hv.w);
                        const int chunk = (lq >> 1) + 32 * j;
                        *(LAS v2u*)(h2s + rloc * 4096 + ((chunk ^ (rloc & 15)) << 4) + (lq & 1) * 8) = o; }
                }
                }
                bf16x8 bqa[4][4], bqb[4][4];
                const unsigned lo_ = lq * 16;
                const unsigned char* wbase = wrf + (size_t)(16 * F.wave) * 4096 + lo_;
#define P5_LDB(dst, q0) do { _Pragma("unroll") for (int q_ = 0; q_ < 4; ++q_) _Pragma("unroll") for (int c_ = 0; c_ < 4; ++c_) dst[q_][c_] = *(const GAS bf16x8*)(wbase + (size_t)((q0) + q_) * 4096 + c_ * 1024); } while (0)
#define P5_MMA(src, q0) do { _Pragma("unroll") for (int q_ = 0; q_ < 4; ++q_) { const int ks = 16 * F.wave + (q0) + q_; \
                    const bf16x8 af = *(const LAS bf16x8*)(h2s + r32 * 4096 + (((2 * ks + hi5) ^ (r32 & 15)) << 4)); \
                    acc0 = __builtin_amdgcn_mfma_f32_32x32x16_bf16(af, src[q_][0], acc0, 0, 0, 0); acc0 = __builtin_amdgcn_mfma_f32_32x32x16_bf16(af, src[q_][1], acc0, 0, 0, 0); \
                    acc1 = __builtin_amdgcn_mfma_f32_32x32x16_bf16(af, src[q_][2], acc1, 0, 0, 0); acc1 = __builtin_amdgcn_mfma_f32_32x32x16_bf16(af, src[q_][3], acc1, 0, 0, 0); } } while (0)
                asm volatile("" ::: "memory");
                P5_LDB(bqa, 0); P5_LDB(bqb, 4);
                __syncthreads();
                att::f32x16 acc0 = att::f32x16{}, acc1 = att::f32x16{};
                P5_MMA(bqa, 0); asm volatile("" ::: "memory"); P5_LDB(bqa, 8);
                P5_MMA(bqb, 4); asm volatile("" ::: "memory"); P5_LDB(bqb, 12);
                P5_MMA(bqa, 8); P5_MMA(bqb, 12);
#undef P5_LDB
#undef P5_MMA
                __syncthreads();
#pragma unroll
                for (int r = 0; r < 16; ++r) { const int row = att::crow(r, hi5); part[(F.wave * 32 + row) * 64 + r32] = acc0[r]; part[(F.wave * 32 + row) * 64 + 32 + r32] = acc1[r]; }
                __syncthreads();
                float score[4]; unsigned key[4]; int ek[4][6]; float sk[4][6];
#pragma unroll
                for (int rr = 0; rr < 4; ++rr) { const int rloc = 4 * F.wave + rr; float lg = 0.f;
#pragma unroll
                    for (int w = 0; w < 8; ++w) lg += part[(w * 32 + rloc) * 64 + F.lane];
                    score[rr] = 1.0f / (1.0f + __expf(-lg)); const float sel = score[rr] + rb;
                    unsigned ob = __float_as_uint(sel); ob = (ob & 0x80000000u) ? ~ob : (ob | 0x80000000u);
                    key[rr] = (ob & ~63u) | (unsigned)(63 - F.lane); }
#pragma unroll
                for (int k = 0; k < 6; ++k) {
                    unsigned mx[4];
#pragma unroll
                    for (int rr = 0; rr < 4; ++rr) mx[rr] = key[rr];
#pragma unroll
                    for (int o = 1; o < 64; o <<= 1) {
#pragma unroll
                        for (int rr = 0; rr < 4; ++rr) { const unsigned t = __shfl_xor(mx[rr], o); mx[rr] = t > mx[rr] ? t : mx[rr]; } }
#pragma unroll
                    for (int rr = 0; rr < 4; ++rr) { const int win = 63 - (int)(__builtin_amdgcn_readfirstlane((int)mx[rr]) & 63);
                        ek[rr][k] = win; sk[rr][k] = __uint_as_float((unsigned)__builtin_amdgcn_readlane((int)__float_as_uint(score[rr]), win)); if (F.lane == win) key[rr] = 0u; }
                }
#pragma unroll
                for (int rr = 0; rr < 4; ++rr) { const int m = m0 + rr;
                    const float ssum = ((sk[rr][0] + sk[rr][1]) + (sk[rr][2] + sk[rr][3])) + (sk[rr][4] + sk[rr][5]);
                    if (F.lane < 6 && rep == 0) { int e = ek[rr][0]; float sc = sk[rr][0];
#pragma unroll
                        for (int k = 1; k < 6; ++k) if (F.lane == k) { e = ek[rr][k]; sc = sk[rr][k]; }
                        const unsigned pos = __hip_atomic_fetch_add(F.ctl + CW_CURSOR + (l * 64 + e) * 16, 1u, RLX_AGENT);
                        if (pos < (unsigned)LISTCAP) { list[(size_t)e * LISTCAP + pos] = m; list2[(size_t)e * LISTCAP + pos] = m * 7 + F.lane; }
                        tinfo[(size_t)m * 6 + F.lane] = e | (int)(pos << 8); gates[(size_t)m * 6 + F.lane] = sc / ssum * ROUTED_SCALE; }
                }
                __syncthreads();
            }
            __syncthreads();
            if (BOTH(pb + 3)) GRID_BAR();
        }
        if (IN(pb + 4)) for (int rep = 0; rep < NREP(6); ++rep) {
            refresh(F);
            build_tables(F, l);
            const LAS int* tb = (const LAS int*)(F.lds + TB_OFF);
            MoeOrder<true, 4> S{F.G, (int)blockIdx.x, tb[65] * 4, (const LAS int*)(F.lds + TILEE_OFF), tb, (const LAS int*)(F.lds + CNT_OFF), (const int*)(ws + WS_LIST), (unsigned)D};
            const bf16* WL = (const bf16*)(ws + WS_W + (size_t)l * W_LAYER);
            pg8::Gemm g{(const void*)(ws + WS_H2), (const void*)(WL + W_1_OFF / 2), D, 127 - WSHIFT, 127};
            EpiSwiglu E{(unsigned char*)(ws + WS_ACT)};
            pg8::gemm_phase<EpiSwiglu, MoeOrder<true, 4>, true, true>(F.lds + RING_OFF, g, S, E, F.wave, F.lane);
            if (BOTH(pb + 4)) GRID_BAR();
        }
        if (IN(pb + 5)) for (int rep = 0; rep < NREP(7); ++rep) {
            refresh(F);
            build_tables(F, l);
            const LAS int* tb = (const LAS int*)(F.lds + TB_OFF);
            MoeOrder<false, 8> S{F.G, (int)blockIdx.x, tb[65] * 8, (const LAS int*)(F.lds + TILEE_OFF), tb, (const LAS int*)(F.lds + CNT_OFF), (const int*)(ws + WS_LIST), (unsigned)EH};
            const bf16* WL = (const bf16*)(ws + WS_W + (size_t)l * W_LAYER);
            pg8::Gemm g{(const void*)(ws + WS_ACT), (const void*)(WL + W_2_OFF / 2), EH, 127 - WSHIFT, 127 - ASHIFT};
            EpiDown E{(unsigned char*)(ws + WS_YBUF), (const LAS int*)(F.lds + TILEE_OFF), tb, (const LAS int*)(F.lds + CNT_OFF), (const int*)(ws + WS_LIST2)};
            pg8::gemm_phase<EpiDown, MoeOrder<false, 8>, true, true>(F.lds + RING_OFF, g, S, E, F.wave, F.lane);
            if (BOTH(pb + 5)) GRID_BAR();
        }
        if (IN(pb + 6)) for (int rep = 0; rep < NREP(8); ++rep) {
            refresh(F);
            const unsigned char* yb = ws + WS_YBUF; const bf16* x1 = (const bf16*)(ws + WS_X1); bf16* x2b = (bf16*)(ws + WS_X2B);
            const int* tinfo = (const int*)(ws + WS_TINFO); const float* gates = (const float*)(ws + WS_GATE);
            const float* g2 = inptr<const float>(F, I_LN2G) + (size_t)l * D; const float* b2 = inptr<const float>(F, I_LN2B) + (size_t)l * D; float* Fout = inptr<float>(F, I_OUT);
            auto row_of = [&](const int m_) { return (F.G == 256) ? (2048 * ((m_ >> 3) & 7) + 8 * ((m_ & 2047) >> 6) + (m_ & 7) + 256 * (m_ >> 11)) : m_; };
            auto load_row = [&](const int m, v4u (&xr)[4], v4u (&yr)[14], float& gtv) {
                int ln = F.lane; asm volatile("" : "+v"(ln));
                gtv = 0.f; if (ln < 6) gtv = gates[(size_t)m * 6 + ln];
#pragma unroll
                for (int jh = 0; jh < 2; ++jh) { xr[2 * jh] = __builtin_nontemporal_load((const GAS v4u*)(x1 + (size_t)m * D + 16 * ln + 1024 * jh)); xr[2 * jh + 1] = __builtin_nontemporal_load((const GAS v4u*)(x1 + (size_t)m * D + 16 * ln + 1024 * jh + 8)); }
#pragma unroll
                for (int jh = 0; jh < 2; ++jh)
#pragma unroll
                    for (int q = 0; q < 7; ++q) yr[7 * jh + q] = __builtin_nontemporal_load((const GAS v4u*)(yb + ((size_t)m * 7 + q) * D + 16 * ln + 1024 * jh));
                asm volatile("" ::: "memory");
            };
            auto process_row = [&](const int m, v4u (&xr)[4], v4u (&yr)[14], const float gtv) {
                int ln = F.lane; asm volatile("" : "+v"(ln));
                const float* mrow = (const float*)(ws + WS_MOD) + ((size_t)l * 8 + (m >> 11)) * 12288;
                float gt[7];
#pragma unroll
                for (int k = 0; k < 6; ++k) gt[k] = __uint_as_float((unsigned)__builtin_amdgcn_readlane((int)__float_as_uint(gtv), k));
                gt[6] = 1.0f;
                f32x4 v[8]; float s = 0.f;
#pragma unroll
                for (int jh = 0; jh < 2; ++jh) { const v4u xa = xr[2 * jh], xb = xr[2 * jh + 1];
                    v[4 * jh] = bf4(xa.x, xa.y); v[4 * jh + 1] = bf4(xa.z, xa.w); v[4 * jh + 2] = bf4(xb.x, xb.y); v[4 * jh + 3] = bf4(xb.z, xb.w); }
#pragma unroll
                for (int jh = 0; jh < 2; ++jh) {
#pragma unroll
                    for (int i = 0; i < 4; ++i) { const int j = 4 * jh + i, k = 16 * ln + 1024 * jh + 4 * i; f32x4 f = (f32x4){0.f, 0.f, 0.f, 0.f};
#pragma unroll
                        for (int q = 0; q < 7; ++q) { const unsigned w = yr[7 * jh + q][i]; const float gq = gt[q];
                            const auto lo2 = __builtin_amdgcn_cvt_pk_f32_fp8((int)w, false), hi2 = __builtin_amdgcn_cvt_pk_f32_fp8((int)w, true);
                            f.x += gq * lo2[0]; f.y += gq * lo2[1]; f.z += gq * hi2[0]; f.w += gq * hi2[1]; }
                        v[j] = v[j] * ALPHA + *(const GAS f32x4*)(mrow + 10240 + k) * (f * (1.0f / (float)(1 << YSHIFT)));
                        s += (v[j].x + v[j].y) + (v[j].z + v[j].w); }
                }
                const float mean = wave_sum(s) * (1.f / D); float s2 = 0.f;
#pragma unroll
                for (int j = 0; j < 8; ++j) { v[j] = v[j] - mean; s2 += (v[j].x * v[j].x + v[j].y * v[j].y) + (v[j].z * v[j].z + v[j].w * v[j].w); }
                const float rstd = 1.f / sqrtf(wave_sum(s2) * (1.f / D) + LN_EPS);
                float* orow = Fout + (size_t)m * D;
#pragma unroll
                for (int j = 0; j < 8; ++j) { const int k = 16 * ln + 1024 * (j >> 2) + 4 * (j & 3);
                    v[j] = v[j] * rstd * *(const GAS f32x4*)(g2 + k) + *(const GAS f32x4*)(b2 + k);
                    if (l == 1) { *(GAS f32x4*)(orow + k) = v[j]; if (j & 1) asm volatile("" ::: "memory"); } }
                if (l == 0) {
#pragma unroll
                    for (int jh = 0; jh < 2; ++jh) { v4u wa, wb; wa.x = pk2(v[4 * jh].x, v[4 * jh].y); wa.y = pk2(v[4 * jh].z, v[4 * jh].w); wa.z = pk2(v[4 * jh + 1].x, v[4 * jh + 1].y); wa.w = pk2(v[4 * jh + 1].z, v[4 * jh + 1].w);
                        wb.x = pk2(v[4 * jh + 2].x, v[4 * jh + 2].y); wb.y = pk2(v[4 * jh + 2].z, v[4 * jh + 2].w); wb.z = pk2(v[4 * jh + 3].x, v[4 * jh + 3].y); wb.w = pk2(v[4 * jh + 3].z, v[4 * jh + 3].w);
                        *(GAS v4u*)(x2b + (size_t)m * D + 16 * ln + 1024 * jh) = wa; *(GAS v4u*)(x2b + (size_t)m * D + 16 * ln + 1024 * jh + 8) = wb; } }
                asm volatile("" ::: "memory");
            };
            {
                v4u xA[4], yA[14], xB[4], yB[14]; float gA = 0.f, gB = 0.f;
                if (gw < T) load_row(row_of(gw), xA, yA, gA);
#pragma clang loop unroll(disable)
                for (int m_ = gw; m_ < T; m_ += 2 * NGW) {
                    const bool hasB = m_ + NGW < T;
                    if (hasB) load_row(row_of(m_ + NGW), xB, yB, gB);
                    process_row(row_of(m_), xA, yA, gA);
                    if (m_ + 2 * NGW < T) load_row(row_of(m_ + 2 * NGW), xA, yA, gA);
                    if (hasB) process_row(row_of(m_ + NGW), xB, yB, gB);
                }
            }
            __syncthreads();
            if ((l == 0 || rep + 1 < NREP(8)) && BOTH(pb + 6)) GRID_BAR();
        }

}
struct Args { const void* in[21]; float* out; unsigned char* ws; int ph_lo, ph_hi; };
__global__ void __launch_bounds__(NWAVES * 64, 2) fwd_kernel(Args args) {
    extern __shared__ __attribute__((aligned(16))) unsigned char lds[];
    Frame F;
    F.lds = (LAS unsigned char*)lds;
    F.wave = __builtin_amdgcn_readfirstlane((int)(threadIdx.x >> 6)); refresh(F); F.G = gridDim.x;
    unsigned char* ws = args.ws; F.ws = ws; F.ctl = (gu32*)(ws + WS_CTL);
    for (int u = F.tid; u < (LDS_BYTES - LDSCTL_OFF) / 4; u += NWAVES * 64) ((LAS unsigned*)(F.lds + LDSCTL_OFF))[u] = 0u;
    __syncthreads();
    if (F.tid < 21) *(LAS unsigned long long*)(F.lds + PTR_OFF + 8 * F.tid) = (unsigned long long)args.in[F.tid];
    if (F.tid == 21) *(LAS unsigned long long*)(F.lds + PTR_OFF + 8 * 21) = (unsigned long long)args.out;
    __syncthreads();
    volatile LAS unsigned* MISC = (volatile LAS unsigned*)(F.lds + MISC_OFF);
    XcdBarrier bar; bar.bar = (unsigned*)(F.ctl + CW_BAR); bar.x = 0; bar.st = nullptr;
#if MK_ONE_LAUNCH
    bar = xcd_barrier_post((unsigned*)(F.ctl + CW_BAR), MISC + 8, F.tid == 0);
#endif
    const int lo = args.ph_lo, hi = args.ph_hi;
    const int gw = blockIdx.x * NWAVES + F.wave, NGW = F.G * NWAVES;

    if (IN(0)) for (int rep = 0; rep < NREP(0); ++rep) { refresh(F); p0_prologue(F); if (BOTH(0)) GRID_BAR(); }
    layer_phases<0>(F, bar, lo, hi);
    layer_phases<1>(F, bar, lo, hi);
#undef IN
#undef BOTH
}

extern "C" void kernel_launch(void* const* d_in, const int* in_sizes, int n_in, void* d_out, int out_size, void* d_ws, size_t ws_size, hipStream_t stream) {
    static int grid = 0;
    if (grid == 0) {
        if (n_in != 21 || out_size != T * D || ws_size < WS_END) { fprintf(stderr, "kernel_launch: unexpected sizes (n_in %d, out %d, ws %zu < %zu)\n", n_in, out_size, ws_size, (size_t)WS_END); grid = -1; return; }
        int dev = 0, cus = 0, per_cu = 0;
        if (hipGetDevice(&dev) != hipSuccess || hipDeviceGetAttribute(&cus, hipDeviceAttributeMultiprocessorCount, dev) != hipSuccess) { grid = -1; return; }
        if (hipFuncSetAttribute((const void*)fwd_kernel, hipFuncAttributeMaxDynamicSharedMemorySize, LDS_BYTES) != hipSuccess) { fprintf(stderr, "kernel_launch: hipFuncSetAttribute failed\n"); grid = -1; return; }
        if (hipOccupancyMaxActiveBlocksPerMultiprocessor(&per_cu, (const void*)fwd_kernel, NWAVES * 64, LDS_BYTES) != hipSuccess || per_cu < 1) { fprintf(stderr, "kernel_launch: occupancy query says %d\n", per_cu); }
        (void)hipGetLastError();
        grid = cus;
    }
    if (grid < 0) return;
    (void)in_sizes;
    hipMemsetAsync((char*)d_ws + WS_CTL, 0, CTL_ZERO_BYTES, stream);
    Args a{};
    for (int i = 0; i < 21; ++i) a.in[i] = d_in[i];
    a.out = (float*)d_out; a.ws = (unsigned char*)d_ws;
#if MK_ONE_LAUNCH
    a.ph_lo = 0; a.ph_hi = 17;
    hipLaunchKernelGGL(fwd_kernel, dim3(grid), dim3(NWAVES * 64), LDS_BYTES, stream, a);
#else
    for (int p = 0; p < 17; ++p) { a.ph_lo = p; a.ph_hi = p + 1; hipLaunchKernelGGL(fwd_kernel, dim3(grid), dim3(NWAVES * 64), LDS_BYTES, stream, a); }
#endif
}
```
